# Optimizing an MI355X kernel written in HIP

```python
import jax, jax.numpy as jnp
from jax import lax
import numpy as np

D_MODEL = 1024
BATCH = 8
SEQ = 4096
DEPTH = 2

CHUNK = 64
MIX_WIDTH = D_MODEL
GMLP_WIDTH = MIX_WIDTH // 2
GMLP_GROUPS = 4
GMLP_GROUP_CH = GMLP_WIDTH // GMLP_GROUPS
GMLP_BLOCK = 128
FOX_WIDTH = MIX_WIDTH - GMLP_WIDTH
FOX_HEAD_DIM = 64
FOX_HEADS = FOX_WIDTH // FOX_HEAD_DIM
FOX_Q_BLOCK = 128
IN_COLS = 2 * GMLP_WIDTH + 3 * FOX_WIDTH + FOX_HEADS
PLE_DIM = 256
N_EXPERTS = 32
TOP_K = 4
D_EXPERT = D_MODEL
SWIGLU_LIMIT = 7.0
SWIGLU_ALPHA = 1.702
EXPERT_ROWS = 256
RMS_EPS = 1e-5
LN_EPS = 1e-5

kernel_name = "hybrid_gmlp_fox_moe_streaming_encoder"


def rms_norm(x, g):
    xf = x.astype(jnp.float32)
    y = xf * lax.rsqrt(jnp.mean(xf * xf, axis=-1, keepdims=True) + RMS_EPS)
    return (y * g.astype(jnp.float32)).astype(x.dtype)


def layer_norm(x, g, b):
    xf = x.astype(jnp.float32)
    mu = jnp.mean(xf, axis=-1, keepdims=True)
    var = jnp.mean(jnp.square(xf - mu), axis=-1, keepdims=True)
    y = (xf - mu) * lax.rsqrt(var + LN_EPS)
    return (y * g.astype(jnp.float32) + b.astype(jnp.float32)).astype(x.dtype)


def spatial_gating(z_a, ln_g, ln_b, w_s, b_s):
    B, S, _ = z_a.shape
    z = jax.nn.gelu(z_a, approximate=False)
    u, v = jnp.split(z, 2, axis=-1)
    v = layer_norm(v, ln_g, ln_b)
    v = v.reshape(B, S // GMLP_BLOCK, GMLP_BLOCK, GMLP_GROUPS, GMLP_GROUP_CH)
    pos = jnp.arange(GMLP_BLOCK)
    allowed = (pos[None, :] // CHUNK) <= (pos[:, None] // CHUNK)
    ws = jnp.where(allowed[None], w_s, jnp.zeros_like(w_s))
    sv = jnp.einsum('gij,bnjgc->bnigc', ws, v) + b_s.T[None, None, :, :, None]
    return u * sv.reshape(B, S, GMLP_WIDTH)


def forgetting_attention(q, k, v, f_logit, b_f):
    B, S, _ = q.shape
    def heads(t):
        return t.reshape(B, S, FOX_HEADS, FOX_HEAD_DIM).transpose(0, 2, 1, 3)
    q, k, v = heads(q), heads(k), heads(v)
    log_f = jax.nn.log_sigmoid((f_logit + b_f).astype(jnp.float32))
    c = jnp.cumsum(log_f, axis=1).transpose(0, 2, 1)
    scale = FOX_HEAD_DIM ** -0.5
    neg = jnp.finfo(jnp.float32).min
    outs = []
    for qb in range(S // FOX_Q_BLOCK):
        s0 = qb * FOX_Q_BLOCK
        end = s0 + FOX_Q_BLOCK
        logits = jnp.einsum('bhqd,bhkd->bhqk', q[:, :, s0:end], k[:, :, :end]).astype(jnp.float32) * scale
        logits = logits + c[:, :, s0:end, None] - c[:, :, None, :end]
        causal = jnp.arange(end)[None, :] <= (s0 + jnp.arange(FOX_Q_BLOCK))[:, None]
        logits = jnp.where(causal, logits, neg)
        w = jax.nn.softmax(logits, axis=-1).astype(v.dtype)
        outs.append(jnp.einsum('bhqk,bhkd->bhqd', w, v[:, :, :end]))
    o = jnp.concatenate(outs, axis=2)
    return o.transpose(0, 2, 1, 3).reshape(B, S, FOX_WIDTH)


def moe_ffn(xn, w_router, b_router, w_gu, b_gu, w_dn, b_dn):
    B, S, D = xn.shape
    T = B * S
    xt = xn.reshape(T, D)
    logits = (xt @ w_router + b_router).astype(jnp.float32)
    top_v, top_i = lax.top_k(logits, TOP_K)
    gates = jax.nn.softmax(top_v, axis=-1)
    A = T * TOP_K
    flat_e = top_i.reshape(A).astype(jnp.int32)
    flat_tok = jnp.arange(A, dtype=jnp.int32) // TOP_K
    order = jnp.argsort(flat_e, stable=True)
    sorted_e = flat_e[order]
    counts = jnp.bincount(flat_e, length=N_EXPERTS).astype(jnp.int32)
    starts = jnp.cumsum(counts) - counts
    padded = (counts + EXPERT_ROWS - 1) // EXPERT_ROWS * EXPERT_ROWS
    pad_ends = jnp.cumsum(padded)
    pad_starts = pad_ends - padded
    rank = jnp.arange(A, dtype=jnp.int32) - starts[sorted_e]
    dest_sorted = pad_starts[sorted_e] + rank
    n_blocks = -(-A // EXPERT_ROWS) + N_EXPERTS
    P = n_blocks * EXPERT_ROWS
    row_tok = jnp.full((P,), T, dtype=jnp.int32).at[dest_sorted].set(flat_tok[order])
    x_pad = jnp.concatenate([xt, jnp.zeros((1, D), xt.dtype)], axis=0)
    xs = x_pad[row_tok].reshape(n_blocks, EXPERT_ROWS, D)
    block_start = jnp.arange(n_blocks, dtype=jnp.int32) * EXPERT_ROWS
    block_e = jnp.minimum(jnp.searchsorted(pad_ends, block_start, side='right'), N_EXPERTS - 1).astype(jnp.int32)

    def expert_block(args):
        xb, e = args
        h = xb @ w_gu[e] + b_gu[e]
        g, lin = jnp.split(h, 2, axis=-1)
        g = jnp.minimum(g, SWIGLU_LIMIT)
        lin = jnp.clip(lin, -SWIGLU_LIMIT, SWIGLU_LIMIT)
        act = g * jax.nn.sigmoid(SWIGLU_ALPHA * g) * (lin + 1.0)
        return act @ w_dn[e] + b_dn[e]

    ys = lax.map(expert_block, (xs, block_e)).reshape(P, D)
    dest = jnp.zeros((A,), jnp.int32).at[order].set(dest_sorted)
    y = jnp.sum(ys[dest].reshape(T, TOP_K, D) * gates[..., None].astype(ys.dtype), axis=1)
    return y.reshape(B, S, D)


def setup_inputs(seed: int = 0) -> dict:
    key = jax.random.key(seed)
    ks = jax.random.split(key, 24)
    f32 = jnp.float32
    def nrm(k, shape, scale):
        return jax.random.normal(k, shape, f32) * scale
    L, D, E, F = DEPTH, D_MODEL, N_EXPERTS, D_EXPERT
    return {
        "x": nrm(ks[0], (BATCH, SEQ, D), 1.0),
        "p": nrm(ks[1], (DEPTH, BATCH, SEQ, PLE_DIM), 1.0),
        "g_mix": 1.0 + nrm(ks[2], (L, D), 0.05),
        "w_in": nrm(ks[3], (L, D, IN_COLS), D ** -0.5),
        "ln_g": 1.0 + nrm(ks[4], (L, GMLP_WIDTH), 0.05),
        "ln_b": nrm(ks[5], (L, GMLP_WIDTH), 0.02),
        "w_s": nrm(ks[6], (L, GMLP_GROUPS, GMLP_BLOCK, GMLP_BLOCK), GMLP_BLOCK ** -0.5),
        "b_s": 1.0 + nrm(ks[7], (L, GMLP_GROUPS, GMLP_BLOCK), 0.1),
        "b_f": 4.0 + nrm(ks[8], (L, FOX_HEADS), 0.5),
        "g_a": 1.0 + nrm(ks[9], (L, GMLP_WIDTH), 0.05),
        "g_b": 1.0 + nrm(ks[10], (L, FOX_WIDTH), 0.05),
        "w_out": nrm(ks[11], (L, MIX_WIDTH, D), MIX_WIDTH ** -0.5),
        "g_moe": 1.0 + nrm(ks[12], (L, D), 0.05),
        "w_router": nrm(ks[13], (L, D, E), D ** -0.5),
        "b_router": nrm(ks[14], (L, E), 0.01),
        "w_gu": nrm(ks[15], (L, E, D, 2 * F), D ** -0.5),
        "b_gu": nrm(ks[16], (L, E, 2 * F), 0.02),
        "w_dn": nrm(ks[17], (L, E, F, D), F ** -0.5),
        "b_dn": nrm(ks[18], (L, E, D), 0.02),
        "g_ple": 1.0 + nrm(ks[19], (L, D), 0.05),
        "w_ple_gate": nrm(ks[20], (L, D, D), D ** -0.5),
        "w_ple": nrm(ks[21], (L, PLE_DIM, D), PLE_DIM ** -0.5),
        "g_final": 1.0 + nrm(ks[22], (D,), 0.05),
    }


def reference(x, p, g_mix, w_in, ln_g, ln_b, w_s, b_s, b_f, g_a, g_b, w_out,
              g_moe, w_router, b_router, w_gu, b_gu, w_dn, b_dn,
              g_ple, w_ple_gate, w_ple, g_final):
    h = x
    c1 = 2 * GMLP_WIDTH
    c2 = c1 + FOX_WIDTH
    c3 = c2 + FOX_WIDTH
    c4 = c3 + FOX_WIDTH
    for i in range(DEPTH):
        xn = rms_norm(h, g_mix[i])
        z = xn @ w_in[i]
        y_a = spatial_gating(z[..., :c1], ln_g[i], ln_b[i], w_s[i], b_s[i])
        y_b = forgetting_attention(z[..., c1:c2], z[..., c2:c3], z[..., c3:c4], z[..., c4:], b_f[i])
        y = jnp.concatenate([rms_norm(y_a, g_a[i]), rms_norm(y_b, g_b[i])], axis=-1) @ w_out[i]
        h = h + y
        h = h + moe_ffn(rms_norm(h, g_moe[i]), w_router[i], b_router[i], w_gu[i], b_gu[i], w_dn[i], b_dn[i])
        gate = jax.nn.sigmoid(rms_norm(h, g_ple[i]) @ w_ple_gate[i])
        h = h + gate * (p[i] @ w_ple[i])
    return rms_norm(h, g_final)
```

```cpp
#include <hip/hip_runtime.h>
#include <hip/hip_bf16.h>
#include <cstdio>
#include <cstdint>
#include <cmath>
namespace pg8 {
#define PG8_LAS __attribute__((address_space(3)))
typedef unsigned short bf16_t;
typedef short bf16x8 __attribute__((ext_vector_type(8)));
typedef float f32x4 __attribute__((ext_vector_type(4)));
typedef float f32x2 __attribute__((ext_vector_type(2)));
typedef unsigned u32x4 __attribute__((ext_vector_type(4)));
typedef unsigned u32x2 __attribute__((ext_vector_type(2)));
constexpr int BM = 256, BK = 64, HALF = 128, HTB = HALF * BK * 2  , STAGE_BYTES = 8 * HTB, NXCD = 8, WGM = 8;

__host__ __device__ __forceinline__ int lds_byte(int r, int c) { const int st = (r >> 4) * 2 + (c >> 5), rr = r & 15, cc = c & 31, ob = rr * 64 + cc * 2; return st * 1024 + (ob ^ (((ob >> 9) & 1) << 5)); }
__host__ __device__ __forceinline__ void stage_rc(int b, int& R, int& C) { const int st = b / 1024, sb = b % 1024, swz = sb ^ (((sb >> 9) & 1) << 5); R = (st >> 1) * 16 + swz / 64; C = (st & 1) * 32 + (swz % 64) / 2; }
__host__ __device__ __forceinline__ int perm32(int rho) { const int n = rho >> 4, i = rho & 15; return 8 * (i >> 2) + 4 * n + (i & 3); }

struct Unit { int pm, pn, e, mt; };

struct DenseOrder {
    const char* A; const char* Bt; int K;
    int nM, nN, nwg, G, c;
    __device__ void init(const void* A_, const void* Bt_, int M, int N, int K_, int G_, int c_) { A = (const char*)A_; Bt = (const char*)Bt_; K = K_; nM = M / BM; nN = N / BM; nwg = nM * nN; G = G_; c = c_; }
    __device__ __forceinline__ bool next(int i, Unit& u) const {
        const long L = (long)i * G + c; if (L >= nwg) return false;
        int wgid = (int)L; { const int q = nwg / NXCD, r = nwg % NXCD, xcd = wgid % NXCD, off = wgid / NXCD; wgid = (xcd < r ? xcd * (q + 1) : r * (q + 1) + (xcd - r) * q) + off; }
        const int nig = WGM * nN, gid = wgid / nig, fm = gid * WGM, gsz = (nM - fm) < WGM ? (nM - fm) : WGM;
        u.pm = fm + ((wgid % nig) % gsz); u.pn = (wgid % nig) / gsz; u.e = 0; u.mt = 0; return true;
    }
    __device__ __forceinline__ const char* a_base(const Unit& u) const { return A + (size_t)u.pm * BM * K * 2; }
    __device__ __forceinline__ const char* b_base(const Unit& u) const { return Bt + (size_t)u.pn * BM * K * 2; }
    __device__ __forceinline__ unsigned row_off(const Unit&, int r) const { return (unsigned)(r * K * 2); }
};
template <bool GATHER> struct GroupedOrder {
    const char* A; const char* Bt; int K, N, npn;
    const PG8_LAS int* tiles; const PG8_LAS int* cnt; const int* lists;
    int ntiles, G, vcu;
    __device__ __forceinline__ bool next(int i, Unit& u) const {
        const int L = i * G + vcu; if (L >= ntiles * npn) return false;
        const int ti = L / npn; u.pn = L - ti * npn; const int v = __builtin_amdgcn_readfirstlane(tiles[ti]); u.e = v & 255; u.mt = v >> 8; u.pm = ti; return true;
    }
    __device__ __forceinline__ const char* a_base(const Unit& u) const { return GATHER ? A : A + (size_t)u.pm * BM * K * 2; }
    __device__ __forceinline__ const char* b_base(const Unit& u) const { return Bt + ((size_t)u.e * N + (size_t)u.pn * BM) * K * 2; }
    __device__ __forceinline__ unsigned row_off(const Unit& u, int r) const {
        if (!GATHER) return (unsigned)(r * K * 2);
        const int rr = u.mt * BM + r; const int tok = (rr < cnt[u.e]) ? lists[u.e * 32768 + rr] : 0; return (unsigned)tok * (unsigned)(K * 2);
    }
};

__device__ __forceinline__ unsigned cvt_pk_bf16(float lo, float hi) { unsigned r; asm volatile("v_cvt_pk_bf16_f32 %0, %1, %2" : "=v"(r) : "v"(lo), "v"(hi)); return r; }
__device__ __forceinline__ f32x2 gelu_pk(f32x2 v) {
    const f32x2 av = __builtin_elementwise_abs(v), d = av * 0.2316418882f + 1.0f;
    f32x2 t; t.x = __builtin_amdgcn_rcpf(d.x); t.y = __builtin_amdgcn_rcpf(d.y);
    f32x2 q = t * 0.5307027145f + (-0.7265760135f); q = q * t + 0.7107068705f; q = q * t + (-0.142248368f); q = q * t + 0.127414796f; q = q * t;
    const f32x2 s = (v * v) * (-0.72134752044f);
    f32x2 e; e.x = __builtin_amdgcn_exp2f(s.x); e.y = __builtin_amdgcn_exp2f(s.y);
    const f32x2 m = v * (q * e), r = v - m;
    f32x2 o; o.x = v.x < 0.f ? m.x : r.x; o.y = v.y < 0.f ? m.y : r.y; return o;
}

template <class Epi, class Sched, bool GATHER, bool MIDK>
__device__ __forceinline__ void gemm_phase(PG8_LAS unsigned char* lds, const int K, const Sched& S, const Epi& E, const int tid_in) {
    int tid_ = tid_in; asm volatile("" : "+v"(tid_));
    const int tid = tid_, wid = __builtin_amdgcn_readfirstlane(tid >> 6), lane = tid & 63, wr = wid >> 2, wc = wid & 3, fr = lane & 15, fq = lane >> 4;
    const int nt = K / BK;
    unsigned voffA[2], voffB[2], ac[2][2], an[2][2];
    PG8_LAS u32x4* anp = (PG8_LAS u32x4*)(lds + STAGE_BYTES + 3072) + tid;
#pragma unroll
    for (int i = 0; i < 2; ++i) { int R, C; stage_rc(tid * 16 + i * 8192, R, C); const int Rb = Epi::PERM ? ((R & ~31) + perm32(R & 31)) : R;
        voffA[i] = (unsigned)(R * K + C) * 2u; voffB[i] = (unsigned)(Rb * K + C) * 2u; ac[0][i] = ac[1][i] = an[0][i] = an[1][i] = 0u; }
    const size_t kstep = (size_t)(BK * 2);
    const size_t hstep = (size_t)HALF * K * 2;
    const unsigned ldsw = (unsigned)wid * 1024u;
    const int aoff = lds_byte(wr * 64 + fr, fq * 8), boff = lds_byte(wc * 32 + fr, fq * 8);
#define PG8_SA(b, h) (((b) * 2 + (h)) * HTB)
#define PG8_SB(b, h) ((4 + (b) * 2 + (h)) * HTB)
#define PG8_STAGE(bufoff, gbase, voff) do { _Pragma("unroll") for (int _i = 0; _i < 2; ++_i) \
        __builtin_amdgcn_global_load_lds((const unsigned*)((const char*)(gbase) + (voff)[_i]), (PG8_LAS unsigned*)(lds + (bufoff) + ldsw + _i * 8192), 16, 0, 0); } while (0)
#define PG8_STAGE2(bufoff, gbase, o0, o1) do { \
        __builtin_amdgcn_global_load_lds((const unsigned*)((const char*)(gbase) + (o0)), (PG8_LAS unsigned*)(lds + (bufoff) + ldsw), 16, 0, 0); \
        __builtin_amdgcn_global_load_lds((const unsigned*)((const char*)(gbase) + (o1)), (PG8_LAS unsigned*)(lds + (bufoff) + ldsw + 8192), 16, 0, 0); } while (0)
#define PG8_LDA(dst, b, h) do { _Pragma("unroll") for (int m = 0; m < 4; ++m) _Pragma("unroll") for (int k = 0; k < 2; ++k) dst[m][k] = *(const PG8_LAS bf16x8*)(lds + PG8_SA(b, h) + aoff + m * 2048 + k * 1024); } while (0)
#define PG8_LDB(dst, b, h) do { _Pragma("unroll") for (int n = 0; n < 2; ++n) _Pragma("unroll") for (int k = 0; k < 2; ++k) dst[n][k] = *(const PG8_LAS bf16x8*)(lds + PG8_SB(b, h) + boff + n * 2048 + k * 1024); } while (0)
#define PG8_MMA(ai, bj, At, Bt) do { __builtin_amdgcn_s_setprio(1); _Pragma("unroll") for (int m = 0; m < 4; ++m) _Pragma("unroll") for (int n = 0; n < 2; ++n) _Pragma("unroll") for (int k = 0; k < 2; ++k) \
        acc[ai][bj][m][n] = __builtin_amdgcn_mfma_f32_16x16x32_bf16(Bt[n][k], At[m][k], acc[ai][bj][m][n], 0, 0, 0); __builtin_amdgcn_s_setprio(0); } while (0)
#define PG8_WAIT_V(n) asm volatile("s_waitcnt vmcnt(" #n ")" ::: "memory")
#define PG8_WAIT_L(n) asm volatile("s_waitcnt lgkmcnt(" #n ")" ::: "memory")
#define PG8_BAR __builtin_amdgcn_s_barrier()
#define PG8_SCHED __builtin_amdgcn_sched_barrier(0)
#define PG8_AOFFS(dst, u) do { if constexpr (GATHER) { int t2_ = tid; asm volatile("" : "+v"(t2_)); _Pragma("unroll") for (int _i = 0; _i < 2; ++_i) { int R_, C_; stage_rc(t2_ * 16 + _i * 8192, R_, C_); \
        _Pragma("unroll") for (int _h = 0; _h < 2; ++_h) dst[_h][_i] = S.row_off(u, _h * HALF + R_) + (unsigned)(C_ * 2); } } } while (0)
#define PG8_STAGE_A(bufoff, gp, h, o0, o1) do { if constexpr (GATHER) { PG8_STAGE2(bufoff, gp, o0, o1); } else { PG8_STAGE(bufoff, (gp) + (h) * hstep, voffA); } } while (0)
    Unit cur, nxt; int ui = 0;
    if (!S.next(0, cur)) return;
    f32x4 acc[2][2][4][2];
#pragma unroll
    for (int a = 0; a < 2; ++a)
#pragma unroll
        for (int b = 0; b < 2; ++b)
#pragma unroll
            for (int m = 0; m < 4; ++m)
#pragma unroll
                for (int n = 0; n < 2; ++n) acc[a][b][m][n] = (f32x4){0.f, 0.f, 0.f, 0.f};
    bf16x8 At[4][2], B0[2][2], B1[2][2];
    const char* cA = S.a_base(cur); const char* cB = S.b_base(cur);
    PG8_AOFFS(ac, cur);
    if constexpr (GATHER) {
#pragma unroll
        for (int _h = 0; _h < 2; ++_h)
#pragma unroll
            for (int _i = 0; _i < 2; ++_i) an[_h][_i] = ac[_h][_i];
    }
    PG8_STAGE(PG8_SB(0, 0), cB, voffB); PG8_STAGE(PG8_SB(0, 1), cB + hstep, voffB); PG8_STAGE_A(PG8_SA(0, 0), cA, 0, ac[0][0], ac[0][1]); PG8_STAGE_A(PG8_SA(0, 1), cA, 1, ac[1][0], ac[1][1]);
    if (wr == 1) PG8_BAR;
    PG8_WAIT_V(2); PG8_BAR;
    PG8_STAGE(PG8_SB(1, 0), cB + kstep, voffB); PG8_STAGE_A(PG8_SA(1, 0), cA + kstep, 0, ac[0][0], ac[0][1]); PG8_STAGE(PG8_SB(1, 1), cB + hstep + kstep, voffB);
    PG8_WAIT_V(6); PG8_BAR;
    for (;;) {
        const bool has_next = S.next(ui + 1, nxt);
        const char* nA = has_next ? S.a_base(nxt) : cA; const char* nB = has_next ? S.b_base(nxt) : cB;
        if constexpr (GATHER) { if (has_next) { PG8_AOFFS(an, nxt); *anp = (u32x4){an[0][0], an[0][1], an[1][0], an[1][1]}; } else { *anp = (u32x4){ac[0][0], ac[0][1], ac[1][0], ac[1][1]}; } }
        for (int t = 0; t < nt; t += 2) {
            const bool last = (t == nt - 2);
            if constexpr (MIDK) { if (t == Epi::MIDK_T) { int fr_e = fr, fq_e = fq; asm volatile("" : "+v"(fr_e), "+v"(fq_e)); E.midk(acc, cur, wr, fr_e, fq_e); } }
            const char* a1 = cA + (size_t)(t + 1) * kstep;
            const char* a2 = last ? nA : cA + (size_t)(t + 2) * kstep; const char* b2 = last ? nB : cB + (size_t)(t + 2) * kstep;
            const char* a3 = a2 + kstep; const char* b3 = b2 + kstep;
            unsigned o00 = ac[0][0], o01 = ac[0][1], o10 = ac[1][0], o11 = ac[1][1];
            if constexpr (GATHER) { if (last) { const u32x4 q_ = *anp; o00 = q_.x; o01 = q_.y; o10 = q_.z; o11 = q_.w; an[0][0] = q_.x; an[0][1] = q_.y; an[1][0] = q_.z; an[1][1] = q_.w; } }
            PG8_LDB(B0, 0, 0); PG8_LDB(B1, 0, 1); PG8_SCHED; PG8_LDA(At, 0, 0); PG8_STAGE_A(PG8_SA(1, 1), a1, 1, ac[1][0], ac[1][1]);
            PG8_WAIT_V(8); PG8_WAIT_L(0); PG8_BAR; PG8_MMA(0, 0, At, B0); PG8_MMA(0, 1, At, B1); PG8_BAR; PG8_SCHED;
            PG8_LDA(At, 0, 1); PG8_STAGE(PG8_SB(0, 0), b2, voffB); PG8_STAGE(PG8_SB(0, 1), b2 + hstep, voffB); PG8_STAGE_A(PG8_SA(0, 0), a2, 0, o00, o01);
            PG8_WAIT_V(8); PG8_WAIT_L(0); PG8_BAR; PG8_MMA(1, 0, At, B0); PG8_MMA(1, 1, At, B1); PG8_BAR; PG8_SCHED;
            PG8_LDB(B0, 1, 0); PG8_LDB(B1, 1, 1); PG8_SCHED; PG8_LDA(At, 1, 0); PG8_STAGE_A(PG8_SA(0, 1), a2, 1, o10, o11);
            PG8_WAIT_V(8); PG8_WAIT_L(0); PG8_BAR; PG8_MMA(0, 0, At, B0); PG8_MMA(0, 1, At, B1); PG8_BAR; PG8_SCHED;
            PG8_LDA(At, 1, 1); PG8_STAGE(PG8_SB(1, 0), b3, voffB); PG8_STAGE(PG8_SB(1, 1), b3 + hstep, voffB); PG8_STAGE_A(PG8_SA(1, 0), a3, 0, o00, o01);
            PG8_WAIT_V(8); PG8_WAIT_L(0); PG8_BAR; PG8_MMA(1, 0, At, B0); PG8_MMA(1, 1, At, B1); PG8_BAR; PG8_SCHED;
        }
        if (wr == 0) PG8_BAR;
        { int fr_e = fr, fq_e = fq; asm volatile("" : "+v"(fr_e), "+v"(fq_e)); E(acc, cur, wr, wc, fr_e, fq_e); }
        if (!has_next) break;
#pragma unroll
        for (int a = 0; a < 2; ++a)
#pragma unroll
            for (int b = 0; b < 2; ++b)
#pragma unroll
                for (int m = 0; m < 4; ++m)
#pragma unroll
                    for (int n = 0; n < 2; ++n) acc[a][b][m][n] = (f32x4){0.f, 0.f, 0.f, 0.f};
        cur = nxt; cA = nA; cB = nB; ++ui;
        if constexpr (GATHER) {
#pragma unroll
            for (int _h = 0; _h < 2; ++_h)
#pragma unroll
                for (int _i = 0; _i < 2; ++_i) ac[_h][_i] = an[_h][_i];
        }
        if (wr == 1) PG8_BAR;
    }
    PG8_WAIT_V(0);
    PG8_BAR;
#undef PG8_SA
#undef PG8_SB
#undef PG8_STAGE
#undef PG8_STAGE2
#undef PG8_LDA
#undef PG8_LDB
#undef PG8_MMA
#undef PG8_WAIT_V
#undef PG8_WAIT_L
#undef PG8_BAR
#undef PG8_SCHED
#undef PG8_AOFFS
#undef PG8_STAGE_A
}
}
namespace attn_body {
using bf16=__hip_bfloat16;
using bf16x8=__attribute__((ext_vector_type(8)))short;
using s16x4=__attribute__((ext_vector_type(4)))short;
using f32x16=__attribute__((ext_vector_type(16)))float;
using u32x4=__attribute__((ext_vector_type(4)))unsigned;
constexpr int BATCH=8,NHEAD=8,SEQ=4096,D=64,DM=NHEAD*D,ODM=1024;
constexpr int NW=8,QBLK=32,QB=QBLK*NW,KVBLK=64,NQB=SEQ/QB;
constexpr int ATTN_PITCH=DM, ATTN_UNIT_ROWS=QB;
__device__ __forceinline__ int crow(int r,int hi){return (r&3)+8*(r>>2)+4*hi;}
#define SBAR() __builtin_amdgcn_sched_barrier(0)
__device__ __forceinline__ void cmask(f32x16&p0,f32x16&p1,int jb,int qrel,int hi){
  const float NEG=-INFINITY; int kb=64*jb+4*hi;
  #pragma unroll
  for(int r=0;r<16;++r){int kv=kb+(r&3)+8*(r>>2); if(kv>qrel)p0[r]=NEG; if(kv+32>qrel)p1[r]=NEG;}
}

constexpr int NSLOT=3, SLOTB=8192;
constexpr int LDS_K=0, LDS_V=NSLOT*SLOTB, LDS_WS=2*NSLOT*SLOTB, LDS_OST=LDS_WS+NW*64*4, LDS_KX=86016, LDS_BYTES=LDS_KX+SEQ*8;
constexpr float C2=0.125f*1.4426950408889634f;
__device__ __forceinline__ void glds16(const void*gsrc,unsigned lds_dst){unsigned keep;
  asm volatile("s_mov_b32 %0, m0\n\ts_mov_b32 m0, %2\n\ts_nop 0\n\tglobal_load_lds_dwordx4 %1, off\n\ts_mov_b32 m0, %0":"=&s"(keep):"v"(gsrc),"s"(lds_dst):"memory");}
__device__ __forceinline__ float max3f(float a,float b,float c){float r;asm("v_max3_f32 %0, %1, %2, %3":"=v"(r):"v"(a),"v"(b),"v"(c));return r;}
__device__ __forceinline__ float max2f(float a,float b){float r;asm("v_max_f32_e32 %0, %1, %2":"=v"(r):"v"(a),"v"(b));return r;}
__device__ __forceinline__ float fadd_s(float a,float b){float r;asm("v_add_f32_e32 %0, %1, %2":"=v"(r):"v"(a),"v"(b));return r;}
__device__ __forceinline__ float fsub_s(float a,float b){float r;asm("v_sub_f32_e32 %0, %1, %2":"=v"(r):"v"(a),"v"(b));return r;}
typedef float f32x2_t __attribute__((ext_vector_type(2))); typedef __bf16 bf16x2_t __attribute__((ext_vector_type(2)));
__device__ __forceinline__ unsigned cvtpk_s(float lo,float hi){f32x2_t v={lo,hi};bf16x2_t b=__builtin_convertvector(v,bf16x2_t);return __builtin_bit_cast(unsigned,b);}
#define WAIT_BAR(N) asm volatile("s_waitcnt vmcnt(" #N ") lgkmcnt(0)\n\ts_barrier":::"memory")


typedef unsigned kx2_t __attribute__((ext_vector_type(2)));
__device__ __forceinline__ unsigned f2bf_(float f){unsigned u=__builtin_bit_cast(unsigned,f);return (u+0x7fffu+((u>>16)&1u))>>16;}
__device__ __forceinline__ float bf2f_(unsigned h){return __builtin_bit_cast(float,h<<16);}
__device__ __forceinline__ bf16x8 mk_qx(float mhat,int hi){ const float nm=-mhat; const unsigned h=f2bf_(nm); const float r1=nm-bf2f_(h); const unsigned m=f2bf_(r1); const float r2=r1-bf2f_(m); const unsigned l=f2bf_(r2);
  u32x4 w; w.x=hi?0u:0x3F803F80u; w.y=hi?0u:(0x3F80u|(h<<16)); w.z=hi?0u:(m|(l<<16)); w.w=0u; return __builtin_bit_cast(bf16x8,w); }
__device__ __forceinline__ bf16x8 mk_kx(kx2_t k,int hi){ (void)hi; u32x4 w; w.x=k.x; w.y=k.y; w.z=0x3F803F80u; w.w=0u; return __builtin_bit_cast(bf16x8,w); }
__device__ __forceinline__ void qkt(f32x16&p0,f32x16&p1,const char*Kslot,const bf16x8*qr,const bf16x8 qx,const bf16x8 kxa,const bf16x8 kxb,int r32,int hi){
  p0=__builtin_amdgcn_mfma_f32_32x32x16_bf16(kxa,qx,f32x16{},0,0,0);p1=__builtin_amdgcn_mfma_f32_32x32x16_bf16(kxb,qx,f32x16{},0,0,0);
  const char*kb=Kslot+hi*1024+r32*16;
  #pragma unroll
  for(int d0=0;d0<4;++d0){
    const bf16x8 b0=*reinterpret_cast<const bf16x8*>(kb+d0*2048);
    const bf16x8 b1=*reinterpret_cast<const bf16x8*>(kb+d0*2048+512);
    p0=__builtin_amdgcn_mfma_f32_32x32x16_bf16(b0,qr[d0],p0,0,0,0);p1=__builtin_amdgcn_mfma_f32_32x32x16_bf16(b1,qr[d0],p1,0,0,0);}
}
typedef __attribute__((address_space(3))) const char* lds_cptr;
typedef short v4i16_t __attribute__((ext_vector_type(4)));
__device__ __forceinline__ void kload8(bf16x8*kf,lds_cptr kp){
  kf[0]=*(const __attribute__((address_space(3))) bf16x8*)(kp);      kf[1]=*(const __attribute__((address_space(3))) bf16x8*)(kp+512);
  kf[2]=*(const __attribute__((address_space(3))) bf16x8*)(kp+2048); kf[3]=*(const __attribute__((address_space(3))) bf16x8*)(kp+2560);
  kf[4]=*(const __attribute__((address_space(3))) bf16x8*)(kp+4096); kf[5]=*(const __attribute__((address_space(3))) bf16x8*)(kp+4608);
  kf[6]=*(const __attribute__((address_space(3))) bf16x8*)(kp+6144); kf[7]=*(const __attribute__((address_space(3))) bf16x8*)(kp+6656);
}
__device__ __forceinline__ void kload2(bf16x8*kf,lds_cptr kp,int j){ kf[2*j]=*(const __attribute__((address_space(3))) bf16x8*)(kp+j*2048); kf[2*j+1]=*(const __attribute__((address_space(3))) bf16x8*)(kp+j*2048+512); }
__device__ __forceinline__ s16x4 vtr(lds_cptr p){ return __builtin_bit_cast(s16x4,__builtin_amdgcn_ds_read_tr16_b64_v4i16((__attribute__((address_space(3))) v4i16_t*)p)); }
__device__ __forceinline__ float rowmax(const f32x16&p0,const f32x16&p1){
  float a=max3f(p0[0],p0[1],p1[0]),b=max3f(p0[2],p0[3],p1[1]);a=max3f(a,p1[2],p1[3]);
  #pragma unroll
  for(int r=4;r<16;r+=4){a=max3f(a,p0[r],p0[r+1]);b=max3f(b,p0[r+2],p0[r+3]);a=max3f(a,p1[r],p1[r+1]);b=max3f(b,p1[r+2],p1[r+3]);}
  const float m=max2f(a,b);
  auto rr=__builtin_amdgcn_permlane32_swap(__float_as_uint(m),__float_as_uint(m),false,false);
  return max2f(__uint_as_float(rr[0]),__uint_as_float(rr[1]));
}
__device__ __forceinline__ void pv(f32x16*o,int vb,bf16x8 pa0,bf16x8 pa1,bf16x8 pa2,bf16x8 pa3){
  #pragma unroll
  for(int d0=0;d0<2;++d0){s16x4 lo[4],hi[4];
    #pragma unroll
    for(int ks=0;ks<4;++ks){
      asm volatile("ds_read_b64_tr_b16 %0,%1 offset:%c2":"=&v"(lo[ks]):"v"(vb),"i"(d0*4096+ks*1024):"memory");
      asm volatile("ds_read_b64_tr_b16 %0,%1 offset:%c2":"=&v"(hi[ks]):"v"(vb),"i"(d0*4096+ks*1024+512):"memory");}
    asm volatile("s_waitcnt lgkmcnt(0)":::"memory");SBAR();
    #define PK(k) (bf16x8){lo[k][0],lo[k][1],lo[k][2],lo[k][3],hi[k][0],hi[k][1],hi[k][2],hi[k][3]}
    o[d0]=__builtin_amdgcn_mfma_f32_32x32x16_bf16(pa0,PK(0),o[d0],0,0,0);
    o[d0]=__builtin_amdgcn_mfma_f32_32x32x16_bf16(pa1,PK(1),o[d0],0,0,0);
    o[d0]=__builtin_amdgcn_mfma_f32_32x32x16_bf16(pa2,PK(2),o[d0],0,0,0);
    o[d0]=__builtin_amdgcn_mfma_f32_32x32x16_bf16(pa3,PK(3),o[d0],0,0,0);
    #undef PK
  }
}

#ifndef ATTN_STORE16
#define ATTN_STORE16(p,v) (*(u32x4*)(p)=(v))
#endif
template<int THRL> __device__ __forceinline__ void attn_unit(int b,int h,int qb,const bf16*Q,const bf16*__restrict__ K,const bf16*__restrict__ V,bf16*O,float*OSS,char*shm,const int tid_in){
  int tid_=tid_in; asm volatile("":"+v"(tid_)); const int tid=tid_,lane=tid&63,r32=lane&31,hi=lane>>5; const int wid=__builtin_amdgcn_readfirstlane(tid>>6);
  const long rowbase=(long)b*SEQ; const int q0=qb*QB;
  const bf16*Qw=Q+(rowbase+q0+wid*QBLK)*DM+h*D;
  const bf16*Kh=K+rowbase*DM+h*D,*Vh=V+rowbase*DM+h*D;
  const unsigned lds0=(unsigned)(uintptr_t)shm;
  float*wsf=(float*)(shm+LDS_WS)+wid*64;
  const bf16*ksrc=Kh+(long)lane*DM+wid*8;
  const bf16*vsrc=Vh+(long)(16*(wid&3)+(lane>>2))*DM+(wid>>2)*32+(lane&3)*8;
  const unsigned kdst=lds0+LDS_K+wid*1024, vdst=lds0+LDS_V+wid*1024;
  #define DMA_K(t,slot) glds16(ksrc+(long)(t)*KVBLK*DM,(unsigned)__builtin_amdgcn_readfirstlane(kdst+(slot)))
  #define DMA_V(t,slot) glds16(vsrc+(long)(t)*KVBLK*DM,(unsigned)__builtin_amdgcn_readfirstlane(vdst+(slot)))
  const int vb0=(int)(lds0+LDS_V)+((lane>>4)&1)*32+(lane&3)*8+(4*hi+((lane&15)>>2))*64;
  const char*Kbase=shm+LDS_K; bf16x8 kf[8];
  const lds_cptr shm3=(lds_cptr)shm; const lds_cptr kp0=shm3+LDS_K+hi*1024+r32*16; const lds_cptr vp0=shm3+LDS_V+((lane>>4)&1)*32+(lane&3)*8+(4*hi+((lane&15)>>2))*64;
  const int NT=(q0+QB)/KVBLK;
  DMA_K(0,0);DMA_V(0,0);DMA_K(1,SLOTB);
  bf16x8 qr[4];
  #pragma unroll
  for(int d0=0;d0<4;++d0)qr[d0]=*reinterpret_cast<const bf16x8*>(&Qw[(long)r32*DM+d0*16+hi*8]);
  float mhat=0.f,l_reg=0.f;f32x16 o[2];o[0]=f32x16{};o[1]=f32x16{};bf16x8 qx=mk_qx(0.f,hi);asm volatile("":"+v"(qx));
  const __attribute__((address_space(3))) kx2_t*kxt=(const __attribute__((address_space(3))) kx2_t*)(shm3+LDS_KX)+r32;
  const int qrel=wid*QBLK+r32;
  #define CMASK(P0,P1,t) do{int jb_=(t)-(NT-4); if(jb_>=0)cmask(P0,P1,jb_,qrel,hi);}while(0)
  bool resc=false;
  #define START(P0,P1) do{ const float rm=rowmax(P0,P1); resc=false; \
    { const float dl=rm; mhat=fadd_s(mhat,dl); \
      _Pragma("unroll") for(int r=0;r<16;++r){P0[r]=fsub_s(P0[r],dl);P1[r]=fsub_s(P1[r],dl);} \
      qx=mk_qx(mhat,hi); asm volatile("":"+v"(qx)); } \
    _Pragma("unroll") for(int r=0;r<16;++r)P0[r]=__builtin_amdgcn_exp2f(P0[r]); }while(0)
  #define RESC() do{ if(resc){ asm volatile("s_waitcnt lgkmcnt(0)":::"memory"); \
      _Pragma("unroll") for(int d_=0;d_<2;++d_) _Pragma("unroll") for(int r=0;r<16;++r)o[d_][r]*=wsf[crow(r,hi)]; } }while(0)
  f32x16 pA0,pA1,pB0,pB1;
  int sl_prev=0,sl_cur=0,sl_next=SLOTB;
  #define ROT() do{sl_prev=sl_cur;sl_cur=sl_next;sl_next=(sl_next==(NSLOT-1)*SLOTB)?0:sl_next+SLOTB;}while(0)
  DMA_K(2,2*SLOTB);
  WAIT_BAR(3);
  {const kx2_t ka_=kxt[0],kb_=kxt[32]; qkt(pA0,pA1,Kbase,qr,qx,mk_kx(ka_,hi),mk_kx(kb_,hi),r32,hi);}asm volatile("s_nop 15\n\ts_nop 7":"+v"(pA0),"+v"(pA1));CMASK(pA0,pA1,0);
  START(pA0,pA1);
  _Pragma("unroll") for(int r=0;r<16;++r)pA1[r]=__builtin_amdgcn_exp2f(pA1[r]);
  WAIT_BAR(0);
  DMA_K(3,0);DMA_V(1,SLOTB);
  ROT();
  kload8(kf,kp0+sl_cur);
  WAIT_BAR(2);
  s16x4 vlo[8],vhi[8]; u32x4 pw0,pw1,pw2,pw3;
  #define PKW(P,B) cvtpk_s(P[B],P[B+1])
  #define PAF(k) __builtin_bit_cast(bf16x8,pw##k)
  #define VFR(i) (bf16x8){vlo[i][0],vlo[i][1],vlo[i][2],vlo[i][3],vhi[i][0],vhi[i][1],vhi[i][2],vhi[i][3]}
  #define PIN(x) asm volatile("":"+v"(x))
  #define MX3(a,b,c) __builtin_fmaxf(__builtin_fmaxf((a),(b)),(c))
  #define GAPA(MF,A0,A1,A2,A3,W0,W1,PW) do{ MF; sacc+=A0; sacc+=A1; sacc+=A2; sacc+=A3; PIN(sacc); W0; W1; PIN(PW); SBAR(); }while(0)
  #define EX(v) __builtin_amdgcn_exp2f(v)
  #define GAPB(MF,X,B) do{ MF; X[B]=EX(X[B]); X[B+1]=EX(X[B+1]); X[B+2]=EX(X[B+2]); X[B+3]=EX(X[B+3]); PIN(X); SBAR(); }while(0)
  #define VRD(i) do{ vlo[i]=vtr(vp_+(((i)>>2)*4096+((i)&3)*1024)); vhi[i]=vtr(vp_+(((i)>>2)*4096+((i)&3)*1024+512)); }while(0)
  #define KRD(G,j) do{ if(G){ kload2(kf,kp0+sl_next,j); SBAR(); } }while(0)
  #define STEP(C0,C1,P0,P1,t,GK,GV,GL) do{ SBAR(); \
    const lds_cptr vp_=vp0+sl_prev; \
    { const kx2_t ka_=kxt[64*(t)],kb_=kxt[64*(t)+32]; C0=__builtin_amdgcn_mfma_f32_32x32x16_bf16(mk_kx(ka_,hi),qx,f32x16{},0,0,0); C1=__builtin_amdgcn_mfma_f32_32x32x16_bf16(mk_kx(kb_,hi),qx,f32x16{},0,0,0); } SBAR(); \
    VRD(0); SBAR(); float sacc=(P0[0]+P0[1]); \
    GAPA(C0=__builtin_amdgcn_mfma_f32_32x32x16_bf16(kf[0],qr[0],C0,0,0,0), P0[2],P0[3],P0[4],P0[5],     pw0[0]=PKW(P0,0), pw0[1]=PKW(P0,2), pw0); \
    VRD(4); SBAR(); GAPA(C1=__builtin_amdgcn_mfma_f32_32x32x16_bf16(kf[1],qr[0],C1,0,0,0), P0[6],P0[7],P0[8],P0[9],     pw0[2]=PKW(P0,4), pw0[3]=PKW(P0,6), pw0); \
    VRD(1); SBAR(); GAPA(C0=__builtin_amdgcn_mfma_f32_32x32x16_bf16(kf[2],qr[1],C0,0,0,0),   P0[10],P0[11],P0[12],P0[13], pw1[0]=PKW(P0,8), pw1[1]=PKW(P0,10), pw1); \
    VRD(5); SBAR(); GAPA(C1=__builtin_amdgcn_mfma_f32_32x32x16_bf16(kf[3],qr[1],C1,0,0,0),   P0[14],P0[15],P1[0],P1[1],   pw1[2]=PKW(P0,12),pw1[3]=PKW(P0,14), pw1); \
    VRD(2); SBAR(); GAPA(C0=__builtin_amdgcn_mfma_f32_32x32x16_bf16(kf[4],qr[2],C0,0,0,0),   P1[2],P1[3],P1[4],P1[5],     pw2[0]=PKW(P1,0), pw2[1]=PKW(P1,2), pw2); \
    VRD(6); SBAR(); GAPA(C1=__builtin_amdgcn_mfma_f32_32x32x16_bf16(kf[5],qr[2],C1,0,0,0),   P1[6],P1[7],P1[8],P1[9],     pw2[2]=PKW(P1,4), pw2[3]=PKW(P1,6), pw2); \
    VRD(3); SBAR(); GAPA(C0=__builtin_amdgcn_mfma_f32_32x32x16_bf16(kf[6],qr[3],C0,0,0,0),   P1[10],P1[11],P1[12],P1[13], pw3[0]=PKW(P1,8), pw3[1]=PKW(P1,10), pw3); \
    VRD(7); SBAR(); GAPA(C1=__builtin_amdgcn_mfma_f32_32x32x16_bf16(kf[7],qr[3],C1,0,0,0),   P1[14],P1[15],0.f,0.f,       pw3[2]=PKW(P1,12),pw3[3]=PKW(P1,14), pw3); \
    l_reg+=sacc; \
    if(GK){DMA_K((t)+3,sl_cur);} if(GV){DMA_V((t)+1,sl_next);} \
    CMASK(C0,C1,t); \
    { float a=MX3(C0[0],C0[1],C1[0]),b=MX3(C0[2],C0[3],C1[1]); a=MX3(a,C1[2],C1[3]); \
      _Pragma("unroll") for(int r=4;r<16;r+=4){a=MX3(a,C0[r],C0[r+1]);b=MX3(b,C0[r+2],C0[r+3]);a=MX3(a,C1[r],C1[r+1]);b=MX3(b,C1[r+2],C1[r+3]);} \
      float rm=__builtin_fmaxf(a,b); { auto rr=__builtin_amdgcn_permlane32_swap(__float_as_uint(rm),__float_as_uint(rm),false,false); rm=__builtin_fmaxf(__uint_as_float(rr[0]),__uint_as_float(rr[1])); } \
      resc=false; \
      if(__builtin_expect(__any(rm>(float)THRL),0)){ const float dl=__builtin_fmaxf(rm,0.f); mhat+=dl; \
        _Pragma("unroll") for(int r=0;r<16;++r){C0[r]-=dl;C1[r]-=dl;} \
        qx=mk_qx(mhat,hi); asm volatile("":"+v"(qx)); \
        const float f=__builtin_amdgcn_exp2f(-dl); l_reg*=f; if(hi==0)wsf[r32]=f; resc=true; } } \
    SBAR(); \
    GAPB(o[0]=__builtin_amdgcn_mfma_f32_32x32x16_bf16(PAF(0),VFR(0),o[0],0,0,0), C0,0); \
    GAPB(o[1]=__builtin_amdgcn_mfma_f32_32x32x16_bf16(PAF(0),VFR(4),o[1],0,0,0), C0,4); \
    KRD(GL,0); GAPB(o[0]=__builtin_amdgcn_mfma_f32_32x32x16_bf16(PAF(1),VFR(1),o[0],0,0,0), C0,8); \
    KRD(GL,1); GAPB(o[1]=__builtin_amdgcn_mfma_f32_32x32x16_bf16(PAF(1),VFR(5),o[1],0,0,0), C0,12); \
    KRD(GL,2); GAPB(o[0]=__builtin_amdgcn_mfma_f32_32x32x16_bf16(PAF(2),VFR(2),o[0],0,0,0), C1,0); \
    KRD(GL,3); GAPB(o[1]=__builtin_amdgcn_mfma_f32_32x32x16_bf16(PAF(2),VFR(6),o[1],0,0,0), C1,4); \
    GAPB(o[0]=__builtin_amdgcn_mfma_f32_32x32x16_bf16(PAF(3),VFR(3),o[0],0,0,0), C1,8); \
    GAPB(o[1]=__builtin_amdgcn_mfma_f32_32x32x16_bf16(PAF(3),VFR(7),o[1],0,0,0), C1,12); \
    }while(0)
  int t=1;
  #undef CMASK
  #define CMASK(P0,P1,t) do{}while(0)
  for(;t+5<NT;t+=2){
    STEP(pB0,pB1,pA0,pA1,t,true,true,true);     WAIT_BAR(2); RESC(); ROT();
    STEP(pA0,pA1,pB0,pB1,t+1,true,true,true);   WAIT_BAR(2); RESC(); ROT();
  }
  #undef CMASK
  #define CMASK(P0,P1,t) do{int jb_=(t)-(NT-4); if(jb_>=0)cmask(P0,P1,jb_,qrel,hi);}while(0)
  #define ENDW(tt) do{ if((tt)+3<NT){WAIT_BAR(2);} else if((tt)+2<NT){WAIT_BAR(1);} else {WAIT_BAR(0);} }while(0)
  for(;t+1<NT;t+=2){
    STEP(pB0,pB1,pA0,pA1,t,(t+3<NT),(t+1<NT),(t+1<NT));       ENDW(t);   RESC(); ROT();
    STEP(pA0,pA1,pB0,pB1,t+1,(t+4<NT),(t+2<NT),(t+2<NT));     ENDW(t+1); RESC(); ROT();
  }
  STEP(pB0,pB1,pA0,pA1,NT-1,false,false,false); RESC();
  { float sacc=pB0[0]+pB0[1]; _Pragma("unroll") for(int r=2;r<16;++r)sacc+=pB0[r]; _Pragma("unroll") for(int r=0;r<16;++r)sacc+=pB1[r]; l_reg+=sacc;
    pw0=(u32x4){PKW(pB0,0),PKW(pB0,2),PKW(pB0,4),PKW(pB0,6)};pw1=(u32x4){PKW(pB0,8),PKW(pB0,10),PKW(pB0,12),PKW(pB0,14)};pw2=(u32x4){PKW(pB1,0),PKW(pB1,2),PKW(pB1,4),PKW(pB1,6)};pw3=(u32x4){PKW(pB1,8),PKW(pB1,10),PKW(pB1,12),PKW(pB1,14)};
    SBAR(); pv(o,vb0+sl_cur,PAF(0),PAF(1),PAF(2),PAF(3)); }
  #undef PKW
  #undef PAF
  #undef VFR
  #undef PIN
  #undef MX3
  #undef GAPA
  #undef GAPB
  #undef EX
  #undef VRD
  #undef KRD
  #undef STEP
  #undef ENDW
  {auto rr=__builtin_amdgcn_permlane32_swap(__float_as_uint(l_reg),__float_as_uint(l_reg),false,false);l_reg=__uint_as_float(rr[0])+__uint_as_float(rr[1]);}
  if(hi==0)wsf[32+r32]=l_reg;asm volatile("s_waitcnt lgkmcnt(0)":::"memory");
  float rli[16];
  #pragma unroll
  for(int r=0;r<16;++r)rli[r]=__builtin_amdgcn_rcpf(wsf[32+crow(r,hi)]);
  bf16*Ow=O+(rowbase+q0+wid*QBLK)*ODM+h*D; float*OSw=OSS+(rowbase+q0+wid*QBLK)*NHEAD+h;
  { bf16*stg=(bf16*)(shm+LDS_OST)+wid*2048;
    #pragma unroll
    for(int r=0;r<16;++r){const int orow=crow(r,hi);
      #pragma unroll
      for(int d0=0;d0<2;++d0)stg[orow*64+d0*32+r32]=__float2bfloat16(o[d0][r]*rli[r]);}
    asm volatile("s_waitcnt lgkmcnt(0)":::"memory");
    #pragma unroll
    for(int i=0;i<4;++i){const int row=i*8+(lane>>3),ch=lane&7; const u32x4 v=*(const u32x4*)(stg+row*64+ch*8); ATTN_STORE16(Ow+(long)row*ODM+ch*8,v);
      float ss=0.f; _Pragma("unroll") for(int j=0;j<4;++j){const float a=__uint_as_float(v[j]<<16),b2=__uint_as_float(v[j]&0xffff0000u); ss+=a*a+b2*b2;}
      ss+=__int_as_float(__builtin_amdgcn_ds_bpermute((lane^1)<<2,__float_as_int(ss)));ss+=__int_as_float(__builtin_amdgcn_ds_bpermute((lane^2)<<2,__float_as_int(ss)));ss+=__int_as_float(__builtin_amdgcn_ds_bpermute((lane^4)<<2,__float_as_int(ss))); if(ch==0)OSw[(long)row*NHEAD]=ss;} }
  asm volatile("s_waitcnt lgkmcnt(0)\n\ts_barrier":::"memory");
  #undef DMA_K
  #undef DMA_V
  #undef CMASK
  #undef START
  #undef RESC
  #undef ROT
}
constexpr int ATTN_LDS_BYTES=LDS_BYTES;
struct AttnTensors { const bf16* Q; const bf16* K; const bf16* V; bf16* O; float* OSS; };
struct AttnUnit { int bh; int qb; };
struct StaticOrder {
  int vcu;
  __device__ __forceinline__ explicit StaticOrder(int v):vcu(v){}
  __device__ __forceinline__ bool next(int i,AttnUnit&u)const{ if(i>=4)return false; const int s=vcu&3; u.bh=vcu>>2; u.qb=(i==0)?s:(i==1)?15-s:(i==2)?4+s:11-s; return true; }
  __device__ __forceinline__ void a_ready(const AttnUnit&)const{}
  __device__ __forceinline__ void done(const AttnUnit&)const{}
};
template<class Sched,int THRL=8> __device__ __forceinline__ void attn_phase(char*lds,const AttnTensors&T,const Sched&S,const int tid_in){
  AttnUnit u;
  for(int i=0;S.next(i,u);++i){ S.a_ready(u); attn_unit<THRL>(u.bh/NHEAD,u.bh%NHEAD,u.qb,T.Q,T.K,T.V,T.O,T.OSS,lds,tid_in); S.done(u); }
}
#undef SBAR
#undef WAIT_BAR
}
constexpr int NWAVES = 8;
constexpr int T = 32768, DM = 1024, SEQ = 4096, NBATCH = 8, NLAYER = 2, NHEADS = 8, NEXP = 32, INC = 2568, NIN = 2560, PLE = 256, MAXTILES = 544;
constexpr float EPS = 1e-5f, LOG2E = 1.4426950408889634f;
constexpr int NSTEPS = 2 + 8 * NLAYER;
#ifndef MK_PER_STEP
#define MK_PER_STEP 0
#endif

constexpr size_t MiB = 1u << 20;
constexpr size_t WS_CTL = 0, CTL_ZERO_BYTES = 1 * MiB;
constexpr size_t WS_WFB = 1 * MiB, WS_WRB = WS_WFB + 128 * 1024, WS_WSB = WS_WRB + 128 * 1024;
constexpr size_t WS_WIN = 2 * MiB, WS_WOUT = 12 * MiB, WS_WPG = 16 * MiB, WS_WPLE = 20 * MiB, WS_WGU = 32 * MiB, WS_WDN = 288 * MiB;
constexpr size_t WS_HBA = 416 * MiB, WS_HBB = 480 * MiB;
constexpr size_t WS_SSQX = 544 * MiB, WS_SSQY = 546 * MiB;
constexpr size_t WS_LF = 548 * MiB, WS_OSS = 549 * MiB, WS_RINV = 550 * MiB, WS_TOPE = 551 * MiB, WS_GATE = 551 * MiB + 512 * 1024, WS_LISTS = 552 * MiB, WS_GSS = 556 * MiB;
constexpr size_t WS_U = 560 * MiB, SEG_BYTES = 32 * MiB;
constexpr size_t WS_YC = 720 * MiB;
constexpr size_t WS_ACT = 784 * MiB, WS_YS = 1056 * MiB;
constexpr size_t WS_PB = 1328 * MiB, WS_E = 1360 * MiB, WS_END = 1488 * MiB;
constexpr int CW_BAR = 4096;
constexpr int CW_CNT = 16384;

constexpr int RING_OFF = 0, RING_BYTES = 131072;
constexpr int LDSCTL_OFF = RING_BYTES, MISC_OFF = LDSCTL_OFF + 320;
constexpr int LCNT_OFF = LDSCTL_OFF + 512, LTST_OFF = LCNT_OFF + 128, LTILES_OFF = LTST_OFF + 256;
constexpr int LDS_BYTES = 147456;
static_assert(LTILES_OFF + MAXTILES * 4 <= LDS_BYTES, "LDS map");

#define GAS __attribute__((address_space(1)))
#define LAS __attribute__((address_space(3)))
typedef unsigned short bf16;
typedef unsigned v4u __attribute__((ext_vector_type(4)));
typedef float f32x4 __attribute__((ext_vector_type(4)));
typedef short bf16x8 __attribute__((ext_vector_type(8)));
typedef GAS unsigned gu32;
typedef GAS unsigned long long gu64;
#define RLX_AGENT __ATOMIC_RELAXED, __HIP_MEMORY_SCOPE_AGENT
#define LDS_WAIT() asm volatile("s_waitcnt lgkmcnt(0)" ::: "memory")
#define VM_WAIT() asm volatile("s_waitcnt vmcnt(0)" ::: "memory")
__device__ __forceinline__ unsigned long long rt() { return __builtin_amdgcn_s_memrealtime(); }
__device__ __forceinline__ unsigned f2bf(float f) { unsigned u = __builtin_bit_cast(unsigned, f); return (u + 0x7fffu + ((u >> 16) & 1u)) >> 16; }
__device__ __forceinline__ unsigned pk2(float lo, float hi) { return f2bf(lo) | (f2bf(hi) << 16); }

#define XB_TMO      128
#define XB_XCNT(j)  (256  + 64 * (j))
#define XB_XSUB(j)  (1280 + 64 * (j))
#define XB_XGEN(j)  (2304 + 64 * (j))
#define XB_TOP      3328
#define XB_TOPGEN   3392
#define XCD_BAR_WORDS 3456
#define XB_SPIN_CAP (1u << 18)

__device__ __forceinline__ unsigned xb_ld(unsigned* p)              { return __hip_atomic_load(p, __ATOMIC_RELAXED, __HIP_MEMORY_SCOPE_AGENT); }
__device__ __forceinline__ unsigned xb_add(unsigned* p, unsigned v) { return __hip_atomic_fetch_add(p, v, __ATOMIC_RELAXED, __HIP_MEMORY_SCOPE_AGENT); }
__device__ __forceinline__ unsigned xb_xcc_id() { return (unsigned)__builtin_amdgcn_s_getreg((3 << 11) | 20) & 0xFu; }
#define XB_SPIN(cond, bar) do { unsigned _sp = 0; while (cond) { __builtin_amdgcn_s_sleep(1); \
    if ((++_sp & 255u) == 0u) { if (xb_ld(&(bar)[XB_TMO])) break; if (_sp > XB_SPIN_CAP) { atomicAdd(&(bar)[XB_TMO], 1u); break; } } } } while (0)

struct XcdBarrier {
    unsigned* bar; unsigned x;
    volatile LAS unsigned* st;
    int wave;
};

__device__ __forceinline__ XcdBarrier xcd_barrier_post(unsigned* bar, volatile LAS unsigned* st) {
    XcdBarrier b; b.bar = bar; b.x = (unsigned)__builtin_amdgcn_readfirstlane((int)xb_xcc_id()); b.st = st;     b.wave = __builtin_amdgcn_readfirstlane((int)(threadIdx.x >> 6));
    if (threadIdx.x == 0) (void)xb_add(&bar[XB_XCNT(b.x)], 1u);
    return b;
}
__device__ __forceinline__ void xcd_barrier_complete(unsigned* bar, unsigned x, unsigned& nloc, unsigned& nx) {
    const unsigned G = gridDim.x * gridDim.y * gridDim.z;
    unsigned sum, cnt, mine, sp = 0u;
    for (;;) {
        sum = 0u; cnt = 0u; mine = 0u;
#pragma unroll
        for (unsigned j = 0; j < 16; ++j) { const unsigned c = xb_ld(&bar[XB_XCNT(j)]); sum += c; cnt += (c > 0u) ? 1u : 0u; mine = (j == x) ? c : mine; }
        if (sum == G) break;
        __builtin_amdgcn_s_sleep(1);
        if ((++sp & 255u) == 0u) { if (xb_ld(&bar[XB_TMO])) break; if (sp > XB_SPIN_CAP) { atomicAdd(&bar[XB_TMO], 1u); break; } }
    }
    nloc = mine > 0u ? mine : 1u; nx = cnt > 0u ? cnt : 1u;
}

__device__ __forceinline__ void xcd_barrier(const XcdBarrier& b) {
    asm volatile("s_waitcnt vmcnt(0)" ::: "memory");
    __syncthreads();
    if (b.wave == 0 && __builtin_amdgcn_mbcnt_hi(~0u, __builtin_amdgcn_mbcnt_lo(~0u, 0u)) == 0u) {
        GAS unsigned* barg_ = (GAS unsigned*)b.bar; asm volatile("" : "+s"(barg_)); unsigned* bar = (unsigned*)barg_; unsigned bx_ = b.x; asm volatile("" : "+s"(bx_));
        __builtin_amdgcn_s_waitcnt(0);
        unsigned nloc = b.st[0], nx = b.st[1];
        if (nloc == 0u) { xcd_barrier_complete(bar, bx_, nloc, nx); b.st[0] = nloc; b.st[1] = nx; }
        const unsigned old = xb_add(&bar[XB_XSUB(bx_)], 1u);
        const unsigned gen = old / nloc;
        if (old + 1u == (gen + 1u) * nloc) {
            __builtin_amdgcn_fence(__ATOMIC_RELEASE, "agent");
            asm volatile("s_waitcnt vmcnt(0)" ::: "memory");
            const unsigned og = xb_add(&bar[XB_TOP], 1u);
            const unsigned tg = og / nx;
            if (og + 1u == (tg + 1u) * nx) xb_add(&bar[XB_TOPGEN], 1u);
            else XB_SPIN(xb_ld(&bar[XB_TOPGEN]) == tg, bar);
            __builtin_amdgcn_fence(__ATOMIC_ACQUIRE, "agent");
            xb_add(&bar[XB_XGEN(bx_)], 1u);
            asm volatile("s_waitcnt vmcnt(0)" ::: "memory");
        } else {
            XB_SPIN(xb_ld(&bar[XB_XGEN(bx_)]) == gen, bar);
            __builtin_amdgcn_fence(__ATOMIC_ACQUIRE, "agent");
            asm volatile("s_waitcnt vmcnt(0)" ::: "memory");
        }
    }
    __syncthreads();
}
struct Frame {
    LAS unsigned char* lds;
    volatile LAS unsigned* MISC;
    gu32* ctl;
    int tid, lane, wave;
    int vcu, G, bx;
    float* H; unsigned char* ws;
};
__device__ __forceinline__ int mk_tid(int wave) { int t = 64 * wave + (int)__builtin_amdgcn_mbcnt_hi(~0u, __builtin_amdgcn_mbcnt_lo(~0u, 0u)); asm volatile("" : "+v"(t)); return t; }
__device__ __forceinline__ const float* ld_inp(int k) { const GAS float* p; asm volatile("s_load_dwordx2 %0, %1, %2\n\ts_waitcnt lgkmcnt(0)" : "=s"(p) : "s"(__builtin_amdgcn_kernarg_segment_ptr()), "s"(k * 8) : "memory"); return (const float*)p; }
#define INP(k) ld_inp(k)
__device__ __forceinline__ float shx(float v, int o, int lane) { return __int_as_float(__builtin_amdgcn_ds_bpermute((lane ^ o) << 2, __float_as_int(v))); }
__device__ __forceinline__ float wave_sum(float v, int lane) {
#pragma unroll
    for (int o = 1; o < 64; o <<= 1) v += shx(v, o, lane);
    return v;
}
__device__ __forceinline__ float bf_lo(unsigned w) { return __uint_as_float(w << 16); }
__device__ __forceinline__ float bf_hi(unsigned w) { return __uint_as_float(w & 0xffff0000u); }
__device__ __forceinline__ float sigmoidf_(float x) { return __builtin_amdgcn_rcpf(1.0f + __builtin_amdgcn_exp2f(-x * LOG2E)); }

using pg8::f32x2; using pg8::u32x4; using pg8::u32x2; using pg8::bf16_t; using pg8::Unit; using pg8::cvt_pk_bf16;
__device__ __forceinline__ void rows_rinv(const float* ssq16, int rowbase, int fq, int lane, float (&rv)[2][4]) {
#pragma unroll
    for (int ai = 0; ai < 2; ++ai)
#pragma unroll
        for (int m = 0; m < 4; ++m) { const f32x4 p = *(const f32x4*)((const char*)ssq16 + ((unsigned)(rowbase + ai * 128 + m * 16) * 64u + 16u * (unsigned)fq));
            float s = (p[0] + p[1]) + (p[2] + p[3]); s += shx(s, 16, lane); s += shx(s, 32, lane); rv[ai][m] = rsqrtf(s * (1.0f / DM) + EPS); }
}
#define GP(T_, base, boff) ((T_*)((char*)(base) + (unsigned)(boff)))
#define GPC(T_, base, boff) ((const T_*)((const char*)(base) + (unsigned)(boff)))
struct EpiIn {
    static constexpr bool PERM = true;
    bf16_t* O; const float* ssq16;
    __device__ __forceinline__ void operator()(const f32x4 (&acc)[2][2][4][2], const Unit& u, int wr, int wc, int fr, int fq) const {
        const int row0 = u.pm * 256 + wr * 64 + fr, seg = u.pn >> 1;
        bf16_t* base = O + (size_t)seg * (SEG_BYTES / 2);
        const unsigned cb = (unsigned)((u.pn & 1) * 256 + wc * 32 + 8 * fq) * 2u;
        float rv[2][4]; rows_rinv(ssq16, row0, fq, fq * 16 + fr, rv);
#pragma unroll
        for (int ai = 0; ai < 2; ++ai)
#pragma unroll
            for (int m = 0; m < 4; ++m) { const unsigned ob = (unsigned)(row0 + ai * 128 + m * 16) * 1024u + cb; const float r = rv[ai][m];
#pragma unroll
                for (int bj = 0; bj < 2; ++bj) { f32x4 v0 = acc[ai][bj][m][0] * r, v1 = acc[ai][bj][m][1] * r;
                    if (seg < 2) { f32x2 a = pg8::gelu_pk((f32x2){v0[0], v0[1]}), b = pg8::gelu_pk((f32x2){v0[2], v0[3]}), c = pg8::gelu_pk((f32x2){v1[0], v1[1]}), d = pg8::gelu_pk((f32x2){v1[2], v1[3]});
                        v0 = (f32x4){a.x, a.y, b.x, b.y}; v1 = (f32x4){c.x, c.y, d.x, d.y}; }
                    else if (seg == 2) { v0 = v0 * attn_body::C2; v1 = v1 * attn_body::C2; }
                    u32x4 w; w.x = cvt_pk_bf16(v0[0], v0[1]); w.y = cvt_pk_bf16(v0[2], v0[3]); w.z = cvt_pk_bf16(v1[0], v1[1]); w.w = cvt_pk_bf16(v1[2], v1[3]);
                    *GP(u32x4, base, ob + bj * 256) = w; }
                asm volatile("" ::: "memory"); }
    }
};
struct EpiBf {
    static constexpr bool PERM = true;
    bf16_t* O; const float* bias; int bias_estride;
    __device__ __forceinline__ void operator()(const f32x4 (&acc)[2][2][4][2], const Unit& u, int wr, int wc, int fr, int fq) const {
        const int row0 = u.pm * 256 + wr * 64 + fr, col0 = u.pn * 256 + wc * 32 + 8 * fq;
        f32x4 bv[2][2];
#pragma unroll
        for (int bj = 0; bj < 2; ++bj)
#pragma unroll
            for (int n = 0; n < 2; ++n) bv[bj][n] = bias ? *GPC(f32x4, bias, (unsigned)(u.e * bias_estride + col0 + bj * 128 + 4 * n) * 4u) : (f32x4){0.f, 0.f, 0.f, 0.f};
#pragma unroll
        for (int ai = 0; ai < 2; ++ai)
#pragma unroll
            for (int m = 0; m < 4; ++m) { const unsigned ob = ((unsigned)(row0 + ai * 128 + m * 16) * 1024u + (unsigned)col0) * 2u;
#pragma unroll
                for (int bj = 0; bj < 2; ++bj) { const f32x4 v0 = acc[ai][bj][m][0] + bv[bj][0], v1 = acc[ai][bj][m][1] + bv[bj][1];
                    u32x4 w; w.x = cvt_pk_bf16(v0[0], v0[1]); w.y = cvt_pk_bf16(v0[2], v0[3]); w.z = cvt_pk_bf16(v1[0], v1[1]); w.w = cvt_pk_bf16(v1[2], v1[3]);
                    *GP(u32x4, O, ob + bj * 256) = w; } }
    }
};
struct EpiSwiglu {
    static constexpr bool PERM = true;
    bf16_t* act; const float* rinv; const int* lists; const LAS int* cnt; const float* bgu;
    __device__ __forceinline__ void operator()(const f32x4 (&acc)[2][2][4][2], const Unit& u, int wr, int wc, int fr, int fq) const {
        const int rl0 = wr * 64 + fr, col8 = u.pn * 128 + wc * 32 + 8 * fq; const int ce = cnt[u.e];
        f32x4 bg[2], bl[2];
#pragma unroll
        for (int n = 0; n < 2; ++n) { bg[n] = *GPC(f32x4, bgu, (unsigned)(u.e * 2048 + col8 + 4 * n) * 4u); bl[n] = *GPC(f32x4, bgu, (unsigned)(u.e * 2048 + 1024 + col8 + 4 * n) * 4u); }
#pragma unroll
        for (int ai = 0; ai < 2; ++ai)
#pragma unroll
            for (int m = 0; m < 4; ++m) { const int rl = rl0 + ai * 128 + m * 16, rr = u.mt * 256 + rl; const int tok = (rr < ce) ? *GPC(int, lists, (unsigned)(u.e * 32768 + rr) * 4u) : 0; const float r = *GPC(float, rinv, (unsigned)tok * 4u);
                u32x4 w; unsigned wv[4];
#pragma unroll
                for (int n = 0; n < 2; ++n) { float a[4];
#pragma unroll
                    for (int i = 0; i < 4; ++i) { float g = acc[ai][0][m][n][i] * r + bg[n][i], li = acc[ai][1][m][n][i] * r + bl[n][i];
                        g = fminf(g, 7.0f); li = fminf(fmaxf(li, -7.0f), 7.0f); a[i] = g * sigmoidf_(1.702f * g) * (li + 1.0f); }
                    wv[2 * n] = cvt_pk_bf16(a[0], a[1]); wv[2 * n + 1] = cvt_pk_bf16(a[2], a[3]); }
                w.x = wv[0]; w.y = wv[1]; w.z = wv[2]; w.w = wv[3];
                *GP(u32x4, act, ((unsigned)(u.pm * 256 + rl) * 1024u + (unsigned)col8) * 2u) = w;
                asm volatile("" ::: "memory"); }
    }
};
struct EpiRes {
    static constexpr bool PERM = false; static constexpr int MIDK_T = 8;
    const float* res; float* hout; bf16_t* hb; float* ssq16; const float* oss; const float* gss;
    __device__ __forceinline__ void midk(f32x4 (&acc)[2][2][4][2], const Unit& u, int wr, int fr, int fq) const {
#pragma unroll
        for (int ai = 0; ai < 2; ++ai)
#pragma unroll
            for (int m = 0; m < 4; ++m) { const unsigned row = (unsigned)(u.pm * 256 + ai * 128 + wr * 64 + m * 16 + fr);
                const f32x2 a = *GPC(f32x2, oss, row * 32u + 8u * fq); float s = a[0] + a[1]; s += shx(s, 16, fq * 16 + fr); s += shx(s, 32, fq * 16 + fr);
                const float f = rsqrtf(s * (1.0f / 512.0f) + EPS) * sqrtf(*GPC(float, gss, row * 4u) * (1.0f / 512.0f) + EPS);
#pragma unroll
                for (int bj = 0; bj < 2; ++bj)
#pragma unroll
                    for (int n = 0; n < 2; ++n) acc[ai][bj][m][n] = acc[ai][bj][m][n] * f;
                asm volatile("" ::: "memory"); }
    }
    __device__ __forceinline__ void operator()(const f32x4 (&acc)[2][2][4][2], const Unit& u, int wr, int wc, int fr, int fq) const {
        const int col0 = u.pn * 256 + wc * 32 + 4 * fq;
#pragma unroll
        for (int ai = 0; ai < 2; ++ai)
#pragma unroll
            for (int m = 0; m < 4; ++m) { const unsigned row = (unsigned)(u.pm * 256 + ai * 128 + wr * 64 + m * 16 + fr); const unsigned ob = (row * 1024u + (unsigned)col0) * 4u; float ss = 0.f;
                const float ra = rsqrtf(*GPC(float, gss, row * 4u) * (1.0f / 512.0f) + EPS);
#pragma unroll
                for (int bj = 0; bj < 2; ++bj)
#pragma unroll
                    for (int n = 0; n < 2; ++n) { const unsigned o4 = ob + (unsigned)(bj * 128 + n * 16) * 4u; const f32x4 r = *GPC(f32x4, res, o4); const f32x4 o = r + acc[ai][bj][m][n] * ra;
                        *GP(f32x4, hout, o4) = o; u32x2 w; w.x = cvt_pk_bf16(o[0], o[1]); w.y = cvt_pk_bf16(o[2], o[3]); *GP(u32x2, hb, o4 >> 1) = w;
                        ss += (o[0] * o[0] + o[1] * o[1]) + (o[2] * o[2] + o[3] * o[3]); }
                ss += shx(ss, 16, fq * 16 + fr); ss += shx(ss, 32, fq * 16 + fr);
                if (fq == 0) *GP(float, ssq16, (row * 16u + (unsigned)(u.pn * 4 + wc)) * 4u) = ss;
                asm volatile("" ::: "memory"); }
    }
};
struct EpiPle {
    static constexpr bool PERM = false;
    float* h; bf16_t* hb; float* ssq_out; const float* ssq_in; const bf16_t* eb;
    __device__ __forceinline__ void operator()(const f32x4 (&acc)[2][2][4][2], const Unit& u, int wr, int wc, int fr, int fq) const {
        const int col0 = u.pn * 256 + wc * 32 + 4 * fq, row0 = u.pm * 256 + wr * 64 + fr;
        float rv[2][4]; rows_rinv(ssq_in, row0, fq, fq * 16 + fr, rv);
#pragma unroll
        for (int ai = 0; ai < 2; ++ai)
#pragma unroll
            for (int m = 0; m < 4; ++m) { const unsigned row = (unsigned)(row0 + ai * 128 + m * 16); const unsigned ob = (row * 1024u + (unsigned)col0) * 4u; float ss = 0.f; const float rr = rv[ai][m];
#pragma unroll
                for (int bj = 0; bj < 2; ++bj)
#pragma unroll
                    for (int n = 0; n < 2; ++n) { const unsigned o4 = ob + (unsigned)(bj * 128 + n * 16) * 4u; const f32x4 r = *GPC(f32x4, h, o4); const u32x2 ev = *GPC(u32x2, eb, o4 >> 1);
                        const f32x4 a = acc[ai][bj][m][n] * rr; f32x4 o;
                        o[0] = r[0] + sigmoidf_(a[0]) * bf_lo(ev.x); o[1] = r[1] + sigmoidf_(a[1]) * bf_hi(ev.x); o[2] = r[2] + sigmoidf_(a[2]) * bf_lo(ev.y); o[3] = r[3] + sigmoidf_(a[3]) * bf_hi(ev.y);
                        *GP(f32x4, h, o4) = o; u32x2 w; w.x = cvt_pk_bf16(o[0], o[1]); w.y = cvt_pk_bf16(o[2], o[3]); *GP(u32x2, hb, o4 >> 1) = w;
                        ss += (o[0] * o[0] + o[1] * o[1]) + (o[2] * o[2] + o[3] * o[3]); }
                ss += shx(ss, 16, fq * 16 + fr); ss += shx(ss, 32, fq * 16 + fr);
                if (fq == 0) *GP(float, ssq_out, (row * 16u + (unsigned)(u.pn * 4 + wc)) * 4u) = ss;
                asm volatile("" ::: "memory"); }
    }
};

__device__ __forceinline__ void tr_item(const float* W, int ldn, int KT, bf16* WT, int k0, int n0, int krow0, int nrow0, const float* g0, const float* g1, int gsplit, LAS float* scr, int lane) {
#pragma unroll 8
    for (int i = 0; i < 32; ++i) { const int kk = 2 * i + (lane >> 5), k = k0 + kk; const float gv = g0 ? (k < gsplit ? g0[k] : g1[k - gsplit]) : 1.0f;
        scr[kk * 33 + (lane & 31)] = W[(size_t)k * ldn + n0 + (lane & 31)] * gv; }
    LDS_WAIT(); asm volatile("" ::: "memory");
    const int c = lane & 7;
#pragma unroll
    for (int j = 0; j < 4; ++j) { const int n = (lane >> 3) + 8 * j; const LAS float* s = scr + (8 * c) * 33 + n;
        v4u o; o.x = pk2(s[0 * 33], s[1 * 33]); o.y = pk2(s[2 * 33], s[3 * 33]); o.z = pk2(s[4 * 33], s[5 * 33]); o.w = pk2(s[6 * 33], s[7 * 33]);
        *(GAS v4u*)(WT + (size_t)(nrow0 + n) * KT + krow0 + 8 * c) = o; }
    LDS_WAIT(); asm volatile("" ::: "memory");
}
__device__ __forceinline__ void p0_prologue(Frame& F) {
    LAS float* scr = (LAS float*)(F.lds + RING_OFF + F.wave * 16384);
    const int gw = F.vcu * NWAVES + F.wave, NGW = F.G * NWAVES;
    unsigned char* ws = F.ws;
    const float* in_x = INP(0); const float* in_p = INP(1); const float* in_gmix = INP(2); const float* in_win = INP(3); const float* in_ws = INP(6); const float* in_ga = INP(9); const float* in_gb = INP(10);
    const float* in_wout = INP(11); const float* in_gmoe = INP(12); const float* in_wr = INP(13); const float* in_wgu = INP(15); const float* in_wdn = INP(17); const float* in_gple = INP(19); const float* in_wpg = INP(20); const float* in_wple = INP(21);
    constexpr int PER_L = 1280 + 512 + 512 + 128, N_SMALL = NLAYER * PER_L, N_GU = NLAYER * NEXP * 1024, N_DN = NLAYER * NEXP * 512, NITEMS = N_SMALL + N_GU + N_DN;
    for (int it = gw; it < NITEMS; it += NGW) {
        if (it < N_SMALL) { const int l = it / PER_L; int r = it % PER_L;
            if (r < 1280) { tr_item(in_win + (size_t)l * DM * INC, INC, DM, (bf16*)(ws + WS_WIN) + (size_t)l * NIN * DM, 64 * (r / 80), 32 * (r % 80), 64 * (r / 80), 32 * (r % 80), in_gmix + l * DM, nullptr, 1 << 30, scr, F.lane); continue; } r -= 1280;
            if (r < 512) { const int k0 = 64 * (r / 32); tr_item(in_wout + (size_t)l * DM * DM, DM, DM, (bf16*)(ws + WS_WOUT) + (size_t)l * DM * DM, k0, 32 * (r % 32), (k0 + 512) & 1023, 32 * (r % 32), in_ga + l * 512, in_gb + l * 512, 512, scr, F.lane); continue; } r -= 512;
            if (r < 512) { tr_item(in_wpg + (size_t)l * DM * DM, DM, DM, (bf16*)(ws + WS_WPG) + (size_t)l * DM * DM, 64 * (r / 32), 32 * (r % 32), 64 * (r / 32), 32 * (r % 32), in_gple + l * DM, nullptr, 1 << 30, scr, F.lane); continue; } r -= 512;
            tr_item(in_wple + (size_t)l * PLE * DM, DM, PLE, (bf16*)(ws + WS_WPLE) + (size_t)l * DM * PLE, 64 * (r / 32), 32 * (r % 32), 64 * (r / 32), 32 * (r % 32), nullptr, nullptr, 1 << 30, scr, F.lane); continue; }
        if (it < N_SMALL + N_GU) { const int r = it - N_SMALL, le = r >> 10, item = r & 1023, k0 = 64 * (item >> 6), n0 = 32 * (item & 63);
            const int nrow0 = n0 < 1024 ? 256 * (n0 >> 7) + (n0 & 127) : 256 * ((n0 - 1024) >> 7) + 128 + ((n0 - 1024) & 127);
            tr_item(in_wgu + (size_t)le * DM * 2048, 2048, DM, (bf16*)(ws + WS_WGU) + (size_t)le * 2048 * DM, k0, n0, k0, nrow0, in_gmoe + (le >> 5) * DM, nullptr, 1 << 30, scr, F.lane); continue; }
        { const int r = it - N_SMALL - N_GU, le = r >> 9, item = r & 511, k0 = 64 * (item >> 5), n0 = 32 * (item & 31);
            tr_item(in_wdn + (size_t)le * DM * DM, DM, DM, (bf16*)(ws + WS_WDN) + (size_t)le * DM * DM, k0, n0, k0, n0, nullptr, nullptr, 1 << 30, scr, F.lane); }
    }
    const int gt = F.vcu * (NWAVES * 64) + F.tid, NGT = F.G * NWAVES * 64;
    for (int i = gt; i < NLAYER * 32 * DM; i += NGT) { const int l = i / (32 * DM), j = (i / DM) % 32, k = i % DM;
        ((bf16*)(ws + WS_WFB))[i] = (bf16)(j < 8 ? f2bf(in_win[((size_t)l * DM + k) * INC + NIN + j] * in_gmix[l * DM + k]) : 0u);
        ((bf16*)(ws + WS_WRB))[i] = (bf16)f2bf(in_wr[((size_t)l * DM + k) * NEXP + j] * in_gmoe[l * DM + k]); }
    for (int i = gt; i < NLAYER * 4 * 128 * 128; i += NGT) { const int ii = (i >> 7) & 127, jj = i & 127; ((bf16*)(ws + WS_WSB))[i] = (bf16)(((jj >> 6) <= (ii >> 6)) ? f2bf(in_ws[i]) : 0u); }
    for (int m = gw; m < T; m += NGW) { const GAS f32x4* xr = (const GAS f32x4*)(in_x + (size_t)m * DM) + F.lane; f32x4 v[4]; float s = 0.f;
#pragma unroll
        for (int j = 0; j < 4; ++j) { v[j] = xr[64 * j]; s += (v[j].x * v[j].x + v[j].y * v[j].y) + (v[j].z * v[j].z + v[j].w * v[j].w); }
        s = wave_sum(s, F.lane);
        GAS unsigned long long* o8 = (GAS unsigned long long*)((bf16*)(ws + WS_HBA) + (size_t)m * DM) + F.lane;
#pragma unroll
        for (int j = 0; j < 4; ++j) o8[64 * j] = (unsigned long long)pk2(v[j].x, v[j].y) | ((unsigned long long)pk2(v[j].z, v[j].w) << 32);
        if (F.lane < 16) ((float*)(ws + WS_SSQX))[(size_t)m * 16 + F.lane] = F.lane == 0 ? s : 0.f; }
    for (size_t i = gt; i < (size_t)NLAYER * T * PLE / 8; i += NGT) { const GAS f32x4* pr = (const GAS f32x4*)in_p + 2 * i; const f32x4 a = pr[0], b = pr[1];
        v4u o; o.x = pk2(a.x, a.y); o.y = pk2(a.z, a.w); o.z = pk2(b.x, b.y); o.w = pk2(b.z, b.w); ((GAS v4u*)(ws + WS_PB))[i] = o; }
}

constexpr int SK_PITCH = 2064, SK_BW = 0, SK_SCR = 32 * SK_PITCH, SK_SCR_BYTES = 4608, SK_LCNT = SK_SCR + 8 * SK_SCR_BYTES, SK_LBASE = SK_LCNT + 128;
typedef float f32x16 __attribute__((ext_vector_type(16)));
__device__ __forceinline__ int crow16(int r, int hi) { return (r & 3) + 8 * (r >> 2) + 4 * hi; }
__device__ __forceinline__ void sk_load_bw(Frame& F, const bf16* wsrc) {
#pragma unroll
    for (int i = 0; i < 8; ++i) { const int idx = F.tid + 512 * i, row = idx >> 7, ch = idx & 127; *(LAS v4u*)(F.lds + SK_BW + row * SK_PITCH + ch * 16) = *(const GAS v4u*)(wsrc + row * 1024 + ch * 8); }
}
__device__ __forceinline__ f32x16 skinny32(const bf16* hb, int tok0, LAS const unsigned char* bw, int lane) {
    const int r32 = lane & 31, hi = lane >> 5;
    const GAS v4u* ap = (const GAS v4u*)(hb + (size_t)(tok0 + r32) * DM + 32 * hi);
    LAS const unsigned char* bp = bw + r32 * SK_PITCH + 64 * hi;
    f32x16 acc = f32x16{};
#pragma unroll 4
    for (int S = 0; S < 16; ++S) {
        const v4u a0 = ap[S * 8 + 0], a1 = ap[S * 8 + 1], a2 = ap[S * 8 + 2], a3 = ap[S * 8 + 3];
        const bf16x8 b0 = *(LAS const bf16x8*)(bp + S * 128), b1 = *(LAS const bf16x8*)(bp + S * 128 + 16), b2 = *(LAS const bf16x8*)(bp + S * 128 + 32), b3 = *(LAS const bf16x8*)(bp + S * 128 + 48);
        acc = __builtin_amdgcn_mfma_f32_32x32x16_bf16(__builtin_bit_cast(bf16x8, a0), b0, acc, 0, 0, 0);
        acc = __builtin_amdgcn_mfma_f32_32x32x16_bf16(__builtin_bit_cast(bf16x8, a1), b1, acc, 0, 0, 0);
        acc = __builtin_amdgcn_mfma_f32_32x32x16_bf16(__builtin_bit_cast(bf16x8, a2), b2, acc, 0, 0, 0);
        acc = __builtin_amdgcn_mfma_f32_32x32x16_bf16(__builtin_bit_cast(bf16x8, a3), b3, acc, 0, 0, 0);
    }
    return acc;
}
__device__ __forceinline__ float row_rinv16(const float* ssq16, int tok) {
    const GAS f32x4* p = (const GAS f32x4*)(ssq16 + (size_t)tok * 16); const f32x4 a = p[0], b = p[1], c = p[2], d = p[3];
    const float s = (((a.x + a.y) + (a.z + a.w)) + ((b.x + b.y) + (b.z + b.w))) + (((c.x + c.y) + (c.z + c.w)) + ((d.x + d.y) + (d.z + d.w)));
    return rsqrtf(s * (1.0f / DM) + EPS);
}
__device__ __forceinline__ void p1_flogit(Frame& F, int l, const bf16* hb, const float* ssq16) {
    sk_load_bw(F, (const bf16*)(F.ws + WS_WFB) + (size_t)l * 32 * DM);
    __syncthreads();
    LAS float* rvs = (LAS float*)(F.lds + SK_SCR + F.wave * SK_SCR_BYTES);
    const float* in_bf = INP(8);
    const int r32 = F.lane & 31, hi = F.lane >> 5;
    for (int g = F.vcu; g < T / 128; g += F.G) {
        if (F.wave < 4) {
            const int tok0 = g * 128 + F.wave * 32;
            if (F.lane < 32) rvs[F.lane] = row_rinv16(ssq16, tok0 + F.lane);
            const f32x16 acc = skinny32(hb, tok0, F.lds + SK_BW, F.lane);
            LDS_WAIT(); asm volatile("" ::: "memory");
            if (r32 < 8) { const float bf = in_bf[l * 8 + r32];
#pragma unroll
                for (int r = 0; r < 16; ++r) { const int tr = crow16(r, hi); const float v = acc[r] * rvs[tr] + bf; const float ls = fminf(v, 0.f) - log1pf(__expf(-fabsf(v)));
                    ((float*)(F.ws + WS_LF))[(size_t)(tok0 + tr) * 8 + r32] = ls * LOG2E; } }
            LDS_WAIT(); asm volatile("" ::: "memory");
        }
    }
    __syncthreads();
}
__device__ __forceinline__ void p4_router(Frame& F, int l, const bf16* hb, const float* ssq16) {
    sk_load_bw(F, (const bf16*)(F.ws + WS_WRB) + (size_t)l * 32 * DM);
    LAS int* lcnt = (LAS int*)(F.lds + SK_LCNT); LAS int* lbase = (LAS int*)(F.lds + SK_LBASE);
    LAS float* lg = (LAS float*)(F.lds + SK_SCR + F.wave * SK_SCR_BYTES);
    const int r32 = F.lane & 31, hi = F.lane >> 5;
    const float* in_br = INP(14);
    int* lists = (int*)(F.ws + WS_LISTS); int* tope = (int*)(F.ws + WS_TOPE); float* gate = (float*)(F.ws + WS_GATE); float* rinv = (float*)(F.ws + WS_RINV);
    for (int g = F.vcu; g < T / 128; g += F.G) {
        if (F.tid < 32) lcnt[F.tid] = 0;
        __syncthreads();
        int ei[4] = {0, 0, 0, 0}, lr[4] = {0, 0, 0, 0}; float gv[4] = {0.f, 0.f, 0.f, 0.f}; const int tok = g * 128 + F.wave * 32 + r32;
        if (F.wave < 4) {
            const int tok0 = g * 128 + F.wave * 32;
            const f32x16 acc = skinny32(hb, tok0, F.lds + SK_BW, F.lane);
#pragma unroll
            for (int r = 0; r < 16; ++r) lg[crow16(r, hi) * 33 + r32] = acc[r];
            LDS_WAIT(); asm volatile("" ::: "memory");
            if (hi == 0) {
                const float rv = row_rinv16(ssq16, tok); rinv[tok] = rv;
                float v[32];
#pragma unroll
                for (int e = 0; e < 32; ++e) v[e] = lg[r32 * 33 + e] * rv + in_br[l * 32 + e];
                float tv[4];
#pragma unroll
                for (int k = 0; k < 4; ++k) { float best = -INFINITY; int bi = 0;
#pragma unroll
                    for (int e = 0; e < 32; ++e) { const bool gt = v[e] > best; best = gt ? v[e] : best; bi = gt ? e : bi; }
#pragma unroll
                    for (int e = 0; e < 32; ++e) v[e] = (e == bi) ? -INFINITY : v[e];
                    tv[k] = best; ei[k] = bi; }
                float sum = 0.f;
#pragma unroll
                for (int k = 0; k < 4; ++k) { gv[k] = __expf(tv[k] - tv[0]); sum += gv[k]; }
                const float inv = 1.0f / sum;
#pragma unroll
                for (int k = 0; k < 4; ++k) { gv[k] *= inv; lr[k] = __hip_atomic_fetch_add(&lcnt[ei[k]], 1, __ATOMIC_RELAXED, __HIP_MEMORY_SCOPE_WORKGROUP); }
            }
        }
        __syncthreads();
        if (F.tid < 32) { const int c = lcnt[F.tid]; lbase[F.tid] = c ? (int)__hip_atomic_fetch_add(F.ctl + CW_CNT + (l * 32 + F.tid) * 64, (unsigned)c, RLX_AGENT) : 0; }
        __syncthreads();
        if (F.wave < 4 && hi == 0) {
#pragma unroll
            for (int k = 0; k < 4; ++k) { const int slot = lbase[ei[k]] + lr[k]; lists[ei[k] * 32768 + slot] = tok; tope[tok * 4 + k] = (ei[k] << 16) | slot; gate[tok * 4 + k] = gv[k]; }
        }
        __syncthreads();
    }
}
__device__ __forceinline__ int build_tiles(Frame& F, int l) {
    LAS int* cnt = (LAS int*)(F.lds + LCNT_OFF); LAS int* tst = (LAS int*)(F.lds + LTST_OFF); LAS int* tiles = (LAS int*)(F.lds + LTILES_OFF);
    if (F.tid < 32) cnt[F.tid] = (int)__hip_atomic_load(F.ctl + CW_CNT + (l * 32 + F.tid) * 64, RLX_AGENT);
    __syncthreads();
    if (F.tid == 0) { int s = 0; for (int e = 0; e < 32; ++e) { tst[e] = s; s += (cnt[e] + 255) >> 8; } tst[32] = s; }
    __syncthreads();
    if (F.tid < 32) { const int n = (cnt[F.tid] + 255) >> 8, s = tst[F.tid]; for (int m = 0; m < n; ++m) tiles[s + m] = F.tid | (m << 8); }
    __syncthreads();
    return __builtin_amdgcn_readfirstlane(tst[32]);
}

__device__ __forceinline__ void fox_scan(Frame& F, int bh) {
    const int b = bh >> 3, h = bh & 7, s0 = 8 * F.tid;
    const float* lf = (const float*)(F.ws + WS_LF) + ((size_t)b * SEQ + s0) * 8 + h;
    float v[8];
#pragma unroll
    for (int i = 0; i < 8; ++i) v[i] = lf[i * 8];
#pragma unroll
    for (int i = 1; i < 8; ++i) v[i] += v[i - 1];
    float x = v[7];
#pragma unroll
    for (int o = 1; o < 64; o <<= 1) { const float y = __int_as_float(__builtin_amdgcn_ds_bpermute((F.lane - o) << 2, __float_as_int(x))); if (F.lane >= o) x += y; }
    LAS float* wsum = (LAS float*)(F.lds + attn_body::LDS_WS);
    if (F.lane == 63) wsum[F.wave] = x;
    __syncthreads();
    float base = x - v[7];
    for (int w = 0; w < F.wave; ++w) base += wsum[w];
    LAS attn_body::kx2_t* kx = (LAS attn_body::kx2_t*)(F.lds + attn_body::LDS_KX) + s0;
#pragma unroll
    for (int i = 0; i < 8; ++i) { const float bias = -(base + v[i]); const unsigned hh = f2bf(bias); const float r1 = bias - __uint_as_float(hh << 16); const unsigned mm = f2bf(r1); const float r2 = r1 - __uint_as_float(mm << 16); const unsigned ll = f2bf(r2);
        attn_body::kx2_t o; o.x = hh | (mm << 16); o.y = ll | 0x3F800000u; kx[i] = o; }
    __syncthreads();
}
constexpr int GM_ST = 0, GM_VT = 1024, GM_PITCH = 136;
typedef float f32x4v __attribute__((ext_vector_type(4)));
__device__ __forceinline__ void gmlp_unit(Frame& F, int l, int blk) {
    const bf16* VG = (const bf16*)(F.ws + WS_U + SEG_BYTES); const bf16* U = (const bf16*)(F.ws + WS_U); bf16* YC = (bf16*)(F.ws + WS_YC);
    const bf16* WSB = (const bf16*)(F.ws + WS_WSB) + (size_t)l * 4 * 128 * 128;
    const float* in_lng = INP(4); const float* in_lnb = INP(5); const float* in_bs = INP(7);
    LAS float* st = (LAS float*)(F.lds + GM_ST); LAS unsigned char* vt = F.lds + GM_VT;
    const int row0 = blk * 128, lane = F.lane, w = F.wave, fr = lane & 15, fq = lane >> 4;
#pragma unroll 2
    for (int rr = 0; rr < 16; ++rr) { const int j = w * 16 + rr; const v4u raw = *(const GAS v4u*)(VG + (size_t)(row0 + j) * 512 + lane * 8);
        float x[8]; x[0] = bf_lo(raw.x); x[1] = bf_hi(raw.x); x[2] = bf_lo(raw.y); x[3] = bf_hi(raw.y); x[4] = bf_lo(raw.z); x[5] = bf_hi(raw.z); x[6] = bf_lo(raw.w); x[7] = bf_hi(raw.w);
        float s = 0.f;
#pragma unroll
        for (int i = 0; i < 8; ++i) s += x[i];
        const float mean = wave_sum(s, F.lane) * (1.0f / 512.0f); float q = 0.f;
#pragma unroll
        for (int i = 0; i < 8; ++i) { const float d = x[i] - mean; q += d * d; }
        const float rstd = rsqrtf(wave_sum(q, F.lane) * (1.0f / 512.0f) + EPS);
        if (lane == 0) { st[2 * j] = mean; st[2 * j + 1] = rstd; } }
    __syncthreads();
    const int i = 16 * w + fr; const size_t grow = (size_t)(row0 + i); float ss = 0.f;
#pragma unroll 1
    for (int g = 0; g < 4; ++g) {
        { const int c = 2 * lane; const float ga0 = in_lng[l * 512 + g * 128 + c], ga1 = in_lng[l * 512 + g * 128 + c + 1], be0 = in_lnb[l * 512 + g * 128 + c], be1 = in_lnb[l * 512 + g * 128 + c + 1];
#pragma unroll 4
            for (int pr = 0; pr < 8; ++pr) { const int j = w * 16 + 2 * pr;
                const unsigned r0 = *(const GAS unsigned*)(VG + (size_t)(row0 + j) * 512 + g * 128 + c), r1 = *(const GAS unsigned*)(VG + (size_t)(row0 + j + 1) * 512 + g * 128 + c);
                const float m0 = st[2 * j], s0 = st[2 * j + 1], m1 = st[2 * j + 2], s1 = st[2 * j + 3];
                const float v00 = (bf_lo(r0) - m0) * s0 * ga0 + be0, v01 = (bf_hi(r0) - m0) * s0 * ga1 + be1, v10 = (bf_lo(r1) - m1) * s1 * ga0 + be0, v11 = (bf_hi(r1) - m1) * s1 * ga1 + be1;
                *(LAS unsigned*)(vt + (c * GM_PITCH + j) * 2) = pk2(v00, v10); *(LAS unsigned*)(vt + ((c + 1) * GM_PITCH + j) * 2) = pk2(v01, v11); } }
        __syncthreads();
        f32x4v acc[8];
#pragma unroll
        for (int nb = 0; nb < 8; ++nb) acc[nb] = (f32x4v){0.f, 0.f, 0.f, 0.f};
#pragma unroll
        for (int ks = 0; ks < 4; ++ks) { const bf16x8 wf = *(const GAS bf16x8*)(WSB + ((size_t)(g * 128 + 16 * w + fr)) * 128 + 32 * ks + 8 * fq);
#pragma unroll
            for (int nb = 0; nb < 8; ++nb) { const bf16x8 vf = *(LAS const bf16x8*)(vt + ((16 * nb + fr) * GM_PITCH + 32 * ks + 8 * fq) * 2);
                acc[nb] = __builtin_amdgcn_mfma_f32_16x16x32_bf16(vf, wf, acc[nb], 0, 0, 0); } }
        const float bs = in_bs[(l * 4 + g) * 128 + i];
#pragma unroll
        for (int nb = 0; nb < 8; ++nb) { const u32x2 uv = *(const GAS u32x2*)(U + grow * 512 + g * 128 + 16 * nb + 4 * fq); f32x4v y = acc[nb] + bs;
            y[0] *= bf_lo(uv.x); y[1] *= bf_hi(uv.x); y[2] *= bf_lo(uv.y); y[3] *= bf_hi(uv.y);
            u32x2 o; o.x = cvt_pk_bf16(y[0], y[1]); o.y = cvt_pk_bf16(y[2], y[3]);
            const float y0 = bf_lo(o.x), y1 = bf_hi(o.x), y2 = bf_lo(o.y), y3 = bf_hi(o.y); ss += (y0 * y0 + y1 * y1) + (y2 * y2 + y3 * y3);
            *(GAS u32x2*)(YC + grow * DM + 512 + g * 128 + 16 * nb + 4 * fq) = o; }
        __syncthreads();
    }
    ss += shx(ss, 16, lane); ss += shx(ss, 32, lane);
    if (fq == 0) ((float*)(F.ws + WS_GSS))[grow] = ss;
}
__device__ __forceinline__ void p7_combine(Frame& F, bf16* hb_out, float* ssq_out) {
    const LAS int* tst = (const LAS int*)(F.lds + LTST_OFF);
    const int gw = F.vcu * NWAVES + F.wave, NGW = F.G * NWAVES;
    const int* tope = (const int*)(F.ws + WS_TOPE); const float* gate = (const float*)(F.ws + WS_GATE); const bf16* ys = (const bf16*)(F.ws + WS_YS);
    for (int tok = gw; tok < T; tok += NGW) {
        GAS f32x4* hr = (GAS f32x4*)(F.H + (size_t)tok * DM) + F.lane; f32x4 a[4];
#pragma unroll
        for (int j = 0; j < 4; ++j) a[j] = hr[64 * j];
#pragma unroll
        for (int k = 0; k < 4; ++k) { const int te = tope[tok * 4 + k]; const float g = gate[tok * 4 + k]; const size_t pos = (size_t)tst[te >> 16] * 256 + (te & 0xffff);
            const GAS u32x2* yr = (const GAS u32x2*)(ys + pos * DM) + F.lane;
#pragma unroll
            for (int j = 0; j < 4; ++j) { const u32x2 y = yr[64 * j]; a[j].x += g * bf_lo(y.x); a[j].y += g * bf_hi(y.x); a[j].z += g * bf_lo(y.y); a[j].w += g * bf_hi(y.y); } }
        float s = 0.f;
        GAS unsigned long long* o8 = (GAS unsigned long long*)(hb_out + (size_t)tok * DM) + F.lane;
#pragma unroll
        for (int j = 0; j < 4; ++j) { hr[64 * j] = a[j]; o8[64 * j] = (unsigned long long)pk2(a[j].x, a[j].y) | ((unsigned long long)pk2(a[j].z, a[j].w) << 32);
            s += (a[j].x * a[j].x + a[j].y * a[j].y) + (a[j].z * a[j].z + a[j].w * a[j].w); }
        s = wave_sum(s, F.lane);
        if (F.lane < 16) ssq_out[(size_t)tok * 16 + F.lane] = F.lane == 0 ? s : 0.f;
    }
}
__device__ __forceinline__ void final_norm(Frame& F, const float* ssq16) {
    const int gw = F.vcu * NWAVES + F.wave, NGW = F.G * NWAVES;
    const GAS f32x4* gf = (const GAS f32x4*)INP(22) + F.lane; f32x4 gg[4];
#pragma unroll
    for (int j = 0; j < 4; ++j) gg[j] = gf[64 * j];
    for (int tok = gw; tok < T; tok += NGW) {
        float s = F.lane < 16 ? ssq16[(size_t)tok * 16 + F.lane] : 0.f; s = wave_sum(s, F.lane); const float ri = rsqrtf(s * (1.0f / DM) + EPS);
        GAS f32x4* hr = (GAS f32x4*)(F.H + (size_t)tok * DM) + F.lane;
#pragma unroll
        for (int j = 0; j < 4; ++j) { const f32x4 v = hr[64 * j]; hr[64 * j] = v * ri * gg[j]; }
    }
}

struct Args { const float* in[23]; float* out; unsigned char* ws; int ph_lo, ph_hi; };
__global__ void __launch_bounds__(NWAVES * 64, 2) fwd_kernel(Args args) {
    extern __shared__ __attribute__((aligned(16))) unsigned char lds[];
    Frame F;
    F.lds = (LAS unsigned char*)lds;
    F.MISC = (volatile LAS unsigned*)(F.lds + MISC_OFF);
    F.tid = threadIdx.x; F.lane = F.tid & 63; F.wave = __builtin_amdgcn_readfirstlane(F.tid >> 6);
    const int wave0 = F.wave;
    F.G = gridDim.x; { const int bx = blockIdx.x; F.bx = bx; F.vcu = (F.G % 8 == 0) ? (bx % 8) * (F.G / 8) + bx / 8 : bx; }
    unsigned char* ws = (unsigned char*)(GAS unsigned char*)args.ws; F.ws = ws; F.H = (float*)(GAS float*)args.out;
    F.ctl = (gu32*)(ws + WS_CTL);
    for (int u = F.tid; u < (LDS_BYTES - LDSCTL_OFF) / 4; u += NWAVES * 64) ((LAS unsigned*)(F.lds + LDSCTL_OFF))[u] = 0u;
    __syncthreads();
    const int lo = args.ph_lo, hi = args.ph_hi;
    XcdBarrier bar; bar.bar = (unsigned*)(F.ctl + CW_BAR); bar.x = 0; bar.st = nullptr; bar.wave = 0;
    if (!MK_PER_STEP) bar = xcd_barrier_post((unsigned*)(F.ctl + CW_BAR), F.MISC + 8);
#if MK_PER_STEP
#define IN(k) (lo <= (k) && (k) < hi)
#else
#define IN(k) true
#endif
#define SEAM(k) do { if (IN(k) && IN((k) + 1)) xcd_barrier(bar); } while (0)
#define HBA ((bf16*)(ws + WS_HBA))
#define HBB ((bf16*)(ws + WS_HBB))
#define SSQX ((float*)(ws + WS_SSQX))
#define SSQY ((float*)(ws + WS_SSQY))

#ifndef PHMASK
#define PHMASK 0x3ff
#endif
#define PH(j) ((PHMASK >> (j)) & 1)
#ifndef SUBMASK
#define SUBMASK 0xff
#endif
#define SUB(j) ((SUBMASK >> (j)) & 1)
    if (PH(0) && IN(0)) { p0_prologue(F); } SEAM(0);

#define RETID() do { int t_ = mk_tid(wave0); F.tid = t_; F.lane = t_ & 63; F.wave = __builtin_amdgcn_readfirstlane(t_ >> 6); GAS unsigned char* w_ = (GAS unsigned char*)args.ws; asm volatile("" : "+s"(w_)); F.ws = (unsigned char*)w_; ws = (unsigned char*)w_; int bx_ = blockIdx.x, g_ = gridDim.x; asm volatile("" : "+s"(bx_), "+s"(g_)); F.G = g_; F.vcu = (g_ % 8 == 0) ? (bx_ % 8) * (g_ / 8) + bx_ / 8 : bx_; F.bx = bx_; } while (0)
    for (int l = 0; l < NLAYER; ++l) {
        const int sb = 1 + 8 * l;
        const bf16* hb_in = l == 0 ? HBA : HBB;
        if (PH(1) && IN(sb)) { RETID();
            if (SUB(0) && l == 0) {
                for (int ll = 0; ll < NLAYER; ++ll) {
                    pg8::DenseOrder S; S.init((const bf16*)(ws + WS_PB) + (size_t)ll * T * PLE, (const bf16*)(ws + WS_WPLE) + (size_t)ll * DM * PLE, T, DM, PLE, F.G, F.bx);
                    EpiBf E{(bf16_t*)(ws + WS_E) + (size_t)ll * T * DM, nullptr, 0};
                    int kple = PLE; asm volatile("" : "+s"(kple));
                    pg8::gemm_phase<EpiBf, pg8::DenseOrder, false, false>(F.lds + RING_OFF, kple, S, E, F.tid);
                }
            }
            if (SUB(1)) p1_flogit(F, l, hb_in, SSQX);
            if (SUB(2)) {
            pg8::DenseOrder S; S.init(hb_in, (const bf16*)(ws + WS_WIN) + (size_t)l * NIN * DM, T, NIN, DM, F.G, F.bx);
            EpiIn E{(bf16_t*)(ws + WS_U), SSQX};
            pg8::gemm_phase<EpiIn, pg8::DenseOrder, false, false>(F.lds + RING_OFF, DM, S, E, F.tid);
            }
        }
        SEAM(sb);
        if (PH(2) && IN(sb + 1)) { RETID();
            if (SUB(3)) for (int blk = F.vcu; blk < T / 128; blk += F.G) gmlp_unit(F, l, blk);
            if (SUB(4)) for (int vv = F.vcu; vv < 256; vv += F.G) {
                fox_scan(F, vv >> 2);
                const attn_body::AttnTensors AT{(const attn_body::bf16*)(ws + WS_U + 2 * SEG_BYTES), (const attn_body::bf16*)(ws + WS_U + 3 * SEG_BYTES), (const attn_body::bf16*)(ws + WS_U + 4 * SEG_BYTES),
                                                (attn_body::bf16*)(ws + WS_YC), (float*)(ws + WS_OSS)};
                const attn_body::StaticOrder S(vv);
                attn_body::attn_phase<attn_body::StaticOrder>((char*)lds + RING_OFF, AT, S, F.tid);
            }
        }
        SEAM(sb + 1);
        if (PH(3) && IN(sb + 2)) { RETID();
            pg8::DenseOrder S; S.init((const bf16*)(ws + WS_YC), (const bf16*)(ws + WS_WOUT) + (size_t)l * DM * DM, T, DM, DM, F.G, F.bx);
            const float* xin_ = INP(0);
            EpiRes E{l == 0 ? xin_ : (const float*)F.H, F.H, (bf16_t*)HBA, SSQX, (const float*)(ws + WS_OSS), (const float*)(ws + WS_GSS)};
            pg8::gemm_phase<EpiRes, pg8::DenseOrder, false, true>(F.lds + RING_OFF, DM, S, E, F.tid);
        }
        SEAM(sb + 2);
        if (PH(4) && IN(sb + 3)) { RETID(); p4_router(F, l, HBA, SSQX); }
        SEAM(sb + 3);
        if (PH(5) && IN(sb + 4)) { RETID();
            const int ntiles = build_tiles(F, l);
            pg8::GroupedOrder<true> S; S.A = (const char*)HBA; S.Bt = (const char*)((const bf16*)(ws + WS_WGU) + (size_t)l * NEXP * 2048 * DM); S.K = DM; S.N = 2048; S.npn = 8;
            S.tiles = (const LAS int*)(F.lds + LTILES_OFF); S.cnt = (const LAS int*)(F.lds + LCNT_OFF); S.lists = (const int*)(ws + WS_LISTS); S.ntiles = ntiles; S.G = F.G; S.vcu = F.vcu;
            EpiSwiglu E{(bf16_t*)(ws + WS_ACT), (const float*)(ws + WS_RINV), (const int*)(ws + WS_LISTS), (const LAS int*)(F.lds + LCNT_OFF), INP(16) + (size_t)l * NEXP * 2048};
            pg8::gemm_phase<EpiSwiglu, pg8::GroupedOrder<true>, true, false>(F.lds + RING_OFF, DM, S, E, F.tid);
        }
        SEAM(sb + 4);
        if (PH(6) && IN(sb + 5)) { RETID();
            const int ntiles = build_tiles(F, l);
            pg8::GroupedOrder<false> S; S.A = (const char*)(ws + WS_ACT); S.Bt = (const char*)((const bf16*)(ws + WS_WDN) + (size_t)l * NEXP * DM * DM); S.K = DM; S.N = DM; S.npn = 4;
            S.tiles = (const LAS int*)(F.lds + LTILES_OFF); S.cnt = (const LAS int*)(F.lds + LCNT_OFF); S.lists = nullptr; S.ntiles = ntiles; S.G = F.G; S.vcu = F.vcu;
            EpiBf E{(bf16_t*)(ws + WS_YS), INP(18) + (size_t)l * NEXP * DM, DM};
            pg8::gemm_phase<EpiBf, pg8::GroupedOrder<false>, false, false>(F.lds + RING_OFF, DM, S, E, F.tid);
        }
        SEAM(sb + 5);
        if (PH(7) && IN(sb + 6)) { RETID(); (void)build_tiles(F, l); p7_combine(F, HBA, SSQY); }
        SEAM(sb + 6);
        if (PH(8) && IN(sb + 7)) { RETID();
            pg8::DenseOrder S; S.init(HBA, (const bf16*)(ws + WS_WPG) + (size_t)l * DM * DM, T, DM, DM, F.G, F.bx);
            EpiPle E{F.H, (bf16_t*)HBB, SSQX, SSQY, (const bf16_t*)(ws + WS_E) + (size_t)l * T * DM};
            pg8::gemm_phase<EpiPle, pg8::DenseOrder, false, false>(F.lds + RING_OFF, DM, S, E, F.tid);
        }
        SEAM(sb + 7);
    }
    if (PH(9) && IN(NSTEPS - 1)) { RETID(); final_norm(F, SSQX); }
#undef IN
#undef SEAM
#undef HBA
#undef HBB
#undef SSQX
#undef SSQY
}

extern "C" void kernel_launch(void* const* d_in, const int* in_sizes, int n_in, void* d_out, int out_size, void* d_ws, size_t ws_size, hipStream_t stream) {
    static int grid = 0;
    if (grid == 0) {
        if (n_in != 23 || in_sizes[0] != T * DM || out_size != T * DM || ws_size < WS_END) { fprintf(stderr, "kernel_launch: unexpected shapes / workspace (n_in %d, ws %zu < %zu); nothing launched\n", n_in, ws_size, (size_t)WS_END); grid = -1; return; }
        int dev = 0, cus = 0, per_cu = 0;
        if (hipGetDevice(&dev) != hipSuccess || hipDeviceGetAttribute(&cus, hipDeviceAttributeMultiprocessorCount, dev) != hipSuccess) { grid = -1; return; }
        if (hipFuncSetAttribute((const void*)fwd_kernel, hipFuncAttributeMaxDynamicSharedMemorySize, LDS_BYTES) != hipSuccess) { fprintf(stderr, "kernel_launch: hipFuncSetAttribute failed\n"); grid = -1; return; }
        if (hipOccupancyMaxActiveBlocksPerMultiprocessor(&per_cu, (const void*)fwd_kernel, NWAVES * 64, LDS_BYTES) != hipSuccess || per_cu < 1) { fprintf(stderr, "kernel_launch: occupancy query says %d blocks per CU\n", per_cu); }
        (void)hipGetLastError();
        grid = cus;
    }
    if (grid < 0) return;
    if (hipMemsetAsync((char*)d_ws + WS_CTL, 0, CTL_ZERO_BYTES, stream) != hipSuccess) return;
    Args a{};
    for (int i = 0; i < 23; ++i) a.in[i] = (const float*)d_in[i];
    a.out = (float*)d_out; a.ws = (unsigned char*)d_ws;
#if MK_PER_STEP
    for (int s = 0; s < NSTEPS; ++s) { a.ph_lo = s; a.ph_hi = s + 1; hipLaunchKernelGGL(fwd_kernel, dim3(grid), dim3(NWAVES * 64), LDS_BYTES, stream, a); }
#else
    a.ph_lo = 0; a.ph_hi = NSTEPS;
    hipLaunchKernelGGL(fwd_kernel, dim3(grid), dim3(NWAVES * 64), LDS_BYTES, stream, a);
#endif
}
```

```cpp
#include <hip/hip_runtime.h>
#include <hip/hip_bf16.h>
#include <cstdio>
#include <cstdint>
#include <cmath>
namespace pg8 {
#ifndef PG8_PRIO8
#define PG8_PRIO8 1
#endif
#ifndef PG8_DMAFIRST
#define PG8_DMAFIRST 0
#endif
#if PG8_DMAFIRST
#define PG8_DMAFIRST_A(x) x
#define PG8_DMAFIRST_B(x)
#else
#define PG8_DMAFIRST_A(x)
#define PG8_DMAFIRST_B(x) x
#endif
#ifndef PG8_BAL
#define PG8_BAL 0
#endif
#define PG8_LAS __attribute__((address_space(3)))
typedef unsigned short bf16_t;
typedef short bf16x8 __attribute__((ext_vector_type(8)));
typedef float f32x4 __attribute__((ext_vector_type(4)));
typedef float f32x2 __attribute__((ext_vector_type(2)));
typedef unsigned u32x4 __attribute__((ext_vector_type(4)));
typedef unsigned u32x2 __attribute__((ext_vector_type(2)));
typedef int i32x8 __attribute__((ext_vector_type(8)));
typedef float f32x16 __attribute__((ext_vector_type(16)));
constexpr int BM = 256, BK = 64, HALF = 128, HTB = HALF * BK * 2  , STAGE_BYTES = 8 * HTB, NXCD = 8, WGM = 8;

__host__ __device__ __forceinline__ int lds_byte(int r, int c) { const int st = (r >> 4) * 2 + (c >> 5), rr = r & 15, cc = c & 31, ob = rr * 64 + cc * 2; return st * 1024 + (ob ^ (((ob >> 9) & 1) << 5)); }
__host__ __device__ __forceinline__ void stage_rc(int b, int& R, int& C) { const int st = b / 1024, sb = b % 1024, swz = sb ^ (((sb >> 9) & 1) << 5); R = (st >> 1) * 16 + swz / 64; C = (st & 1) * 32 + (swz % 64) / 2; }
__host__ __device__ __forceinline__ int perm32b(int rho) { return 16 * ((rho >> 2) & 1) + (rho & 3) + 4 * (rho >> 3); }
__host__ __device__ __forceinline__ int perm32(int rho) { const int n = rho >> 4, i = rho & 15; return 8 * (i >> 2) + 4 * n + (i & 3); }

struct Unit { int pm, pn, e, mt; };

struct DenseOrder {
    const char* A; const char* Bt; int K;
    int nM, nN, nwg, G, c;
    __device__ void init(const void* A_, const void* Bt_, int M, int N, int K_, int G_, int c_) { A = (const char*)A_; Bt = (const char*)Bt_; K = K_; nM = M / BM; nN = N / BM; nwg = nM * nN; G = G_; c = c_; }
    __device__ __forceinline__ bool next(int i, Unit& u) const {
        const long L = (long)i * G + c; if (L >= nwg) return false;
        int wgid = (int)L; { const int q = nwg / NXCD, r = nwg % NXCD, xcd = wgid % NXCD, off = wgid / NXCD; wgid = (xcd < r ? xcd * (q + 1) : r * (q + 1) + (xcd - r) * q) + off; }
        const int nig = WGM * nN, gid = wgid / nig, fm = gid * WGM, gsz = (nM - fm) < WGM ? (nM - fm) : WGM;
        u.pm = fm + ((wgid % nig) % gsz); u.pn = (wgid % nig) / gsz; u.e = 0; u.mt = 0; return true;
    }
    __device__ __forceinline__ const char* a_base(const Unit& u) const { return A + (size_t)u.pm * BM * K * 2; }
    __device__ __forceinline__ const char* b_base(const Unit& u) const { return Bt + (size_t)u.pn * BM * K * 2; }
    __device__ __forceinline__ unsigned row_off(const Unit&, int r) const { return (unsigned)(r * K * 2); }
    __device__ __forceinline__ const int* tok_ptr(const Unit&, int) const { return nullptr; }
};
struct DenseOrder2 : DenseOrder {
    size_t astride, bstride;
    __device__ __forceinline__ bool next(int i, Unit& u) const {
        const long L = (long)i * G + c; if (L >= 2L * nwg) return false;
        const int lay = L >= nwg ? 1 : 0; int wgid = (int)(L - (long)lay * nwg); { const int q = nwg / NXCD, r = nwg % NXCD, xcd = wgid % NXCD, off = wgid / NXCD; wgid = (xcd < r ? xcd * (q + 1) : r * (q + 1) + (xcd - r) * q) + off; }
        const int nig = WGM * nN, gid = wgid / nig, fm = gid * WGM, gsz = (nM - fm) < WGM ? (nM - fm) : WGM;
        u.pm = fm + ((wgid % nig) % gsz); u.pn = (wgid % nig) / gsz; u.e = lay; u.mt = 0; return true;
    }
    __device__ __forceinline__ const char* a_base(const Unit& u) const { return A + (size_t)u.e * astride + (size_t)u.pm * BM * K * 2; }
    __device__ __forceinline__ const char* b_base(const Unit& u) const { return Bt + (size_t)u.e * bstride + (size_t)u.pn * BM * K * 2; }
};
template <bool GATHER> struct GroupedOrder {
    const char* A; const char* Bt; int K, N, npn;
    const PG8_LAS int* tiles; const PG8_LAS int* cnt; const int* lists;
    int ntiles, G, vcu;
    __device__ __forceinline__ bool next(int i, Unit& u) const {
        const int L = i * G + vcu; if (L >= ntiles * npn) return false;
        const int ti = L / npn; u.pn = L - ti * npn; const int v = __builtin_amdgcn_readfirstlane(tiles[ti]); u.e = v & 255; u.mt = v >> 8; u.pm = ti; return true;
    }
    __device__ __forceinline__ const char* a_base(const Unit& u) const { return GATHER ? A : A + (size_t)u.pm * BM * K * 2; }
    __device__ __forceinline__ const char* b_base(const Unit& u) const { return Bt + ((size_t)u.e * N + (size_t)u.pn * BM) * K * 2; }
    __device__ __forceinline__ const int* tok_ptr(const Unit& u, int r) const { const int c1 = cnt[u.e] - 1; int rr = u.mt * BM + r; rr = rr < c1 ? rr : c1; return lists + 2 * (u.e * 32768 + rr); }
    __device__ __forceinline__ unsigned row_off(const Unit& u, int r) const {
        if (!GATHER) return (unsigned)(r * K * 2);
        const int c1 = cnt[u.e] - 1; int rr = u.mt * BM + r; rr = rr < c1 ? rr : c1; const int tok = lists[2 * (u.e * 32768 + rr)]; return (unsigned)tok * (unsigned)(K * 2);
    }
};

__device__ __forceinline__ unsigned cvt_pk_bf16(float lo, float hi) { unsigned r; asm volatile("v_cvt_pk_bf16_f32 %0, %1, %2" : "=v"(r) : "v"(lo), "v"(hi)); return r; }
__device__ __forceinline__ f32x2 gelu_pk(f32x2 v) {
    const f32x2 av = __builtin_elementwise_abs(v), d = av * 0.2316418882f + 1.0f;
    f32x2 t; t.x = __builtin_amdgcn_rcpf(d.x); t.y = __builtin_amdgcn_rcpf(d.y);
    f32x2 q = t * 0.5307027145f + (-0.7265760135f); q = q * t + 0.7107068705f; q = q * t + (-0.142248368f); q = q * t + 0.127414796f; q = q * t;
    const f32x2 s = (v * v) * (-0.72134752044f);
    f32x2 e; e.x = __builtin_amdgcn_exp2f(s.x); e.y = __builtin_amdgcn_exp2f(s.y);
    const f32x2 m = v * (q * e), r = v - m;
    f32x2 o; o.x = v.x < 0.f ? m.x : r.x; o.y = v.y < 0.f ? m.y : r.y; return o;
}

template <class Epi, class Sched, bool GATHER, bool MIDK, int F8 = 0>
__device__ __forceinline__ void gemm_phase(PG8_LAS unsigned char* lds, const int K, const Sched& S, const Epi& E, const int tid_in) {
    int tid_ = tid_in; asm volatile("" : "+v"(tid_));
    const int tid = tid_, wid = __builtin_amdgcn_readfirstlane(tid >> 6), lane = tid & 63, wr = wid >> 2, wc = wid & 3, fr = lane & 15, fq = lane >> 4;
    const int nt0 = K / BK;
#ifdef PROBE_K2
    const int nt = (F8 != 0 && GATHER) ? 2 * nt0 : nt0;
#else
    const int nt = nt0;
#endif
    unsigned voffA[2], voffB[2], ac[2][2], an[2][2];
    PG8_LAS unsigned char* anb = lds + STAGE_BYTES + 3072;
#pragma unroll
    for (int i = 0; i < 2; ++i) { int R, C; stage_rc(tid * 16 + i * 8192, R, C); if (F8 == 1) C ^= ((R >> 4) & 1) << 3;
        const int Rb = F8 == 1 ? ((R & ~31) + perm32b(R & 31)) : (Epi::PERM ? ((R & ~31) + perm32(R & 31)) : R);
        voffA[i] = (unsigned)(R * K + C) * 2u; voffB[i] = (unsigned)(Rb * K + C) * 2u; ac[0][i] = ac[1][i] = an[0][i] = an[1][i] = 0u; }
    const size_t kstep = (size_t)(BK * 2);
    const size_t hstep = (size_t)HALF * K * 2;
    const unsigned ldsw = (unsigned)wid * 1024u;
    const int aoff = F8 == 1 ? lds_byte(wr * 64 + (lane & 31), (lane >> 5) * 16) + ((lane >> 4) & 1) * 16 : F8 == 2 ? lds_byte(wr * 64 + fr, fq * 16) + (fq & 1) * 16 : lds_byte(wr * 64 + fr, fq * 8);
    const int boff = F8 == 1 ? lds_byte(wc * 32 + (lane & 31), (lane >> 5) * 16) + ((lane >> 4) & 1) * 16 : F8 == 2 ? lds_byte(wc * 32 + fr, fq * 16) + (fq & 1) * 16 : lds_byte(wc * 32 + fr, fq * 8);
    const int aoff2 = aoff ^ 16, boff2 = boff ^ 16;
#define PG8_SA(b, h) (((b) * 2 + (h)) * HTB)
#define PG8_SB(b, h) ((4 + (b) * 2 + (h)) * HTB)
#define PG8_STAGE(bufoff, gbase, voff) do { _Pragma("unroll") for (int _i = 0; _i < 2; ++_i) \
        __builtin_amdgcn_global_load_lds((const unsigned*)((const char*)(gbase) + (voff)[_i]), (PG8_LAS unsigned*)(lds + (bufoff) + ldsw + _i * 8192), 16, 0, 0); } while (0)
#define PG8_STAGE2(bufoff, gbase, o0, o1) do { \
        __builtin_amdgcn_global_load_lds((const unsigned*)((const char*)(gbase) + (o0)), (PG8_LAS unsigned*)(lds + (bufoff) + ldsw), 16, 0, 0); \
        __builtin_amdgcn_global_load_lds((const unsigned*)((const char*)(gbase) + (o1)), (PG8_LAS unsigned*)(lds + (bufoff) + ldsw + 8192), 16, 0, 0); } while (0)
#define PG8_LDA(dst, b, h) do { _Pragma("unroll") for (int m = 0; m < 4; ++m) _Pragma("unroll") for (int k = 0; k < 2; ++k) dst[m][k] = *(const PG8_LAS bf16x8*)(lds + PG8_SA(b, h) + aoff + m * 2048 + k * 1024); } while (0)
#define PG8_LDB(dst, b, h) do { _Pragma("unroll") for (int n = 0; n < 2; ++n) _Pragma("unroll") for (int k = 0; k < 2; ++k) dst[n][k] = *(const PG8_LAS bf16x8*)(lds + PG8_SB(b, h) + boff + n * 2048 + k * 1024); } while (0)
#define PG8_MMA(ai, bj, At, Bt) do { __builtin_amdgcn_s_setprio(1); _Pragma("unroll") for (int m = 0; m < 4; ++m) _Pragma("unroll") for (int n = 0; n < 2; ++n) _Pragma("unroll") for (int k = 0; k < 2; ++k) \
        acc[ai][bj][m][n] = __builtin_amdgcn_mfma_f32_16x16x32_bf16(Bt[n][k], At[m][k], acc[ai][bj][m][n], 0, 0, 0); __builtin_amdgcn_s_setprio(0); } while (0)
#define PG8_LDA8(dst, b, h) do { _Pragma("unroll") for (int m = 0; m < 2; ++m) _Pragma("unroll") for (int k = 0; k < 2; ++k) { const u32x4 lo_ = *(const PG8_LAS u32x4*)(lds + PG8_SA(b, h) + aoff + m * 4096 + k * 1024), hi_ = *(const PG8_LAS u32x4*)(lds + PG8_SA(b, h) + aoff2 + m * 4096 + k * 1024); \
        dst[m][k] = (i32x8){(int)lo_.x, (int)lo_.y, (int)lo_.z, (int)lo_.w, (int)hi_.x, (int)hi_.y, (int)hi_.z, (int)hi_.w}; } } while (0)
#define PG8_LDB8(dst, b, h) do { _Pragma("unroll") for (int k = 0; k < 2; ++k) { const u32x4 lo_ = *(const PG8_LAS u32x4*)(lds + PG8_SB(b, h) + boff + k * 1024), hi_ = *(const PG8_LAS u32x4*)(lds + PG8_SB(b, h) + boff2 + k * 1024); \
        dst[k] = (i32x8){(int)lo_.x, (int)lo_.y, (int)lo_.z, (int)lo_.w, (int)hi_.x, (int)hi_.y, (int)hi_.z, (int)hi_.w}; } } while (0)
#define PG8_MMA8(ai, bj, At, Bt) do { if (PG8_PRIO8) __builtin_amdgcn_s_setprio(1); _Pragma("unroll") for (int m = 0; m < 2; ++m) _Pragma("unroll") for (int k = 0; k < 2; ++k) \
        acc8[ai][bj][m] = __builtin_amdgcn_mfma_scale_f32_32x32x64_f8f6f4(Bt[k], At[m][k], acc8[ai][bj][m], 0, 0, 0, sc_w, 0, sc_x); if (PG8_PRIO8) __builtin_amdgcn_s_setprio(0); } while (0)
#define PG8_LDA16(dst, b, h) do { _Pragma("unroll") for (int m = 0; m < 4; ++m) { const u32x4 lo_ = *(const PG8_LAS u32x4*)(lds + PG8_SA(b, h) + aoff + m * 2048), hi_ = *(const PG8_LAS u32x4*)(lds + PG8_SA(b, h) + aoff2 + m * 2048); \
        dst[m] = (i32x8){(int)lo_.x, (int)lo_.y, (int)lo_.z, (int)lo_.w, (int)hi_.x, (int)hi_.y, (int)hi_.z, (int)hi_.w}; } } while (0)
#define PG8_LDB16(dst, b, h) do { _Pragma("unroll") for (int n = 0; n < 2; ++n) { const u32x4 lo_ = *(const PG8_LAS u32x4*)(lds + PG8_SB(b, h) + boff + n * 2048), hi_ = *(const PG8_LAS u32x4*)(lds + PG8_SB(b, h) + boff2 + n * 2048); \
        dst[n] = (i32x8){(int)lo_.x, (int)lo_.y, (int)lo_.z, (int)lo_.w, (int)hi_.x, (int)hi_.y, (int)hi_.z, (int)hi_.w}; } } while (0)
#define PG8_MMA16(ai, bj, At, Bt) do { __builtin_amdgcn_s_setprio(1); _Pragma("unroll") for (int m = 0; m < 4; ++m) _Pragma("unroll") for (int n = 0; n < 2; ++n) \
        asm volatile("s_nop 1\n\tv_mfma_scale_f32_16x16x128_f8f6f4 %0, %1, %2, %0, %3, %4 op_sel_hi:[0,0,0]" : "+v"(acc[ai][bj][m][n]) : "v"(Bt[n]), "v"(At[m]), "v"(sc_w), "v"(sc_x)); __builtin_amdgcn_s_setprio(0); } while (0)
#define PG8_XLDA(b, h) do { if constexpr (F8 == 1) { PG8_LDA8(At8, b, h); } else if constexpr (F8 == 2) { PG8_LDA16(At16, b, h); } else { PG8_LDA(At, b, h); } } while (0)
#define PG8_XLDB0(b, h) do { if constexpr (F8 == 1) { PG8_LDB8(B08, b, h); } else if constexpr (F8 == 2) { PG8_LDB16(B016, b, h); } else { PG8_LDB(B0, b, h); } } while (0)
#define PG8_XLDB1(b, h) do { if constexpr (F8 == 1) { PG8_LDB8(B18, b, h); } else if constexpr (F8 == 2) { PG8_LDB16(B116, b, h); } else { PG8_LDB(B1, b, h); } } while (0)
#define PG8_XMMA0(ai, bj) do { if constexpr (F8 == 1) { PG8_MMA8(ai, bj, At8, B08); } else if constexpr (F8 == 2) { PG8_MMA16(ai, bj, At16, B016); } else { PG8_MMA(ai, bj, At, B0); } } while (0)
#define PG8_XMMA1(ai, bj) do { if constexpr (F8 == 1) { PG8_MMA8(ai, bj, At8, B18); } else if constexpr (F8 == 2) { PG8_MMA16(ai, bj, At16, B116); } else { PG8_MMA(ai, bj, At, B1); } } while (0)
#define PG8_WAIT_V(n) asm volatile("s_waitcnt vmcnt(" #n ")" ::: "memory")
#define PG8_WAIT_V8R PG8_WAIT_V(8)
#define PG8_WAIT_L(n) asm volatile("s_waitcnt lgkmcnt(" #n ")" ::: "memory")
#define PG8_BAR __builtin_amdgcn_s_barrier()
#define PG8_SCHED __builtin_amdgcn_sched_barrier(0)
#define PG8_AOFFS(dst, u) do { if constexpr (GATHER) { int t2_ = tid; asm volatile("" : "+v"(t2_)); _Pragma("unroll") for (int _i = 0; _i < 2; ++_i) { int R_, C_; stage_rc(t2_ * 16 + _i * 8192, R_, C_); if (F8 == 1) C_ ^= ((R_ >> 4) & 1) << 3; \
        _Pragma("unroll") for (int _h = 0; _h < 2; ++_h) dst[_h][_i] = S.row_off(u, _h * HALF + R_) + (unsigned)(C_ * 2); } } } while (0)
#define PG8_TOKDMA(u) do { int t2_ = tid; asm volatile("" : "+v"(t2_)); _Pragma("unroll") for (int _i = 0; _i < 2; ++_i) { int R_, C_; stage_rc(t2_ * 16 + _i * 8192, R_, C_); \
        _Pragma("unroll") for (int _h = 0; _h < 2; ++_h) __builtin_amdgcn_global_load_lds((const unsigned*)S.tok_ptr(u, _h * HALF + R_), (PG8_LAS unsigned*)(anb + (_h * 2 + _i) * 2048 + wid * 256), 4, 0, 0); } } while (0)
#define PG8_STAGE_A(bufoff, gp, h, o0, o1) do { if constexpr (GATHER) { PG8_STAGE2(bufoff, gp, o0, o1); } else { PG8_STAGE(bufoff, (gp) + (h) * hstep, voffA); } } while (0)
    Unit cur, nxt; int ui = 0;
    if (!S.next(0, cur)) return;
    f32x4 acc[2][2][4][2];
#pragma unroll
    for (int a = 0; a < 2; ++a)
#pragma unroll
        for (int b = 0; b < 2; ++b)
#pragma unroll
            for (int m = 0; m < 4; ++m)
#pragma unroll
                for (int n = 0; n < 2; ++n) acc[a][b][m][n] = (f32x4){0.f, 0.f, 0.f, 0.f};
    bf16x8 At[4][2], B0[2][2], B1[2][2];
    f32x16 acc8[2][2][2]; i32x8 At8[2][2], B08[2], B18[2], At16[4], B016[2], B116[2];
    int sc_w = 0, sc_x = 0; if constexpr (F8 != 0) { sc_w = Epi::SCALE_W; sc_x = Epi::SCALE_X; asm volatile("" : "+v"(sc_w), "+v"(sc_x)); }
#pragma unroll
    for (int a = 0; a < 2; ++a)
#pragma unroll
        for (int b = 0; b < 2; ++b)
#pragma unroll
            for (int m = 0; m < 2; ++m) acc8[a][b][m] = f32x16{};
    const char* cA = S.a_base(cur); const char* cB = S.b_base(cur);
    PG8_AOFFS(ac, cur);
    if constexpr (GATHER) {
        Unit u1_; if (S.next(1, u1_)) { PG8_TOKDMA(u1_); } else { PG8_TOKDMA(cur); }
    }
    PG8_LAS unsigned char* epib = lds + STAGE_BYTES + 11264;
    if constexpr (F8 == 1) { int ln_e = lane; asm volatile("" : "+v"(ln_e)); E.epidma(cur, epib, wid, ln_e); }
    PG8_STAGE(PG8_SB(0, 0), cB, voffB); PG8_STAGE(PG8_SB(0, 1), cB + hstep, voffB); PG8_STAGE_A(PG8_SA(0, 0), cA, 0, ac[0][0], ac[0][1]); PG8_STAGE_A(PG8_SA(0, 1), cA, 1, ac[1][0], ac[1][1]);
    if (wr == 1) PG8_BAR;
    PG8_WAIT_V(2); PG8_BAR;
#if PG8_BAL
    PG8_STAGE(PG8_SB(1, 1), cB + hstep + kstep, voffB); PG8_STAGE_A(PG8_SA(1, 0), cA + kstep, 0, ac[0][0], ac[0][1]);
    PG8_WAIT_V(4); PG8_BAR;
#else
    PG8_STAGE(PG8_SB(1, 0), cB + kstep, voffB); PG8_STAGE_A(PG8_SA(1, 0), cA + kstep, 0, ac[0][0], ac[0][1]); PG8_STAGE(PG8_SB(1, 1), cB + hstep + kstep, voffB);
    PG8_WAIT_V(6); PG8_BAR;
#endif
    bool fresh = false;
    for (;;) {
        float pre[4] = {0.f, 0.f, 0.f, 0.f};
        if constexpr (F8 == 1) { E.prefetch(cur, wr, lane & 31, pre); }
        const bool has_next = S.next(ui + 1, nxt);
        const char* nA = has_next ? S.a_base(nxt) : cA; const char* nB = has_next ? S.b_base(nxt) : cB;
        for (int t = 0; t < nt; t += 2) {
            const bool last = (t == nt - 2);
            if constexpr (MIDK) { if (t == Epi::MIDK_T) { int fr_e = fr, fq_e = fq; asm volatile("" : "+v"(fr_e), "+v"(fq_e)); E.midk(acc, cur, wr, fr_e, fq_e); } }
            const char* a1 = cA + (size_t)((t + 1) & (nt0 - 1)) * kstep;
            const char* a2 = last ? nA : cA + (size_t)((t + 2) & (nt0 - 1)) * kstep; const char* b2 = last ? nB : cB + (size_t)((t + 2) & (nt0 - 1)) * kstep;
            const char* a3 = a2 + kstep; const char* b3 = b2 + kstep;
            unsigned o00 = ac[0][0], o01 = ac[0][1], o10 = ac[1][0], o11 = ac[1][1];
            if constexpr (GATHER) { if (last) { int t2_ = tid; asm volatile("" : "+v"(t2_));
#pragma unroll
                for (int _i = 0; _i < 2; ++_i) { int R_, C_; stage_rc(t2_ * 16 + _i * 8192, R_, C_); if (F8 == 1) C_ ^= ((R_ >> 4) & 1) << 3;
#pragma unroll
                    for (int _h = 0; _h < 2; ++_h) an[_h][_i] = *(const PG8_LAS unsigned*)(anb + (_h * 2 + _i) * 2048 + t2_ * 4) * (unsigned)(K * 2) + (unsigned)(C_ * 2); }
                o00 = an[0][0]; o01 = an[0][1]; o10 = an[1][0]; o11 = an[1][1]; } }
#if PG8_BAL
            const char* b1 = cB + (size_t)((t + 1) & (nt0 - 1)) * kstep;
            PG8_XLDB0(0, 0); PG8_XLDB1(0, 1); PG8_SCHED; PG8_XLDA(0, 0); PG8_STAGE(PG8_SB(1, 0), b1, voffB); PG8_STAGE_A(PG8_SA(1, 1), a1, 1, ac[1][0], ac[1][1]);
            PG8_WAIT_V(8); PG8_WAIT_L(0); PG8_BAR; PG8_XMMA0(0, 0); PG8_XMMA1(0, 1); PG8_BAR; PG8_SCHED;
            PG8_XLDA(0, 1); PG8_STAGE(PG8_SB(0, 1), b2 + hstep, voffB); PG8_STAGE_A(PG8_SA(0, 0), a2, 0, o00, o01);
            PG8_WAIT_V(6); PG8_WAIT_L(0); PG8_BAR; PG8_XMMA0(1, 0); PG8_XMMA1(1, 1); PG8_BAR; PG8_SCHED;
            PG8_XLDB0(1, 0); PG8_XLDB1(1, 1); PG8_SCHED; PG8_XLDA(1, 0); PG8_STAGE(PG8_SB(0, 0), b2, voffB); PG8_STAGE_A(PG8_SA(0, 1), a2, 1, o10, o11);
            PG8_WAIT_V(8); PG8_WAIT_L(0); PG8_BAR; PG8_XMMA0(0, 0); PG8_XMMA1(0, 1); PG8_BAR; PG8_SCHED;
            PG8_XLDA(1, 1); PG8_STAGE(PG8_SB(1, 1), b3 + hstep, voffB); PG8_STAGE_A(PG8_SA(1, 0), a3, 0, o00, o01);
            PG8_WAIT_V(6); PG8_WAIT_L(0); PG8_BAR; PG8_XMMA0(1, 0); PG8_XMMA1(1, 1); PG8_BAR; PG8_SCHED;
#else
            PG8_DMAFIRST_A(PG8_STAGE_A(PG8_SA(1, 1), a1, 1, ac[1][0], ac[1][1])); PG8_XLDB0(0, 0); PG8_XLDB1(0, 1); PG8_SCHED; PG8_XLDA(0, 0); PG8_DMAFIRST_B(PG8_STAGE_A(PG8_SA(1, 1), a1, 1, ac[1][0], ac[1][1]));
            PG8_WAIT_V8R; PG8_WAIT_L(0); PG8_BAR; PG8_XMMA0(0, 0); PG8_XMMA1(0, 1); PG8_BAR; PG8_SCHED;
            PG8_DMAFIRST_B(PG8_XLDA(0, 1)); PG8_STAGE(PG8_SB(0, 0), b2, voffB); PG8_STAGE(PG8_SB(0, 1), b2 + hstep, voffB); PG8_STAGE_A(PG8_SA(0, 0), a2, 0, o00, o01); PG8_DMAFIRST_A(PG8_XLDA(0, 1));
            PG8_WAIT_V8R; PG8_WAIT_L(0); PG8_BAR; PG8_XMMA0(1, 0); PG8_XMMA1(1, 1); PG8_BAR; PG8_SCHED;
            PG8_DMAFIRST_A(PG8_STAGE_A(PG8_SA(0, 1), a2, 1, o10, o11)); PG8_XLDB0(1, 0); PG8_XLDB1(1, 1); PG8_SCHED; PG8_XLDA(1, 0); PG8_DMAFIRST_B(PG8_STAGE_A(PG8_SA(0, 1), a2, 1, o10, o11));
            PG8_WAIT_V(8); PG8_WAIT_L(0); PG8_BAR; PG8_XMMA0(0, 0); PG8_XMMA1(0, 1); PG8_BAR; PG8_SCHED;
            PG8_DMAFIRST_B(PG8_XLDA(1, 1)); PG8_STAGE(PG8_SB(1, 0), b3, voffB); PG8_STAGE(PG8_SB(1, 1), b3 + hstep, voffB); PG8_STAGE_A(PG8_SA(1, 0), a3, 0, o00, o01); PG8_DMAFIRST_A(PG8_XLDA(1, 1));
            PG8_WAIT_V(8); PG8_WAIT_L(0); PG8_BAR; PG8_XMMA0(1, 0); PG8_XMMA1(1, 1); PG8_BAR; PG8_SCHED;
#endif
        }
#ifdef PROBE_EPI
        unsigned long long pe0_ = 0; if (Epi::PID == PROBE_EPI) pe0_ = __builtin_amdgcn_s_memrealtime();
#endif
        if (wr == 0) PG8_BAR;
        if constexpr (F8 == 1) { int r32_e = lane & 31, hi_e = lane >> 5; asm volatile("" : "+v"(r32_e), "+v"(hi_e)); E(acc8, cur, wr, wc, r32_e, hi_e, pre, epib + (ui & 1) * 2048); }
        else { int fr_e = fr, fq_e = fq; asm volatile("" : "+v"(fr_e), "+v"(fq_e)); E(acc, cur, wr, wc, fr_e, fq_e); }
        if constexpr (GATHER) { Unit u2_; if (S.next(ui + 2, u2_)) { PG8_TOKDMA(u2_); } }
        if constexpr (F8 == 1) { if (has_next) { int ln_e = lane; asm volatile("" : "+v"(ln_e)); E.epidma(nxt, epib + ((ui + 1) & 1) * 2048, wid, ln_e); } }
        if (!has_next) break;
#pragma unroll
        for (int a = 0; a < 2; ++a)
#pragma unroll
            for (int b = 0; b < 2; ++b)
#pragma unroll
                for (int m = 0; m < 4; ++m)
#pragma unroll
                    for (int n = 0; n < 2; ++n) acc[a][b][m][n] = (f32x4){0.f, 0.f, 0.f, 0.f};
#pragma unroll
        for (int a = 0; a < 2; ++a)
#pragma unroll
            for (int b = 0; b < 2; ++b)
#pragma unroll
                for (int m = 0; m < 2; ++m) acc8[a][b][m] = f32x16{};
        cur = nxt; cA = nA; cB = nB; ++ui; fresh = true;
        if constexpr (GATHER) {
#pragma unroll
            for (int _h = 0; _h < 2; ++_h)
#pragma unroll
                for (int _i = 0; _i < 2; ++_i) ac[_h][_i] = an[_h][_i];
        }
        if (wr == 1) PG8_BAR;
#ifdef PROBE_EPI
        if (Epi::PID == PROBE_EPI && tid == 0) { PG8_LAS unsigned long long* pa_ = (PG8_LAS unsigned long long*)(lds + STAGE_BYTES + 384); *pa_ += __builtin_amdgcn_s_memrealtime() - pe0_; }
#endif
    }
    PG8_WAIT_V(0);
    PG8_BAR;
#undef PG8_SA
#undef PG8_SB
#undef PG8_STAGE
#undef PG8_STAGE2
#undef PG8_LDA
#undef PG8_LDB
#undef PG8_MMA
#undef PG8_WAIT_V
#undef PG8_WAIT_L
#undef PG8_WAIT_V8R
#undef PG8_BAR
#undef PG8_SCHED
#undef PG8_AOFFS
#undef PG8_TOKDMA
#undef PG8_XLDA
#undef PG8_XLDB0
#undef PG8_XLDB1
#undef PG8_XMMA0
#undef PG8_XMMA1
#undef PG8_LDA8
#undef PG8_LDB8
#undef PG8_MMA8
#undef PG8_LDA16
#undef PG8_LDB16
#undef PG8_MMA16
#undef PG8_STAGE_A
}
}
namespace attn_body {
using bf16=__hip_bfloat16;
using bf16x8=__attribute__((ext_vector_type(8)))short;
using s16x4=__attribute__((ext_vector_type(4)))short;
using f32x16=__attribute__((ext_vector_type(16)))float;
using u32x4=__attribute__((ext_vector_type(4)))unsigned;
constexpr int BATCH=8,NHEAD=8,SEQ=4096,D=64,DM=NHEAD*D,ODM=1024;
constexpr int NW=8,QBLK=32,QB=QBLK*NW,KVBLK=64,NQB=SEQ/QB;
constexpr int ATTN_PITCH=DM, ATTN_UNIT_ROWS=QB;
__device__ __forceinline__ int crow(int r,int hi){return (r&3)+8*(r>>2)+4*hi;}
#define SBAR() __builtin_amdgcn_sched_barrier(0)
__device__ __forceinline__ void cmask(f32x16&p0,f32x16&p1,int jb,int qrel,int hi){
  const float NEG=-INFINITY; int kb=64*jb+4*hi;
  #pragma unroll
  for(int r=0;r<16;++r){int kv=kb+(r&3)+8*(r>>2); if(kv>qrel)p0[r]=NEG; if(kv+32>qrel)p1[r]=NEG;}
}

constexpr int NSLOT=3, SLOTB=8192;
constexpr int LDS_K=0, LDS_V=NSLOT*SLOTB, LDS_WS=2*NSLOT*SLOTB, LDS_OST=LDS_WS+NW*64*4, LDS_KX=86016, LDS_BYTES=LDS_KX+SEQ*8;
constexpr float C2=0.125f*1.4426950408889634f;
__device__ __forceinline__ void glds16(const void*gsrc,unsigned lds_dst){unsigned keep;
  asm volatile("s_mov_b32 %0, m0\n\ts_mov_b32 m0, %2\n\ts_nop 0\n\tglobal_load_lds_dwordx4 %1, off\n\ts_mov_b32 m0, %0":"=&s"(keep):"v"(gsrc),"s"(lds_dst):"memory");}
__device__ __forceinline__ float max3f(float a,float b,float c){float r;asm("v_max3_f32 %0, %1, %2, %3":"=v"(r):"v"(a),"v"(b),"v"(c));return r;}
__device__ __forceinline__ float max2f(float a,float b){float r;asm("v_max_f32_e32 %0, %1, %2":"=v"(r):"v"(a),"v"(b));return r;}
__device__ __forceinline__ float fadd_s(float a,float b){float r;asm("v_add_f32_e32 %0, %1, %2":"=v"(r):"v"(a),"v"(b));return r;}
__device__ __forceinline__ float fsub_s(float a,float b){float r;asm("v_sub_f32_e32 %0, %1, %2":"=v"(r):"v"(a),"v"(b));return r;}
typedef float f32x2_t __attribute__((ext_vector_type(2))); typedef __bf16 bf16x2_t __attribute__((ext_vector_type(2)));
__device__ __forceinline__ unsigned cvtpk_s(float lo,float hi){f32x2_t v={lo,hi};bf16x2_t b=__builtin_convertvector(v,bf16x2_t);return __builtin_bit_cast(unsigned,b);}
#define WAIT_BAR(N) asm volatile("s_waitcnt vmcnt(" #N ") lgkmcnt(0)\n\ts_barrier":::"memory")


typedef unsigned kx2_t __attribute__((ext_vector_type(2)));
__device__ __forceinline__ unsigned f2bf_(float f){unsigned u=__builtin_bit_cast(unsigned,f);return (u+0x7fffu+((u>>16)&1u))>>16;}
__device__ __forceinline__ float bf2f_(unsigned h){return __builtin_bit_cast(float,h<<16);}
__device__ __forceinline__ bf16x8 mk_qx(float mhat,int hi){ const float nm=-mhat; const unsigned h=f2bf_(nm); const float r1=nm-bf2f_(h); const unsigned m=f2bf_(r1); const float r2=r1-bf2f_(m); const unsigned l=f2bf_(r2);
  u32x4 w; w.x=hi?0u:0x3F803F80u; w.y=hi?0u:(0x3F80u|(h<<16)); w.z=hi?0u:(m|(l<<16)); w.w=0u; return __builtin_bit_cast(bf16x8,w); }
__device__ __forceinline__ bf16x8 mk_kx(kx2_t k,int hi){ (void)hi; u32x4 w; w.x=k.x; w.y=k.y; w.z=0x3F803F80u; w.w=0u; return __builtin_bit_cast(bf16x8,w); }
__device__ __forceinline__ void qkt(f32x16&p0,f32x16&p1,const char*Kslot,const bf16x8*qr,const bf16x8 qx,const bf16x8 kxa,const bf16x8 kxb,int r32,int hi){
  p0=__builtin_amdgcn_mfma_f32_32x32x16_bf16(kxa,qx,f32x16{},0,0,0);p1=__builtin_amdgcn_mfma_f32_32x32x16_bf16(kxb,qx,f32x16{},0,0,0);
  const char*kb=Kslot+hi*1024+r32*16;
  #pragma unroll
  for(int d0=0;d0<4;++d0){
    const bf16x8 b0=*reinterpret_cast<const bf16x8*>(kb+d0*2048);
    const bf16x8 b1=*reinterpret_cast<const bf16x8*>(kb+d0*2048+512);
    p0=__builtin_amdgcn_mfma_f32_32x32x16_bf16(b0,qr[d0],p0,0,0,0);p1=__builtin_amdgcn_mfma_f32_32x32x16_bf16(b1,qr[d0],p1,0,0,0);}
}
typedef __attribute__((address_space(3))) const char* lds_cptr;
typedef short v4i16_t __attribute__((ext_vector_type(4)));
__device__ __forceinline__ void kload8(bf16x8*kf,lds_cptr kp){
  kf[0]=*(const __attribute__((address_space(3))) bf16x8*)(kp);      kf[1]=*(const __attribute__((address_space(3))) bf16x8*)(kp+512);
  kf[2]=*(const __attribute__((address_space(3))) bf16x8*)(kp+2048); kf[3]=*(const __attribute__((address_space(3))) bf16x8*)(kp+2560);
  kf[4]=*(const __attribute__((address_space(3))) bf16x8*)(kp+4096); kf[5]=*(const __attribute__((address_space(3))) bf16x8*)(kp+4608);
  kf[6]=*(const __attribute__((address_space(3))) bf16x8*)(kp+6144); kf[7]=*(const __attribute__((address_space(3))) bf16x8*)(kp+6656);
}
__device__ __forceinline__ void kload2(bf16x8*kf,lds_cptr kp,int j){ kf[2*j]=*(const __attribute__((address_space(3))) bf16x8*)(kp+j*2048); kf[2*j+1]=*(const __attribute__((address_space(3))) bf16x8*)(kp+j*2048+512); }
__device__ __forceinline__ s16x4 vtr(lds_cptr p){ return __builtin_bit_cast(s16x4,__builtin_amdgcn_ds_read_tr16_b64_v4i16((__attribute__((address_space(3))) v4i16_t*)p)); }
__device__ __forceinline__ float rowmax(const f32x16&p0,const f32x16&p1){
  float a=max3f(p0[0],p0[1],p1[0]),b=max3f(p0[2],p0[3],p1[1]);a=max3f(a,p1[2],p1[3]);
  #pragma unroll
  for(int r=4;r<16;r+=4){a=max3f(a,p0[r],p0[r+1]);b=max3f(b,p0[r+2],p0[r+3]);a=max3f(a,p1[r],p1[r+1]);b=max3f(b,p1[r+2],p1[r+3]);}
  const float m=max2f(a,b);
  auto rr=__builtin_amdgcn_permlane32_swap(__float_as_uint(m),__float_as_uint(m),false,false);
  return max2f(__uint_as_float(rr[0]),__uint_as_float(rr[1]));
}
__device__ __forceinline__ void pv(f32x16*o,int vb,bf16x8 pa0,bf16x8 pa1,bf16x8 pa2,bf16x8 pa3){
  #pragma unroll
  for(int d0=0;d0<2;++d0){s16x4 lo[4],hi[4];
    #pragma unroll
    for(int ks=0;ks<4;++ks){
      asm volatile("ds_read_b64_tr_b16 %0,%1 offset:%c2":"=&v"(lo[ks]):"v"(vb),"i"(d0*4096+ks*1024):"memory");
      asm volatile("ds_read_b64_tr_b16 %0,%1 offset:%c2":"=&v"(hi[ks]):"v"(vb),"i"(d0*4096+ks*1024+512):"memory");}
    asm volatile("s_waitcnt lgkmcnt(0)":::"memory");SBAR();
    #define PK(k) (bf16x8){lo[k][0],lo[k][1],lo[k][2],lo[k][3],hi[k][0],hi[k][1],hi[k][2],hi[k][3]}
    o[d0]=__builtin_amdgcn_mfma_f32_32x32x16_bf16(pa0,PK(0),o[d0],0,0,0);
    o[d0]=__builtin_amdgcn_mfma_f32_32x32x16_bf16(pa1,PK(1),o[d0],0,0,0);
    o[d0]=__builtin_amdgcn_mfma_f32_32x32x16_bf16(pa2,PK(2),o[d0],0,0,0);
    o[d0]=__builtin_amdgcn_mfma_f32_32x32x16_bf16(pa3,PK(3),o[d0],0,0,0);
    #undef PK
  }
}

#ifndef ATTN_STORE16
#define ATTN_STORE16(p,v) (*(u32x4*)(p)=(v))
#endif
template<int THRL> __device__ __forceinline__ void attn_unit(int b,int h,int qb,const bf16*Q,const bf16*__restrict__ K,const bf16*__restrict__ V,bf16*O,float*OSS,char*shm,const int tid_in,const float theta,unsigned*grab_ctr,unsigned&grabbed){
  int tid_=tid_in; asm volatile("":"+v"(tid_)); const int tid=tid_,lane=tid&63,r32=lane&31,hi=lane>>5; const int wid=__builtin_amdgcn_readfirstlane(tid>>6);
  const long rowbase=(long)b*SEQ; const int q0=qb*QB;
  const bf16*Qw=Q+(rowbase+q0+wid*QBLK)*DM+h*D;
  int t0=0; { const __attribute__((address_space(3))) kx2_t*kb_=(const __attribute__((address_space(3))) kx2_t*)((lds_cptr)shm+LDS_KX);
    auto bias_at=[&](int k)->float{ const kx2_t e=kb_[k]; return bf2f_(e.x&0xffffu)+bf2f_(e.x>>16)+bf2f_(e.y&0xffffu); };
    const float lim=bias_at(q0)-theta; int lo_=0,hi_=((q0+QB)/KVBLK-4)>>1;
    while(lo_<hi_){ const int mid_=(lo_+hi_+1)>>1; if(bias_at(128*mid_-1)<=lim)lo_=mid_; else hi_=mid_-1; }
    t0=__builtin_amdgcn_readfirstlane(2*lo_); }
  const bf16*Kh=K+(rowbase+(long)t0*KVBLK)*DM+h*D,*Vh=V+(rowbase+(long)t0*KVBLK)*DM+h*D;
  const unsigned lds0=(unsigned)(uintptr_t)shm;
  float*wsf=(float*)(shm+LDS_WS)+wid*64;
  const bf16*ksrc=Kh+(long)lane*DM+wid*8;
  const bf16*vsrc=Vh+(long)(16*(wid&3)+(lane>>2))*DM+(wid>>2)*32+(lane&3)*8;
  const unsigned kdst=lds0+LDS_K+wid*1024, vdst=lds0+LDS_V+wid*1024;
  #define DMA_K(t,slot) glds16(ksrc+(long)(t)*KVBLK*DM,(unsigned)__builtin_amdgcn_readfirstlane(kdst+(slot)))
  #define DMA_V(t,slot) glds16(vsrc+(long)(t)*KVBLK*DM,(unsigned)__builtin_amdgcn_readfirstlane(vdst+(slot)))
  const int vb0=(int)(lds0+LDS_V)+((lane>>4)&1)*32+(lane&3)*8+(4*hi+((lane&15)>>2))*64;
  const char*Kbase=shm+LDS_K; bf16x8 kf[8];
  const lds_cptr shm3=(lds_cptr)shm; const lds_cptr kp0=shm3+LDS_K+hi*1024+r32*16; const lds_cptr vp0=shm3+LDS_V+((lane>>4)&1)*32+(lane&3)*8+(4*hi+((lane&15)>>2))*64;
  const int NT=(q0+QB)/KVBLK-t0;
  DMA_K(0,0);DMA_V(0,0);DMA_K(1,SLOTB);
  bf16x8 qr[4];
  #pragma unroll
  for(int d0=0;d0<4;++d0)qr[d0]=__builtin_nontemporal_load((const __attribute__((address_space(1))) bf16x8*)(const void*)(&Qw[(long)r32*DM+d0*16+hi*8]));
  float mhat=0.f,l_reg=0.f;f32x16 o[2];o[0]=f32x16{};o[1]=f32x16{};bf16x8 qx=mk_qx(0.f,hi);asm volatile("":"+v"(qx));
  const __attribute__((address_space(3))) kx2_t*kxt=(const __attribute__((address_space(3))) kx2_t*)(shm3+LDS_KX)+r32+64*t0;
  const int qrel=wid*QBLK+r32;
  #define CMASK(P0,P1,t) do{int jb_=(t)-(NT-4); if(jb_>=0)cmask(P0,P1,jb_,qrel,hi);}while(0)
  bool resc=false;
  #define START(P0,P1) do{ const float rm=rowmax(P0,P1); resc=false; \
    { const float dl=rm; mhat=fadd_s(mhat,dl); \
      _Pragma("unroll") for(int r=0;r<16;++r){P0[r]=fsub_s(P0[r],dl);P1[r]=fsub_s(P1[r],dl);} \
      qx=mk_qx(mhat,hi); asm volatile("":"+v"(qx)); } \
    _Pragma("unroll") for(int r=0;r<16;++r)P0[r]=__builtin_amdgcn_exp2f(P0[r]); }while(0)
  #define RESC() do{ if(resc){ asm volatile("s_waitcnt lgkmcnt(0)":::"memory"); \
      _Pragma("unroll") for(int d_=0;d_<2;++d_) _Pragma("unroll") for(int r=0;r<16;++r)o[d_][r]*=wsf[crow(r,hi)]; } }while(0)
  f32x16 pA0,pA1,pB0,pB1;
  int sl_prev=0,sl_cur=0,sl_next=SLOTB;
  #define ROT() do{sl_prev=sl_cur;sl_cur=sl_next;sl_next=(sl_next==(NSLOT-1)*SLOTB)?0:sl_next+SLOTB;}while(0)
  DMA_K(2,2*SLOTB);
  WAIT_BAR(3);
  {const kx2_t ka_=kxt[0],kb_=kxt[32]; qkt(pA0,pA1,Kbase,qr,qx,mk_kx(ka_,hi),mk_kx(kb_,hi),r32,hi);}asm volatile("s_nop 15\n\ts_nop 7":"+v"(pA0),"+v"(pA1));CMASK(pA0,pA1,0);
  START(pA0,pA1);
  _Pragma("unroll") for(int r=0;r<16;++r)pA1[r]=__builtin_amdgcn_exp2f(pA1[r]);
  WAIT_BAR(0);
  DMA_K(3,0);DMA_V(1,SLOTB);
  ROT();
  kload8(kf,kp0+sl_cur);
  WAIT_BAR(2);
  s16x4 vlo[8],vhi[8]; u32x4 pw0,pw1,pw2,pw3;
  #define PKW(P,B) cvtpk_s(P[B],P[B+1])
  #define PAF(k) __builtin_bit_cast(bf16x8,pw##k)
  #define VFR(i) (bf16x8){vlo[i][0],vlo[i][1],vlo[i][2],vlo[i][3],vhi[i][0],vhi[i][1],vhi[i][2],vhi[i][3]}
  #define PIN(x) asm volatile("":"+v"(x))
  #define MX3(a,b,c) __builtin_fmaxf(__builtin_fmaxf((a),(b)),(c))
  #define GAPA(MF,A0,A1,A2,A3,W0,W1,PW) do{ MF; sacc+=A0; sacc+=A1; sacc+=A2; sacc+=A3; PIN(sacc); W0; W1; PIN(PW); SBAR(); }while(0)
  #define EX(v) __builtin_amdgcn_exp2f(v)
  #define GAPB(MF,X,B) do{ MF; X[B]=EX(X[B]); X[B+1]=EX(X[B+1]); X[B+2]=EX(X[B+2]); X[B+3]=EX(X[B+3]); PIN(X); SBAR(); }while(0)
  #define VRD(i) do{ vlo[i]=vtr(vp_+(((i)>>2)*4096+((i)&3)*1024)); vhi[i]=vtr(vp_+(((i)>>2)*4096+((i)&3)*1024+512)); }while(0)
  #define KRD(G,j) do{ if(G){ kload2(kf,kp0+sl_next,j); SBAR(); } }while(0)
  #define STEP(C0,C1,P0,P1,t,GK,GV,GL) do{ SBAR(); \
    const lds_cptr vp_=vp0+sl_prev; \
    { const kx2_t ka_=kxt[64*(t)],kb_=kxt[64*(t)+32]; C0=__builtin_amdgcn_mfma_f32_32x32x16_bf16(mk_kx(ka_,hi),qx,f32x16{},0,0,0); C1=__builtin_amdgcn_mfma_f32_32x32x16_bf16(mk_kx(kb_,hi),qx,f32x16{},0,0,0); } SBAR(); \
    VRD(0); SBAR(); float sacc=(P0[0]+P0[1]); \
    GAPA(C0=__builtin_amdgcn_mfma_f32_32x32x16_bf16(kf[0],qr[0],C0,0,0,0), P0[2],P0[3],P0[4],P0[5],     pw0[0]=PKW(P0,0), pw0[1]=PKW(P0,2), pw0); \
    VRD(4); SBAR(); GAPA(C1=__builtin_amdgcn_mfma_f32_32x32x16_bf16(kf[1],qr[0],C1,0,0,0), P0[6],P0[7],P0[8],P0[9],     pw0[2]=PKW(P0,4), pw0[3]=PKW(P0,6), pw0); \
    VRD(1); SBAR(); GAPA(C0=__builtin_amdgcn_mfma_f32_32x32x16_bf16(kf[2],qr[1],C0,0,0,0),   P0[10],P0[11],P0[12],P0[13], pw1[0]=PKW(P0,8), pw1[1]=PKW(P0,10), pw1); \
    VRD(5); SBAR(); GAPA(C1=__builtin_amdgcn_mfma_f32_32x32x16_bf16(kf[3],qr[1],C1,0,0,0),   P0[14],P0[15],P1[0],P1[1],   pw1[2]=PKW(P0,12),pw1[3]=PKW(P0,14), pw1); \
    VRD(2); SBAR(); GAPA(C0=__builtin_amdgcn_mfma_f32_32x32x16_bf16(kf[4],qr[2],C0,0,0,0),   P1[2],P1[3],P1[4],P1[5],     pw2[0]=PKW(P1,0), pw2[1]=PKW(P1,2), pw2); \
    VRD(6); SBAR(); GAPA(C1=__builtin_amdgcn_mfma_f32_32x32x16_bf16(kf[5],qr[2],C1,0,0,0),   P1[6],P1[7],P1[8],P1[9],     pw2[2]=PKW(P1,4), pw2[3]=PKW(P1,6), pw2); \
    VRD(3); SBAR(); GAPA(C0=__builtin_amdgcn_mfma_f32_32x32x16_bf16(kf[6],qr[3],C0,0,0,0),   P1[10],P1[11],P1[12],P1[13], pw3[0]=PKW(P1,8), pw3[1]=PKW(P1,10), pw3); \
    VRD(7); SBAR(); GAPA(C1=__builtin_amdgcn_mfma_f32_32x32x16_bf16(kf[7],qr[3],C1,0,0,0),   P1[14],P1[15],0.f,0.f,       pw3[2]=PKW(P1,12),pw3[3]=PKW(P1,14), pw3); \
    l_reg+=sacc; \
    if(GK){DMA_K((t)+3,sl_cur);} if(GV){DMA_V((t)+1,sl_next);} \
    CMASK(C0,C1,t); \
    { float a=MX3(C0[0],C0[1],C1[0]),b=MX3(C0[2],C0[3],C1[1]); a=MX3(a,C1[2],C1[3]); \
      _Pragma("unroll") for(int r=4;r<16;r+=4){a=MX3(a,C0[r],C0[r+1]);b=MX3(b,C0[r+2],C0[r+3]);a=MX3(a,C1[r],C1[r+1]);b=MX3(b,C1[r+2],C1[r+3]);} \
      float rm=__builtin_fmaxf(a,b); { auto rr=__builtin_amdgcn_permlane32_swap(__float_as_uint(rm),__float_as_uint(rm),false,false); rm=__builtin_fmaxf(__uint_as_float(rr[0]),__uint_as_float(rr[1])); } \
      resc=false; \
      if(__builtin_expect(__any(rm>(float)THRL),0)){ const float dl=__builtin_fmaxf(rm,0.f); mhat+=dl; \
        _Pragma("unroll") for(int r=0;r<16;++r){C0[r]-=dl;C1[r]-=dl;} \
        qx=mk_qx(mhat,hi); asm volatile("":"+v"(qx)); \
        const float f=__builtin_amdgcn_exp2f(-dl); l_reg*=f; if(hi==0)wsf[r32]=f; resc=true; } } \
    SBAR(); \
    GAPB(o[0]=__builtin_amdgcn_mfma_f32_32x32x16_bf16(PAF(0),VFR(0),o[0],0,0,0), C0,0); \
    GAPB(o[1]=__builtin_amdgcn_mfma_f32_32x32x16_bf16(PAF(0),VFR(4),o[1],0,0,0), C0,4); \
    KRD(GL,0); GAPB(o[0]=__builtin_amdgcn_mfma_f32_32x32x16_bf16(PAF(1),VFR(1),o[0],0,0,0), C0,8); \
    KRD(GL,1); GAPB(o[1]=__builtin_amdgcn_mfma_f32_32x32x16_bf16(PAF(1),VFR(5),o[1],0,0,0), C0,12); \
    KRD(GL,2); GAPB(o[0]=__builtin_amdgcn_mfma_f32_32x32x16_bf16(PAF(2),VFR(2),o[0],0,0,0), C1,0); \
    KRD(GL,3); GAPB(o[1]=__builtin_amdgcn_mfma_f32_32x32x16_bf16(PAF(2),VFR(6),o[1],0,0,0), C1,4); \
    GAPB(o[0]=__builtin_amdgcn_mfma_f32_32x32x16_bf16(PAF(3),VFR(3),o[0],0,0,0), C1,8); \
    GAPB(o[1]=__builtin_amdgcn_mfma_f32_32x32x16_bf16(PAF(3),VFR(7),o[1],0,0,0), C1,12); \
    }while(0)
  int t=1;
  #undef CMASK
  #define CMASK(P0,P1,t) do{}while(0)
  for(;t+5<NT;t+=2){
    STEP(pB0,pB1,pA0,pA1,t,true,true,true);     WAIT_BAR(2); RESC(); ROT();
    STEP(pA0,pA1,pB0,pB1,t+1,true,true,true);   WAIT_BAR(2); RESC(); ROT();
  }
  #undef CMASK
  #define CMASK(P0,P1,t) do{int jb_=(t)-(NT-4); if(jb_>=0)cmask(P0,P1,jb_,qrel,hi);}while(0)
  #define ENDW(tt) do{ if((tt)+3<NT){WAIT_BAR(2);} else if((tt)+2<NT){WAIT_BAR(1);} else {WAIT_BAR(0);} }while(0)
  for(;t+1<NT;t+=2){
    STEP(pB0,pB1,pA0,pA1,t,(t+3<NT),(t+1<NT),(t+1<NT));       ENDW(t);   RESC(); ROT();
    STEP(pA0,pA1,pB0,pB1,t+1,(t+4<NT),(t+2<NT),(t+2<NT));     ENDW(t+1); RESC(); ROT();
  }
  STEP(pB0,pB1,pA0,pA1,NT-1,false,false,false); RESC();
  if(grab_ctr&&tid_in==0) grabbed=__hip_atomic_fetch_add((__attribute__((address_space(1))) unsigned*)grab_ctr,1u,__ATOMIC_RELAXED,__HIP_MEMORY_SCOPE_AGENT);
  { float sacc=pB0[0]+pB0[1]; _Pragma("unroll") for(int r=2;r<16;++r)sacc+=pB0[r]; _Pragma("unroll") for(int r=0;r<16;++r)sacc+=pB1[r]; l_reg+=sacc;
    pw0=(u32x4){PKW(pB0,0),PKW(pB0,2),PKW(pB0,4),PKW(pB0,6)};pw1=(u32x4){PKW(pB0,8),PKW(pB0,10),PKW(pB0,12),PKW(pB0,14)};pw2=(u32x4){PKW(pB1,0),PKW(pB1,2),PKW(pB1,4),PKW(pB1,6)};pw3=(u32x4){PKW(pB1,8),PKW(pB1,10),PKW(pB1,12),PKW(pB1,14)};
    SBAR(); pv(o,vb0+sl_cur,PAF(0),PAF(1),PAF(2),PAF(3)); }
  #undef PKW
  #undef PAF
  #undef VFR
  #undef PIN
  #undef MX3
  #undef GAPA
  #undef GAPB
  #undef EX
  #undef VRD
  #undef KRD
  #undef STEP
  #undef ENDW
  {auto rr=__builtin_amdgcn_permlane32_swap(__float_as_uint(l_reg),__float_as_uint(l_reg),false,false);l_reg=__uint_as_float(rr[0])+__uint_as_float(rr[1]);}
  if(hi==0)wsf[32+r32]=l_reg;asm volatile("s_waitcnt lgkmcnt(0)":::"memory");
  float rli[16];
  #pragma unroll
  for(int r=0;r<16;++r)rli[r]=__builtin_amdgcn_rcpf(wsf[32+crow(r,hi)]);
  bf16*Ow=O+(rowbase+q0+wid*QBLK)*ODM+h*D; float*OSw=OSS+(rowbase+q0+wid*QBLK)*NHEAD+h;
  { bf16*stg=(bf16*)(shm+LDS_OST)+wid*2048;
    #pragma unroll
    for(int r=0;r<16;++r){const int orow=crow(r,hi);
      #pragma unroll
      for(int d0=0;d0<2;++d0)stg[orow*64+d0*32+r32]=__float2bfloat16(o[d0][r]*rli[r]);}
    asm volatile("s_waitcnt lgkmcnt(0)":::"memory");
    #pragma unroll
    for(int i=0;i<4;++i){const int row=i*8+(lane>>3),ch=lane&7; const u32x4 v=*(const u32x4*)(stg+row*64+ch*8); ATTN_STORE16(Ow+(long)row*ODM+ch*8,v);
      float ss=0.f; _Pragma("unroll") for(int j=0;j<4;++j){const float a=__uint_as_float(v[j]<<16),b2=__uint_as_float(v[j]&0xffff0000u); ss+=a*a+b2*b2;}
      ss+=__int_as_float(__builtin_amdgcn_ds_bpermute((lane^1)<<2,__float_as_int(ss)));ss+=__int_as_float(__builtin_amdgcn_ds_bpermute((lane^2)<<2,__float_as_int(ss)));ss+=__int_as_float(__builtin_amdgcn_ds_bpermute((lane^4)<<2,__float_as_int(ss))); if(ch==0)OSw[(long)row*NHEAD]=ss;} }
  asm volatile("s_waitcnt lgkmcnt(0)\n\ts_barrier":::"memory");
  #undef DMA_K
  #undef DMA_V
  #undef CMASK
  #undef START
  #undef RESC
  #undef ROT
}
constexpr int ATTN_LDS_BYTES=LDS_BYTES;
struct AttnTensors { const bf16* Q; const bf16* K; const bf16* V; bf16* O; float* OSS; };
struct AttnUnit { int bh; int qb; };
struct StaticOrder {
  int vcu;
  __device__ __forceinline__ explicit StaticOrder(int v):vcu(v){}
  __device__ __forceinline__ bool next(int i,AttnUnit&u)const{ if(i>=4)return false; const int s=vcu&3; u.bh=vcu>>2; u.qb=(i==0)?s:(i==1)?15-s:(i==2)?4+s:11-s; return true; }
  __device__ __forceinline__ void a_ready(const AttnUnit&)const{}
  __device__ __forceinline__ void done(const AttnUnit&)const{}
};
template<class Sched,int THRL=8> __device__ __forceinline__ void attn_phase(char*lds,const AttnTensors&T,const Sched&S,const int tid_in){
  AttnUnit u;
  for(int i=0;S.next(i,u);++i){ S.a_ready(u); { unsigned g_=0u; attn_unit<THRL>(u.bh/NHEAD,u.bh%NHEAD,u.qb,T.Q,T.K,T.V,T.O,T.OSS,lds,tid_in,0.f,nullptr,g_); } S.done(u); }
}
#undef SBAR
#undef WAIT_BAR
}
constexpr int NWAVES = 8;
constexpr int T = 32768, DM = 1024, SEQ = 4096, NBATCH = 8, NLAYER = 2, NHEADS = 8, NEXP = 32, INC = 2568, NIN = 2560, PLE = 256, MAXTILES = 544;
constexpr float EPS = 1e-5f, LOG2E = 1.4426950408889634f;
constexpr int NSTEPS = 2 + 8 * NLAYER;
#ifndef FP8_SHAPE
#define FP8_SHAPE 32
#endif
#ifndef ATT_PREGRAB
#define ATT_PREGRAB 0
#endif
#ifndef ATT_LATEGRAB
#define ATT_LATEGRAB 1
#endif
#ifndef RD1_NT
#define RD1_NT 1
#endif
#ifndef FIN_NT
#define FIN_NT 1
#endif
#ifndef P0_NT
#define P0_NT 0
#endif
#ifndef ATT_SKIP_T
#define ATT_SKIP_T 40.0f
#endif
#ifndef MK_PER_STEP
#define MK_PER_STEP 0
#endif

constexpr size_t MiB = 1u << 20;
constexpr size_t WS_CTL = 0, CTL_ZERO_BYTES = 1 * MiB;
constexpr size_t WS_WFB = 1 * MiB, WS_WRB = WS_WFB + 128 * 1024, WS_WSB = WS_WRB + 128 * 1024;
constexpr size_t WS_WIN = 2 * MiB, WS_WOUT = 12 * MiB, WS_WPG = 16 * MiB, WS_WPLE = 20 * MiB, WS_WGU = 32 * MiB, WS_WDN = 288 * MiB;
constexpr size_t WS_HBA = 416 * MiB, WS_HBB = 480 * MiB;
constexpr size_t WS_SSQX = 544 * MiB, WS_SSQY = 546 * MiB;
constexpr size_t WS_LF = 548 * MiB, WS_OSS = 549 * MiB, WS_RINV = 550 * MiB, WS_TOPE = 551 * MiB, WS_GATE = 551 * MiB + 512 * 1024, WS_LISTS = 552 * MiB  , WS_GSS = 550 * MiB + 512 * 1024;
constexpr size_t WS_U = 560 * MiB, SEG_BYTES = 32 * MiB;
constexpr size_t WS_YC = 720 * MiB;
constexpr size_t WS_ACT = 784 * MiB, WS_YS = 1056 * MiB;
constexpr size_t WS_PB = 1328 * MiB, WS_E = 1360 * MiB, WS_H8 = 1488 * MiB, WS_END = 1520 * MiB;
constexpr int CW_BAR = 4096;
constexpr int CW_NORM = 24576;
constexpr int CW_AQ = 32768;
constexpr int CW_CONV = 65536;
#ifndef P1_F8
#define P1_F8 0
#endif
#ifndef CONV_IN_P2
#define CONV_IN_P2 1
#endif
#ifndef EPI_DMA6
#define EPI_DMA6 1
#endif
#ifndef CONV_DMA
#define CONV_DMA 0
#endif
#ifndef CONV_DMA_AUX
#define CONV_DMA_AUX 0
#endif
#ifndef CONV_BUF
#define CONV_BUF 0
#endif
#ifndef E_F8
#define E_F8 1
#endif
#ifndef P_IN_P2
#define P_IN_P2 1
#endif
#ifndef CONV_WG
#define CONV_WG 1
#endif
#ifndef CONV_XCD
#define CONV_XCD 0
#endif
#ifndef CONV_NUM
#define CONV_NUM 3
#endif
constexpr int CW_CNT = 16384;

constexpr int RING_OFF = 0, RING_BYTES = 131072;
constexpr int LDSCTL_OFF = RING_BYTES, MISC_OFF = LDSCTL_OFF + 320;
constexpr int LCNT_OFF = LDSCTL_OFF + 512, LTST_OFF = LCNT_OFF + 128, LTILES_OFF = LTST_OFF + 256;
constexpr int LDS_BYTES = 147456;
static_assert(LTILES_OFF + MAXTILES * 4 <= LDS_BYTES, "LDS map");

#define GAS __attribute__((address_space(1)))
#define LAS __attribute__((address_space(3)))
typedef unsigned short bf16;
typedef unsigned v4u __attribute__((ext_vector_type(4)));
typedef float f32x4 __attribute__((ext_vector_type(4)));
typedef short bf16x8 __attribute__((ext_vector_type(8)));
typedef GAS unsigned gu32;
typedef GAS unsigned long long gu64;
#define RLX_AGENT __ATOMIC_RELAXED, __HIP_MEMORY_SCOPE_AGENT
#define LDS_WAIT() asm volatile("s_waitcnt lgkmcnt(0)" ::: "memory")
#define VM_WAIT() asm volatile("s_waitcnt vmcnt(0)" ::: "memory")
__device__ __forceinline__ unsigned long long rt() { return __builtin_amdgcn_s_memrealtime(); }
__device__ __forceinline__ unsigned f2bf(float f) { unsigned u = __builtin_bit_cast(unsigned, f); return (u + 0x7fffu + ((u >> 16) & 1u)) >> 16; }
__device__ __forceinline__ unsigned pk2(float lo, float hi) { return f2bf(lo) | (f2bf(hi) << 16); }

#define XB_TMO      128
#define XB_XCNT(j)  (256  + 64 * (j))
#define XB_XSUB(j)  (1280 + 64 * (j))
#define XB_XGEN(j)  (2304 + 64 * (j))
#define XB_TOP      3328
#define XB_TOPGEN   3392
#define XCD_BAR_WORDS 3456
#define XB_SPIN_CAP (1u << 18)

__device__ __forceinline__ unsigned xb_ld(unsigned* p)              { return __hip_atomic_load(p, __ATOMIC_RELAXED, __HIP_MEMORY_SCOPE_AGENT); }
__device__ __forceinline__ unsigned xb_add(unsigned* p, unsigned v) { return __hip_atomic_fetch_add(p, v, __ATOMIC_RELAXED, __HIP_MEMORY_SCOPE_AGENT); }
__device__ __forceinline__ unsigned xb_xcc_id() { return (unsigned)__builtin_amdgcn_s_getreg((3 << 11) | 20) & 0xFu; }
#define XB_SPIN(cond, bar) do { unsigned _sp = 0; while (cond) { __builtin_amdgcn_s_sleep(1); \
    if ((++_sp & 255u) == 0u) { if (xb_ld(&(bar)[XB_TMO])) break; if (_sp > XB_SPIN_CAP) { atomicAdd(&(bar)[XB_TMO], 1u); break; } } } } while (0)

struct XcdBarrier {
    unsigned* bar; unsigned x;
    volatile LAS unsigned* st;
    int wave;
};

__device__ __forceinline__ XcdBarrier xcd_barrier_post(unsigned* bar, volatile LAS unsigned* st) {
    XcdBarrier b; b.bar = bar; b.x = (unsigned)__builtin_amdgcn_readfirstlane((int)xb_xcc_id()); b.st = st;     b.wave = __builtin_amdgcn_readfirstlane((int)(threadIdx.x >> 6));
    if (threadIdx.x == 0) (void)xb_add(&bar[XB_XCNT(b.x)], 1u);
    return b;
}
__device__ __forceinline__ void xcd_barrier_complete(unsigned* bar, unsigned x, unsigned& nloc, unsigned& nx) {
    const unsigned G = gridDim.x * gridDim.y * gridDim.z;
    unsigned sum, cnt, mine, sp = 0u;
    for (;;) {
        sum = 0u; cnt = 0u; mine = 0u;
#pragma unroll
        for (unsigned j = 0; j < 16; ++j) { const unsigned c = xb_ld(&bar[XB_XCNT(j)]); sum += c; cnt += (c > 0u) ? 1u : 0u; mine = (j == x) ? c : mine; }
        if (sum == G) break;
        __builtin_amdgcn_s_sleep(1);
        if ((++sp & 255u) == 0u) { if (xb_ld(&bar[XB_TMO])) break; if (sp > XB_SPIN_CAP) { atomicAdd(&bar[XB_TMO], 1u); break; } }
    }
    nloc = mine > 0u ? mine : 1u; nx = cnt > 0u ? cnt : 1u;
}

__device__ __forceinline__ void xcd_barrier(const XcdBarrier& b) {
    asm volatile("s_waitcnt vmcnt(0)" ::: "memory");
    __syncthreads();
    unsigned ln_; asm volatile("v_mbcnt_lo_u32_b32 %0, -1, 0\n\tv_mbcnt_hi_u32_b32 %0, -1, %0" : "=v"(ln_));
    if (b.wave == 0 && ln_ == 0u) {
        GAS unsigned* barg_ = (GAS unsigned*)b.bar; asm volatile("" : "+s"(barg_)); unsigned* bar = (unsigned*)barg_; unsigned bx_ = b.x; asm volatile("" : "+s"(bx_));
        __builtin_amdgcn_s_waitcnt(0);
        unsigned nloc = b.st[0], nx = b.st[1];
        if (nloc == 0u) { xcd_barrier_complete(bar, bx_, nloc, nx); b.st[0] = nloc; b.st[1] = nx; }
        const unsigned old = xb_add(&bar[XB_XSUB(bx_)], 1u);
        const unsigned gen = old / nloc;
        if (old + 1u == (gen + 1u) * nloc) {
            __builtin_amdgcn_fence(__ATOMIC_RELEASE, "agent");
            asm volatile("s_waitcnt vmcnt(0)" ::: "memory");
            const unsigned og = xb_add(&bar[XB_TOP], 1u);
            const unsigned tg = og / nx;
            if (og + 1u == (tg + 1u) * nx) xb_add(&bar[XB_TOPGEN], 1u);
            else XB_SPIN(xb_ld(&bar[XB_TOPGEN]) == tg, bar);
            __builtin_amdgcn_fence(__ATOMIC_ACQUIRE, "agent");
            xb_add(&bar[XB_XGEN(bx_)], 1u);
            asm volatile("s_waitcnt vmcnt(0)" ::: "memory");
        } else {
            XB_SPIN(xb_ld(&bar[XB_XGEN(bx_)]) == gen, bar);
            __builtin_amdgcn_fence(__ATOMIC_ACQUIRE, "agent");
            asm volatile("s_waitcnt vmcnt(0)" ::: "memory");
        }
    }
    __syncthreads();
}
struct Frame {
    LAS unsigned char* lds;
    volatile LAS unsigned* MISC;
    gu32* ctl;
    int tid, lane, wave;
    int vcu, G, bx;
    float* H; unsigned char* ws;
};
__device__ __forceinline__ int mk_tid(int wave) { int t; asm volatile("v_mbcnt_lo_u32_b32 %0, -1, 0\n\tv_mbcnt_hi_u32_b32 %0, -1, %0\n\tv_lshl_add_u32 %0, %1, 6, %0" : "=&v"(t) : "s"(wave)); return t; }
__device__ __forceinline__ const float* ld_inp(int k) { const GAS float* p; asm volatile("s_load_dwordx2 %0, %1, %2\n\ts_waitcnt lgkmcnt(0)" : "=s"(p) : "s"(__builtin_amdgcn_kernarg_segment_ptr()), "s"(k * 8) : "memory"); return (const float*)p; }
#define INP(k) ld_inp(k)
__device__ __forceinline__ float shx(float v, int o, int lane) { return __int_as_float(__builtin_amdgcn_ds_bpermute((lane ^ o) << 2, __float_as_int(v))); }
__device__ __forceinline__ float wave_sum(float v, int lane) {
#pragma unroll
    for (int o = 1; o < 64; o <<= 1) v += shx(v, o, lane);
    return v;
}
__device__ __forceinline__ float bf_lo(unsigned w) { return __uint_as_float(w << 16); }
__device__ __forceinline__ float bf_hi(unsigned w) { return __uint_as_float(w & 0xffff0000u); }
__device__ __forceinline__ float sigmoidf_(float x) { return __builtin_amdgcn_rcpf(1.0f + __builtin_amdgcn_exp2f(-x * LOG2E)); }

#define GM_JOIN16(a) asm volatile("s_waitcnt lgkmcnt(0)" : "+v"(a[0]), "+v"(a[1]), "+v"(a[2]), "+v"(a[3]), "+v"(a[4]), "+v"(a[5]), "+v"(a[6]), "+v"(a[7]), "+v"(a[8]), "+v"(a[9]), "+v"(a[10]), "+v"(a[11]), "+v"(a[12]), "+v"(a[13]), "+v"(a[14]), "+v"(a[15]))
using pg8::f32x2; using pg8::u32x4; using pg8::u32x2; using pg8::bf16_t; using pg8::Unit; using pg8::cvt_pk_bf16;
__device__ __forceinline__ void rows_rinv(const float* ssq16, int rowbase, int fq, int lane, float (&rv)[2][4]) {
    f32x4 p[8];
#pragma unroll
    for (int k = 0; k < 8; ++k) p[k] = *(const f32x4*)((const char*)ssq16 + ((unsigned)(rowbase + (k >> 2) * 128 + (k & 3) * 16) * 64u + 16u * (unsigned)fq));
    asm volatile("" : "+v"(p[0]), "+v"(p[1]), "+v"(p[2]), "+v"(p[3]), "+v"(p[4]), "+v"(p[5]), "+v"(p[6]), "+v"(p[7]));
    float sv[8], tv[8];
#pragma unroll
    for (int k = 0; k < 8; ++k) sv[k] = (p[k][0] + p[k][1]) + (p[k][2] + p[k][3]);
#pragma unroll
    for (int o = 16; o <= 32; o <<= 1) {
#pragma unroll
        for (int k = 0; k < 8; ++k) tv[k] = shx(sv[k], o, lane);
        asm volatile("s_waitcnt lgkmcnt(0)" : "+v"(tv[0]), "+v"(tv[1]), "+v"(tv[2]), "+v"(tv[3]), "+v"(tv[4]), "+v"(tv[5]), "+v"(tv[6]), "+v"(tv[7]));
#pragma unroll
        for (int k = 0; k < 8; ++k) sv[k] += tv[k]; }
#pragma unroll
    for (int k = 0; k < 8; ++k) rv[k >> 2][k & 3] = rsqrtf(sv[k] * (1.0f / DM) + EPS);
}
#define GP(T_, base, boff) ((T_*)((char*)(base) + (unsigned)(boff)))
#define GPC(T_, base, boff) ((const T_*)((const char*)(base) + (unsigned)(boff)))
#ifndef ST_AUX
#define ST_AUX 0
#endif
__device__ __forceinline__ void st16(void* base, unsigned boff, u32x4 v) {
#if ST_AUX
    __builtin_amdgcn_raw_buffer_store_b128(v, __builtin_amdgcn_make_buffer_rsrc(base, 0, 0x7fffffff, 0x00020000), boff, 0, ST_AUX);
#else
    *GP(u32x4, base, boff) = v;
#endif
}
struct EpiIn {
    static constexpr bool PERM = true; static constexpr int PID = 1; static constexpr int NST = 16;
    bf16_t* O; const float* ssq16; gu32* norm;
    __device__ __forceinline__ void operator()(const f32x4 (&acc)[2][2][4][2], const Unit& u, int wr, int wc, int fr, int fq) const {
        const int row0 = u.pm * 256 + wr * 64 + fr, seg = u.pn >> 1; float nmx[2] = {0.f, 0.f};
        bf16_t* base = O + (size_t)seg * (SEG_BYTES / 2);
        const unsigned cb = (unsigned)((u.pn & 1) * 256 + wc * 32 + 8 * fq) * 2u;
        float rv[2][4]; rows_rinv(ssq16, row0, fq, fq * 16 + fr, rv);
#pragma unroll
        for (int ai = 0; ai < 2; ++ai)
#pragma unroll
            for (int m = 0; m < 4; ++m) { const unsigned ob = (unsigned)(row0 + ai * 128 + m * 16) * 1024u + cb; const float r = rv[ai][m];
#pragma unroll
                for (int bj = 0; bj < 2; ++bj) { f32x4 v0 = acc[ai][bj][m][0] * r, v1 = acc[ai][bj][m][1] * r;
                    if (seg < 2) { f32x2 a = pg8::gelu_pk((f32x2){v0[0], v0[1]}), b = pg8::gelu_pk((f32x2){v0[2], v0[3]}), c = pg8::gelu_pk((f32x2){v1[0], v1[1]}), d = pg8::gelu_pk((f32x2){v1[2], v1[3]});
                        v0 = (f32x4){a.x, a.y, b.x, b.y}; v1 = (f32x4){c.x, c.y, d.x, d.y}; }
                    else if (seg == 2) { v0 = v0 * attn_body::C2; v1 = v1 * attn_body::C2; }
                    if (seg == 2 || seg == 3) { float s = ((v0[0] * v0[0] + v0[1] * v0[1]) + (v0[2] * v0[2] + v0[3] * v0[3])) + ((v1[0] * v1[0] + v1[1] * v1[1]) + (v1[2] * v1[2] + v1[3] * v1[3]));
                        s += shx(s, 16, fq * 16 + fr); s += shx(s, 32, fq * 16 + fr); nmx[bj] = fmaxf(nmx[bj], s); }
                    u32x4 w; w.x = cvt_pk_bf16(v0[0], v0[1]); w.y = cvt_pk_bf16(v0[2], v0[3]); w.z = cvt_pk_bf16(v1[0], v1[1]); w.w = cvt_pk_bf16(v1[2], v1[3]);
                    *GP(u32x4, base, ob + bj * 256) = w; }
                asm volatile("" ::: "memory"); }
        if (seg == 2 || seg == 3) {
#pragma unroll
            for (int bj = 0; bj < 2; ++bj) { float s = nmx[bj];
#pragma unroll
                for (int o = 1; o < 16; o <<= 1) s = fmaxf(s, shx(s, o, fq * 16 + fr));
                if (fr == 0 && fq == 0) __hip_atomic_fetch_max(norm + ((((seg - 2) * 8 + (u.pm >> 4)) * 8 + (u.pn & 1) * 4 + bj * 2 + (wc >> 1)) * 2 + (wc & 1)), __float_as_uint(s * 1.02f), __ATOMIC_RELAXED, __HIP_MEMORY_SCOPE_AGENT); } }
    }
};
struct EpiBf {
    static constexpr bool PERM = true; static constexpr int PID = 0; static constexpr int NST = 16;
    bf16_t* O; const float* bias; int bias_estride; size_t o_estride;
    __device__ __forceinline__ void operator()(const f32x4 (&acc)[2][2][4][2], const Unit& u, int wr, int wc, int fr, int fq) const {
        const int row0 = u.pm * 256 + wr * 64 + fr, col0 = u.pn * 256 + wc * 32 + 8 * fq;
        f32x4 bv[2][2];
#pragma unroll
        for (int bj = 0; bj < 2; ++bj)
#pragma unroll
            for (int n = 0; n < 2; ++n) bv[bj][n] = bias ? *GPC(f32x4, bias, (unsigned)(u.e * bias_estride + col0 + bj * 128 + 4 * n) * 4u) : (f32x4){0.f, 0.f, 0.f, 0.f};
#pragma unroll
        for (int ai = 0; ai < 2; ++ai)
#pragma unroll
            for (int m = 0; m < 4; ++m) { const unsigned ob = ((unsigned)(row0 + ai * 128 + m * 16) * 1024u + (unsigned)col0) * 2u;
#pragma unroll
                for (int bj = 0; bj < 2; ++bj) { const f32x4 v0 = acc[ai][bj][m][0] + bv[bj][0], v1 = acc[ai][bj][m][1] + bv[bj][1];
                    u32x4 w; w.x = cvt_pk_bf16(v0[0], v0[1]); w.y = cvt_pk_bf16(v0[2], v0[3]); w.z = cvt_pk_bf16(v1[0], v1[1]); w.w = cvt_pk_bf16(v1[2], v1[3]);
                    *GP(u32x4, O + (size_t)u.e * o_estride, ob + bj * 256) = w; } }
    }
};
struct EpiSwiglu {
    static constexpr bool PERM = true;
    bf16_t* act; const float* rinv; const int* lists; const LAS int* cnt; const float* bgu;
    __device__ __forceinline__ void operator()(const f32x4 (&acc)[2][2][4][2], const Unit& u, int wr, int wc, int fr, int fq) const {
        const int rl0 = wr * 64 + fr, col8 = u.pn * 128 + wc * 32 + 8 * fq; const int ce = cnt[u.e];
        f32x4 bg[2], bl[2];
#pragma unroll
        for (int n = 0; n < 2; ++n) { bg[n] = *GPC(f32x4, bgu, (unsigned)(u.e * 2048 + col8 + 4 * n) * 4u); bl[n] = *GPC(f32x4, bgu, (unsigned)(u.e * 2048 + 1024 + col8 + 4 * n) * 4u); }
#pragma unroll
        for (int ai = 0; ai < 2; ++ai)
#pragma unroll
            for (int m = 0; m < 4; ++m) { const int rl = rl0 + ai * 128 + m * 16, rr = u.mt * 256 + rl; const int tok = (rr < ce) ? *GPC(int, lists, (unsigned)(u.e * 32768 + rr) * 4u) : 0; const float r = *GPC(float, rinv, (unsigned)tok * 4u);
                u32x4 w; unsigned wv[4];
#pragma unroll
                for (int n = 0; n < 2; ++n) { float a[4];
#pragma unroll
                    for (int i = 0; i < 4; ++i) { float g = acc[ai][0][m][n][i] * r + bg[n][i], li = acc[ai][1][m][n][i] * r + bl[n][i];
                        g = fminf(g, 7.0f); li = fminf(fmaxf(li, -7.0f), 7.0f); a[i] = g * sigmoidf_(1.702f * g) * (li + 1.0f); }
                    wv[2 * n] = cvt_pk_bf16(a[0], a[1]); wv[2 * n + 1] = cvt_pk_bf16(a[2], a[3]); }
                w.x = wv[0]; w.y = wv[1]; w.z = wv[2]; w.w = wv[3];
                *GP(u32x4, act, ((unsigned)(u.pm * 256 + rl) * 1024u + (unsigned)col8) * 2u) = w;
                asm volatile("" ::: "memory"); }
    }
};
using pg8::f32x16;
__device__ __forceinline__ unsigned pk4_fp8(float a, float b, float c, float d) { int w = 0; w = __builtin_amdgcn_cvt_pk_fp8_f32(a, b, w, false); w = __builtin_amdgcn_cvt_pk_fp8_f32(c, d, w, true); return (unsigned)w; }
__device__ __forceinline__ float clamp448(float v) { return __builtin_amdgcn_fmed3f(v, -448.0f, 448.0f); }
struct EpiSwiglu8 {
    static constexpr bool PERM = true; static constexpr int PID = 5; static constexpr int NST = 4; static constexpr int SCALE_W = 0x79797979, SCALE_X = 0x7F7F7F7F;
    unsigned char* act8; const float* rinv; const int* lists; const LAS int* cnt; const float* bgu;
    __device__ __forceinline__ void prefetch(const Unit&, int, int, float (&)[4]) const {}
    __device__ __forceinline__ void epidma(const Unit& u, LAS unsigned char* buf, int wid, int lane) const {
        if (wid < 4) { const int ce = cnt[u.e]; int rr = u.mt * 256 + wid * 64 + lane; rr = rr < ce ? rr : ce - 1;
            __builtin_amdgcn_global_load_lds((const unsigned*)(lists + 2 * (u.e * 32768 + rr) + 1), (LAS unsigned*)(buf + wid * 256), 4, 0, 0); }
        else { const int idx = (wid - 4) * 64 + lane;
            __builtin_amdgcn_global_load_lds((const unsigned*)(bgu + u.e * 2048 + (idx >> 7) * 1024 + u.pn * 128 + (idx & 127)), (LAS unsigned*)(buf + 1024 + (wid - 4) * 256), 4, 0, 0); }
    }
    __device__ __forceinline__ void operator()(const f32x16 (&acc)[2][2][2], const Unit& u, int wr, int wc, int r32, int hi, const float (&)[4], const LAS unsigned char* ep) const {
        const int cbase = u.pn * 128 + wc * 32 + 16 * hi;
#pragma unroll
        for (int ai = 0; ai < 2; ++ai)
#pragma unroll
            for (int m = 0; m < 2; ++m) { const int rl = ai * 128 + wr * 64 + m * 32 + r32;
#ifdef PROBE_K2
                const float r = 0.5f * *(const LAS float*)(ep + rl * 4);
#else
                const float r = *(const LAS float*)(ep + rl * 4);
#endif
                u32x4 w; unsigned wv[4];
#pragma unroll
                for (int q = 0; q < 4; ++q) { f32x2 a2[2];
                    const f32x4 bgq = *(const LAS f32x4*)(ep + 1024 + (wc * 32 + 16 * hi + 4 * q) * 4), blq = *(const LAS f32x4*)(ep + 1536 + (wc * 32 + 16 * hi + 4 * q) * 4);
#pragma unroll
                    for (int i = 0; i < 2; ++i) { f32x2 g = (f32x2){acc[ai][0][m][4 * q + 2 * i], acc[ai][0][m][4 * q + 2 * i + 1]} * r + (f32x2){bgq[2 * i], bgq[2 * i + 1]};
                        f32x2 li = (f32x2){acc[ai][1][m][4 * q + 2 * i], acc[ai][1][m][4 * q + 2 * i + 1]} * r + (f32x2){blq[2 * i], blq[2 * i + 1]};
                        g.x = fminf(g.x, 7.0f); g.y = fminf(g.y, 7.0f); li.x = __builtin_amdgcn_fmed3f(li.x, -7.0f, 7.0f); li.y = __builtin_amdgcn_fmed3f(li.y, -7.0f, 7.0f);
                        const f32x2 x = g * (-1.702f * LOG2E); f32x2 e; e.x = __builtin_amdgcn_exp2f(x.x); e.y = __builtin_amdgcn_exp2f(x.y); e = e + 1.0f;
                        f32x2 s; s.x = __builtin_amdgcn_rcpf(e.x); s.y = __builtin_amdgcn_rcpf(e.y);
                        a2[i] = (g * s) * (li + 1.0f); }
                    wv[q] = pk4_fp8(a2[0].x, a2[0].y, a2[1].x, a2[1].y); }
                w.x = wv[0]; w.y = wv[1]; w.z = wv[2]; w.w = wv[3];
                st16(act8, (unsigned)(u.pm * 256 + rl) * 1024u + (unsigned)cbase, w); }
    }
};
struct EpiDown8 {
    static constexpr bool PERM = true; static constexpr int NST = 8; static constexpr int PID = 6; static constexpr int SCALE_W = 0x79797979, SCALE_X = 0x7F7F7F7F;
    unsigned char* O; const float* bias;
    __device__ __forceinline__ void prefetch(const Unit&, int, int, float (&)[4]) const {}
    __device__ __forceinline__ void epidma(const Unit& u, LAS unsigned char* buf, int wid, int lane) const {
        if (EPI_DMA6 && wid == 0) __builtin_amdgcn_global_load_lds((const unsigned*)(bias + u.e * 1024 + u.pn * 256 + 4 * lane), (LAS unsigned*)buf, 16, 0, 0);
    }
    __device__ __forceinline__ void operator()(const f32x16 (&acc)[2][2][2], const Unit& u, int wr, int wc, int r32, int hi, const float (&)[4], const LAS unsigned char* ep) const {
#pragma unroll
        for (int bj = 0; bj < 2; ++bj) { const int col0 = u.pn * 256 + bj * 128 + wc * 32 + 16 * hi; f32x4 bv[2][4];
#pragma unroll
            for (int q = 0; q < 4; ++q) bv[bj][q] = EPI_DMA6 ? *(const LAS f32x4*)(ep + (bj * 128 + wc * 32 + 16 * hi + 4 * q) * 4) : *GPC(f32x4, bias, (unsigned)(u.e * 1024 + u.pn * 256 + bj * 128 + wc * 32 + 16 * hi + 4 * q) * 4u);
#pragma unroll
            for (int ai = 0; ai < 2; ++ai)
#pragma unroll
                for (int m = 0; m < 2; ++m) { const unsigned row = (unsigned)(u.pm * 256 + ai * 128 + wr * 64 + m * 32 + r32); u32x4 w; unsigned wv[4];
#pragma unroll
                    for (int q = 0; q < 4; ++q) wv[q] = pk4_fp8(clamp448(acc[ai][bj][m][4 * q] + bv[bj][q][0]), clamp448(acc[ai][bj][m][4 * q + 1] + bv[bj][q][1]), clamp448(acc[ai][bj][m][4 * q + 2] + bv[bj][q][2]), clamp448(acc[ai][bj][m][4 * q + 3] + bv[bj][q][3]));
                    w.x = wv[0]; w.y = wv[1]; w.z = wv[2]; w.w = wv[3];
                    st16(O, row * 1024u + (unsigned)col0, w); } }
    }
};
struct EpiE8 {
    static constexpr bool PERM = true; static constexpr int PID = 0; static constexpr int NST = 16;
    unsigned char* O; size_t o_estride;
    __device__ __forceinline__ void operator()(const f32x4 (&acc)[2][2][4][2], const Unit& u, int wr, int wc, int fr, int fq) const {
        const int row0 = u.pm * 256 + wr * 64 + fr, col0 = u.pn * 256 + wc * 32 + 8 * fq;
#pragma unroll
        for (int ai = 0; ai < 2; ++ai)
#pragma unroll
            for (int m = 0; m < 4; ++m) { const unsigned ob = (unsigned)(row0 + ai * 128 + m * 16) * 1024u + (unsigned)col0;
#pragma unroll
                for (int bj = 0; bj < 2; ++bj) { const f32x4 v0 = acc[ai][bj][m][0], v1 = acc[ai][bj][m][1];
                    u32x2 w; w.x = pk4_fp8(clamp448(v0[0]), clamp448(v0[1]), clamp448(v0[2]), clamp448(v0[3])); w.y = pk4_fp8(clamp448(v1[0]), clamp448(v1[1]), clamp448(v1[2]), clamp448(v1[3]));
                    *GP(u32x2, O + (size_t)u.e * o_estride, ob + bj * 128) = w; } }
    }
};
struct EpiIn8 {
    static constexpr bool PERM = true; static constexpr int PID = 1; static constexpr int NST = 16; static constexpr int SCALE_W = 0x79797979, SCALE_X = 0x7F7F7F7F;
    bf16_t* O; const float* ssq16; gu32* norm;
    __device__ __forceinline__ void prefetch(const Unit&, int, int, float (&)[4]) const {}
    __device__ __forceinline__ void epidma(const Unit&, LAS unsigned char*, int, int) const {}
    __device__ __forceinline__ void operator()(const f32x16 (&acc)[2][2][2], const Unit& u, int wr, int wc, int r32, int hi, const float (&)[4], const LAS unsigned char*) const {
        const int row0 = u.pm * 256 + wr * 64 + r32, seg = u.pn >> 1, lane = hi * 32 + r32; float nmx[2] = {0.f, 0.f};
        bf16_t* base = O + (size_t)seg * (SEG_BYTES / 2);
        const unsigned cb = (unsigned)((u.pn & 1) * 256 + wc * 32 + 16 * hi) * 2u;
        float rv[2][2];
#pragma unroll
        for (int ai = 0; ai < 2; ++ai)
#pragma unroll
            for (int m = 0; m < 2; ++m) { const unsigned rb = (unsigned)(row0 + ai * 128 + m * 32) * 64u + 32u * (unsigned)hi; const f32x4 p0 = *GPC(f32x4, ssq16, rb), p1 = *GPC(f32x4, ssq16, rb + 16u);
                float s = ((p0[0] + p0[1]) + (p0[2] + p0[3])) + ((p1[0] + p1[1]) + (p1[2] + p1[3])); s += shx(s, 32, lane); rv[ai][m] = rsqrtf(s * (1.0f / DM) + EPS); }
#pragma unroll
        for (int ai = 0; ai < 2; ++ai)
#pragma unroll
            for (int m = 0; m < 2; ++m) { const unsigned ob = (unsigned)(row0 + ai * 128 + m * 32) * 1024u + cb; const float r = rv[ai][m];
#pragma unroll
                for (int bj = 0; bj < 2; ++bj) { f32x2 s2 = (f32x2){0.f, 0.f};
#pragma unroll
                    for (int h = 0; h < 2; ++h) { f32x2 v[4];
#pragma unroll
                        for (int i = 0; i < 4; ++i) v[i] = (f32x2){acc[ai][bj][m][8 * h + 2 * i], acc[ai][bj][m][8 * h + 2 * i + 1]} * r;
                        if (seg < 2) {
#pragma unroll
                            for (int i = 0; i < 4; ++i) v[i] = pg8::gelu_pk(v[i]); }
                        else if (seg == 2) {
#pragma unroll
                            for (int i = 0; i < 4; ++i) v[i] = v[i] * attn_body::C2; }
#pragma unroll
                        for (int i = 0; i < 4; ++i) s2 = s2 + v[i] * v[i];
                        u32x4 w0; w0.x = cvt_pk_bf16(v[0].x, v[0].y); w0.y = cvt_pk_bf16(v[1].x, v[1].y); w0.z = cvt_pk_bf16(v[2].x, v[2].y); w0.w = cvt_pk_bf16(v[3].x, v[3].y);
                        *GP(u32x4, base, ob + bj * 256 + h * 16) = w0; asm volatile("" ::: "memory"); }
                    if (seg == 2 || seg == 3) { float s = s2.x + s2.y; s += shx(s, 32, lane); nmx[bj] = fmaxf(nmx[bj], s); } }
                asm volatile("" ::: "memory"); }
        if (seg == 2 || seg == 3) {
#pragma unroll
            for (int bj = 0; bj < 2; ++bj) { float s = nmx[bj];
#pragma unroll
                for (int o = 1; o < 32; o <<= 1) s = fmaxf(s, shx(s, o, lane));
                if (lane == 0) __hip_atomic_fetch_max(norm + ((((seg - 2) * 8 + (u.pm >> 4)) * 8 + (u.pn & 1) * 4 + bj * 2 + (wc >> 1)) * 2 + (wc & 1)), __float_as_uint(s * 1.02f), __ATOMIC_RELAXED, __HIP_MEMORY_SCOPE_AGENT); } }
    }
};
struct EpiSwiglu16 {
    static constexpr bool PERM = true; static constexpr int NST = 8; static constexpr int PID = 5; static constexpr int SCALE_W = 0x79797979, SCALE_X = 0x7F7F7F7F;
    unsigned char* act8; const int* lists; const LAS int* cnt; const float* bgu;
    __device__ __forceinline__ void operator()(const f32x4 (&acc)[2][2][4][2], const Unit& u, int wr, int wc, int fr, int fq) const {
        const int col8 = u.pn * 128 + wc * 32 + 8 * fq; const int ce = cnt[u.e];
        float rr_[8]; f32x4 bg[2], bl[2];
#pragma unroll
        for (int j = 0; j < 8; ++j) { const int rr = u.mt * 256 + (j >> 2) * 128 + wr * 64 + (j & 3) * 16 + fr; rr_[j] = (rr < ce) ? *GPC(float, lists, (unsigned)(u.e * 32768 + rr) * 8u + 4u) : 0.f; }
#pragma unroll
        for (int n = 0; n < 2; ++n) { bg[n] = *GPC(f32x4, bgu, (unsigned)(u.e * 2048 + col8 + 4 * n) * 4u); bl[n] = *GPC(f32x4, bgu, (unsigned)(u.e * 2048 + 1024 + col8 + 4 * n) * 4u); }
#pragma unroll
        for (int ai = 0; ai < 2; ++ai)
#pragma unroll
            for (int m = 0; m < 4; ++m) { const int rl = ai * 128 + wr * 64 + m * 16 + fr; const float r = rr_[ai * 4 + m]; u32x2 w; unsigned wv[2];
#pragma unroll
                for (int n = 0; n < 2; ++n) { f32x2 a2[2];
#pragma unroll
                    for (int i = 0; i < 2; ++i) { f32x2 g = (f32x2){acc[ai][0][m][n][2 * i], acc[ai][0][m][n][2 * i + 1]} * r + (f32x2){bg[n][2 * i], bg[n][2 * i + 1]};
                        f32x2 li = (f32x2){acc[ai][1][m][n][2 * i], acc[ai][1][m][n][2 * i + 1]} * r + (f32x2){bl[n][2 * i], bl[n][2 * i + 1]};
                        g.x = fminf(g.x, 7.0f); g.y = fminf(g.y, 7.0f); li.x = __builtin_amdgcn_fmed3f(li.x, -7.0f, 7.0f); li.y = __builtin_amdgcn_fmed3f(li.y, -7.0f, 7.0f);
                        const f32x2 x = g * (-1.702f * LOG2E); f32x2 e; e.x = __builtin_amdgcn_exp2f(x.x); e.y = __builtin_amdgcn_exp2f(x.y); e = e + 1.0f;
                        f32x2 s; s.x = __builtin_amdgcn_rcpf(e.x); s.y = __builtin_amdgcn_rcpf(e.y);
                        a2[i] = (g * s) * (li + 1.0f); }
                    wv[n] = pk4_fp8(a2[0].x, a2[0].y, a2[1].x, a2[1].y); }
                w.x = wv[0]; w.y = wv[1];
                *GP(u32x2, act8, (unsigned)(u.pm * 256 + rl) * 1024u + (unsigned)col8) = w; }
    }
};
struct EpiDown16 {
    static constexpr bool PERM = true; static constexpr int NST = 16; static constexpr int PID = 6; static constexpr int SCALE_W = 0x79797979, SCALE_X = 0x7F7F7F7F;
    unsigned char* O; const float* bias;
    __device__ __forceinline__ void operator()(const f32x4 (&acc)[2][2][4][2], const Unit& u, int wr, int wc, int fr, int fq) const {
        f32x4 bv[2][2];
#pragma unroll
        for (int bj = 0; bj < 2; ++bj)
#pragma unroll
            for (int n = 0; n < 2; ++n) bv[bj][n] = *GPC(f32x4, bias, (unsigned)(u.e * 1024 + u.pn * 256 + bj * 128 + wc * 32 + 8 * fq + 4 * n) * 4u);
#pragma unroll
        for (int ai = 0; ai < 2; ++ai)
#pragma unroll
            for (int m = 0; m < 4; ++m) { const unsigned row = (unsigned)(u.pm * 256 + ai * 128 + wr * 64 + m * 16 + fr);
#pragma unroll
                for (int bj = 0; bj < 2; ++bj) { const f32x4 v0 = acc[ai][bj][m][0] + bv[bj][0], v1 = acc[ai][bj][m][1] + bv[bj][1]; u32x2 w;
                    w.x = pk4_fp8(clamp448(v0[0]), clamp448(v0[1]), clamp448(v0[2]), clamp448(v0[3])); w.y = pk4_fp8(clamp448(v1[0]), clamp448(v1[1]), clamp448(v1[2]), clamp448(v1[3]));
                    *GP(u32x2, O, row * 1024u + (unsigned)(u.pn * 256 + bj * 128 + wc * 32 + 8 * fq)) = w; } }
    }
};
struct EpiRes {
    static constexpr bool PERM = true; static constexpr int PID = 3; static constexpr int NST = 32; static constexpr int MIDK_T = 8;
    const bf16_t* res; bf16_t* hb; float* ssq16; const float* oss; const float* gss; unsigned char* h8;
    __device__ __forceinline__ void midk(f32x4 (&acc)[2][2][4][2], const Unit& u, int wr, int fr, int fq) const {
#pragma unroll
        for (int ai = 0; ai < 2; ++ai) { f32x2 a[4]; float gs[4];
#pragma unroll
            for (int m = 0; m < 4; ++m) { const unsigned row = (unsigned)(u.pm * 256 + ai * 128 + wr * 64 + m * 16 + fr); a[m] = *GPC(f32x2, oss, row * 32u + 8u * fq); gs[m] = *GPC(float, gss, row * 4u); }
#pragma unroll
            for (int m = 0; m < 4; ++m) { float s = a[m][0] + a[m][1]; s += shx(s, 16, fq * 16 + fr); s += shx(s, 32, fq * 16 + fr);
                const float f = rsqrtf(s * (1.0f / 512.0f) + EPS) * sqrtf(gs[m] * (1.0f / 512.0f) + EPS);
#pragma unroll
                for (int bj = 0; bj < 2; ++bj)
#pragma unroll
                    for (int n = 0; n < 2; ++n) acc[ai][bj][m][n] = acc[ai][bj][m][n] * f; }
            asm volatile("" ::: "memory"); }
    }
    __device__ __forceinline__ void operator()(const f32x4 (&acc)[2][2][4][2], const Unit& u, int wr, int wc, int fr, int fq) const {
        const int col0 = u.pn * 256 + wc * 32 + 8 * fq;
        u32x4 rv[4][2]; float gs[4];
        auto ld = [&](int k, int sl) { const unsigned row = (unsigned)(u.pm * 256 + (k >> 2) * 128 + wr * 64 + (k & 3) * 16 + fr); const unsigned ob = (row * 1024u + (unsigned)col0) * 2u; gs[sl] = *GPC(float, gss, row * 4u);
#pragma unroll
            for (int bj = 0; bj < 2; ++bj) rv[sl][bj] = *GPC(u32x4, res, ob + (unsigned)(bj * 256)); };
#pragma unroll
        for (int k = 0; k < 4; ++k) ld(k, k);
#pragma unroll
        for (int k = 0; k < 8; ++k) { const int ai = k >> 2, m = k & 3, sl = k & 3;
            const unsigned row = (unsigned)(u.pm * 256 + ai * 128 + wr * 64 + m * 16 + fr); const unsigned ob = (row * 1024u + (unsigned)col0) * 2u; float ss = 0.f;
            const float ra = rsqrtf(gs[sl] * (1.0f / 512.0f) + EPS);
#pragma unroll
            for (int bj = 0; bj < 2; ++bj) { const unsigned o2 = ob + (unsigned)(bj * 256); const u32x4 r = rv[sl][bj]; const f32x4 a0 = acc[ai][bj][m][0] * ra, a1 = acc[ai][bj][m][1] * ra; float o[8];
                o[0] = bf_lo(r.x) + a0[0]; o[1] = bf_hi(r.x) + a0[1]; o[2] = bf_lo(r.y) + a0[2]; o[3] = bf_hi(r.y) + a0[3]; o[4] = bf_lo(r.z) + a1[0]; o[5] = bf_hi(r.z) + a1[1]; o[6] = bf_lo(r.w) + a1[2]; o[7] = bf_hi(r.w) + a1[3];
                u32x4 w; w.x = cvt_pk_bf16(o[0], o[1]); w.y = cvt_pk_bf16(o[2], o[3]); w.z = cvt_pk_bf16(o[4], o[5]); w.w = cvt_pk_bf16(o[6], o[7]); *GP(u32x4, hb, o2) = w;
                u32x2 q8; q8.x = pk4_fp8(clamp448(o[0]), clamp448(o[1]), clamp448(o[2]), clamp448(o[3])); q8.y = pk4_fp8(clamp448(o[4]), clamp448(o[5]), clamp448(o[6]), clamp448(o[7])); *GP(u32x2, h8, o2 >> 1) = q8;
#pragma unroll
                for (int i = 0; i < 8; ++i) ss += o[i] * o[i]; }
            if (k + 4 < 8) ld(k + 4, sl);
            ss += shx(ss, 16, fq * 16 + fr); ss += shx(ss, 32, fq * 16 + fr);
            if (fq == 0) *GP(float, ssq16, (row * 16u + (unsigned)(u.pn * 4 + wc)) * 4u) = ss;
            asm volatile("" ::: "memory"); }
    }
};
struct EpiPle {
    static constexpr bool PERM = true; static constexpr int PID = 8; static constexpr int NST = 16;
    const bf16_t* res; bf16_t* hb; float* ssq_out; const float* ssq_in; const bf16_t* eb;
    __device__ __forceinline__ void operator()(const f32x4 (&acc)[2][2][4][2], const Unit& u, int wr, int wc, int fr, int fq) const {
        const int col0 = u.pn * 256 + wc * 32 + 8 * fq, row0 = u.pm * 256 + wr * 64 + fr;
        u32x4 rr[4][2], ee[4][2];
        auto ld = [&](int k, int sl) { const unsigned ob = ((unsigned)(row0 + (k >> 2) * 128 + (k & 3) * 16) * 1024u + (unsigned)col0) * 2u;
#pragma unroll
            for (int bj = 0; bj < 2; ++bj) { rr[sl][bj] = *GPC(u32x4, res, ob + (unsigned)(bj * 256));
                if (E_F8) { const u32x2 e8 = RD1_NT ? __builtin_nontemporal_load(GPC(u32x2, eb, (ob >> 1) + (unsigned)(bj * 128))) : *GPC(u32x2, eb, (ob >> 1) + (unsigned)(bj * 128)); ee[sl][bj].x = e8.x; ee[sl][bj].y = e8.y; } else ee[sl][bj] = *GPC(u32x4, eb, ob + (unsigned)(bj * 256)); } };
#pragma unroll
        for (int k = 0; k < 4; ++k) ld(k, k);
        float rv[2][4]; rows_rinv(ssq_in, row0, fq, fq * 16 + fr, rv);
#pragma unroll
        for (int k = 0; k < 8; ++k) { const int ai = k >> 2, m = k & 3, sl = k & 3;
            const unsigned row = (unsigned)(row0 + ai * 128 + m * 16); const unsigned ob = (row * 1024u + (unsigned)col0) * 2u; float ss = 0.f; const float sc = rv[ai][m];
#pragma unroll
            for (int bj = 0; bj < 2; ++bj) { const unsigned o2 = ob + (unsigned)(bj * 256); const u32x4 r = rr[sl][bj], ev = ee[sl][bj]; float o[8];
#pragma unroll
                for (int i = 0; i < 4; ++i) { const unsigned rw = i == 0 ? r.x : i == 1 ? r.y : i == 2 ? r.z : r.w, ew = i == 0 ? ev.x : i == 1 ? ev.y : i == 2 ? ev.z : ev.w;
                    const f32x2 a2 = (f32x2){acc[ai][bj][m][i >> 1][2 * (i & 1)], acc[ai][bj][m][i >> 1][2 * (i & 1) + 1]} * (sc * -LOG2E); f32x2 e; e.x = __builtin_amdgcn_exp2f(a2.x); e.y = __builtin_amdgcn_exp2f(a2.y); e = e + 1.0f;
                    f32x2 s; s.x = __builtin_amdgcn_rcpf(e.x); s.y = __builtin_amdgcn_rcpf(e.y);
                    f32x2 e2; if (E_F8) { const unsigned e8w = (i >> 1) ? ev.y : ev.x; e2 = (i & 1) ? __builtin_amdgcn_cvt_pk_f32_fp8((int)e8w, true) : __builtin_amdgcn_cvt_pk_f32_fp8((int)e8w, false); } else e2 = (f32x2){bf_lo(ew), bf_hi(ew)};
                    const f32x2 o2v = (f32x2){bf_lo(rw), bf_hi(rw)} + s * e2; o[2 * i] = o2v.x; o[2 * i + 1] = o2v.y; }
                u32x4 w; w.x = cvt_pk_bf16(o[0], o[1]); w.y = cvt_pk_bf16(o[2], o[3]); w.z = cvt_pk_bf16(o[4], o[5]); w.w = cvt_pk_bf16(o[6], o[7]); *GP(u32x4, hb, o2) = w;
                if (P1_F8) { u32x2 q8; q8.x = pk4_fp8(clamp448(o[0]), clamp448(o[1]), clamp448(o[2]), clamp448(o[3])); q8.y = pk4_fp8(clamp448(o[4]), clamp448(o[5]), clamp448(o[6]), clamp448(o[7])); *GP(u32x2, (unsigned char*)hb + (WS_H8 - WS_HBB), o2 >> 1) = q8; }
#pragma unroll
                for (int i = 0; i < 8; ++i) ss += o[i] * o[i]; }
            if (k + 4 < 8) ld(k + 4, sl);
            ss += shx(ss, 16, fq * 16 + fr); ss += shx(ss, 32, fq * 16 + fr);
            if (fq == 0) *GP(float, ssq_out, (row * 16u + (unsigned)(u.pn * 4 + wc)) * 4u) = ss;
            asm volatile("" ::: "memory"); }
    }
};

struct TrItem { const float* W; bf16* WT; const float* g0; const float* g1; int ldn, KT, k0, n0, krow0, nrow0, gsplit, f8; };
__device__ __forceinline__ void tr_gain(const TrItem& d, float (&g)[8], int lane) {
    if (d.g0) {
#pragma unroll
        for (int i = 0; i < 8; ++i) { const int k = d.k0 + 8 * i + (lane >> 3); const GAS float* gp = (const GAS float*)(k < d.gsplit ? d.g0 + k : d.g1 + (k - d.gsplit)); g[i] = *gp; }
    } else {
#pragma unroll
        for (int i = 0; i < 8; ++i) g[i] = 1.0f;
    }
}
__device__ __forceinline__ void tr_data(const TrItem& d, f32x4 (&v)[8], int lane) {
#if CONV_BUF
    const __amdgpu_buffer_rsrc_t rs = __builtin_amdgcn_make_buffer_rsrc((void*)d.W, 0, 0x40000000, 0x00020000);
    const unsigned vo = (unsigned)((d.k0 + (lane >> 3)) * d.ldn + d.n0 + 4 * (lane & 7)) * 4u;
#pragma unroll
    for (int i = 0; i < 8; ++i) v[i] = __builtin_bit_cast(f32x4, __builtin_amdgcn_raw_buffer_load_b128(rs, vo + (unsigned)(8 * i * d.ldn) * 4u, 0, CONV_BUF));
#else
    const GAS f32x4* src = (const GAS f32x4*)(d.W + (size_t)(d.k0 + (lane >> 3)) * d.ldn + d.n0 + 4 * (lane & 7));
#pragma unroll
    for (int i = 0; i < 8; ++i) v[i] = (P0_NT || RD1_NT) ? __builtin_nontemporal_load((const GAS f32x4*)((const GAS float*)src + (size_t)(8 * i) * d.ldn)) : *(const GAS f32x4*)((const GAS float*)src + (size_t)(8 * i) * d.ldn);
#endif
}
__device__ __forceinline__ void tr_load(const TrItem& d, f32x4 (&v)[8], float (&g)[8], int lane) { tr_gain(d, g, lane); tr_data(d, v, lane); }
__device__ __forceinline__ void tr_store(const TrItem& d, const f32x4 (&v)[8], const float (&g)[8], LAS float* scr, int lane) {
    const float gm = d.f8 ? 64.0f : 1.0f;
#pragma unroll
    for (int i = 0; i < 8; ++i) { const f32x4 w = v[i] * (g[i] * gm);
#pragma unroll
        for (int j = 0; j < 4; ++j) scr[(4 * (lane & 7) + j) * 65 + 8 * i + (lane >> 3)] = w[j]; }
    LDS_WAIT(); asm volatile("" ::: "memory");
    const int n16 = lane >> 2, qt = lane & 3; const LAS float* s = scr + n16 * 65 + 16 * qt;
    f32x4 t[8];
#pragma unroll
    for (int q = 0; q < 2; ++q)
#pragma unroll
        for (int e = 0; e < 4; ++e) { t[4 * q + e].x = s[q * 16 * 65 + 4 * e]; t[4 * q + e].y = s[q * 16 * 65 + 4 * e + 1]; t[4 * q + e].z = s[q * 16 * 65 + 4 * e + 2]; t[4 * q + e].w = s[q * 16 * 65 + 4 * e + 3]; }
    asm volatile("s_waitcnt lgkmcnt(0)" : "+v"(t[0]), "+v"(t[1]), "+v"(t[2]), "+v"(t[3]), "+v"(t[4]), "+v"(t[5]), "+v"(t[6]), "+v"(t[7]) :: "memory");
    if (d.f8) {
#pragma unroll
        for (int q = 0; q < 2; ++q) { unsigned char* dst8 = (unsigned char*)d.WT + (size_t)(d.nrow0 + n16 + 16 * q) * d.KT + d.krow0 + 16 * qt;
            v4u o; o.x = pk4_fp8(t[4 * q].x, t[4 * q].y, t[4 * q].z, t[4 * q].w); o.y = pk4_fp8(t[4 * q + 1].x, t[4 * q + 1].y, t[4 * q + 1].z, t[4 * q + 1].w);
            o.z = pk4_fp8(t[4 * q + 2].x, t[4 * q + 2].y, t[4 * q + 2].z, t[4 * q + 2].w); o.w = pk4_fp8(t[4 * q + 3].x, t[4 * q + 3].y, t[4 * q + 3].z, t[4 * q + 3].w);
            if (P0_NT) __builtin_nontemporal_store(o, (GAS v4u*)dst8); else *(GAS v4u*)dst8 = o; }
        return; }
#pragma unroll
    for (int q = 0; q < 2; ++q) { bf16* dst = d.WT + (size_t)(d.nrow0 + n16 + 16 * q) * d.KT + d.krow0 + 16 * qt;
#pragma unroll
        for (int h = 0; h < 2; ++h) { v4u o; o.x = pk2(t[4 * q + 2 * h].x, t[4 * q + 2 * h].y); o.y = pk2(t[4 * q + 2 * h].z, t[4 * q + 2 * h].w); o.z = pk2(t[4 * q + 2 * h + 1].x, t[4 * q + 2 * h + 1].y); o.w = pk2(t[4 * q + 2 * h + 1].z, t[4 * q + 2 * h + 1].w);
            *(GAS v4u*)(dst + 8 * h) = o; } }
}
__device__ __forceinline__ void p0_prologue(Frame& F) {
    LAS float* scr = (LAS float*)(F.lds + RING_OFF + F.wave * 8448);
    const int gw = F.vcu * NWAVES + F.wave, NGW = F.G * NWAVES;
    unsigned char* ws = F.ws;
    const float* in_x = INP(0); const float* in_p = INP(1); const float* in_gmix = INP(2); const float* in_win = INP(3); const float* in_ws = INP(6); const float* in_ga = INP(9); const float* in_gb = INP(10);
    const float* in_wout = INP(11); const float* in_gmoe = INP(12); const float* in_wr = INP(13); const float* in_gple = INP(19); const float* in_wpg = INP(20); const float* in_wple = INP(21);
#if CONV_IN_P2
    constexpr int PER_L = 1280 + 512 + 512 + 128, N_SMALL = NLAYER * PER_L, NITEMS = N_SMALL;
#else
    const float* in_wgu = INP(15); const float* in_wdn = INP(17);
    constexpr int PER_L = 1280 + 512 + 512 + 128, N_SMALL = NLAYER * PER_L, N_GU = NLAYER * NEXP * 1024, N_DN = NLAYER * NEXP * 512, NITEMS = N_SMALL + N_GU + N_DN;
#endif
    auto kbnb = [](int item, int NB, int& kb, int& nb) { const int q = item >> 1; kb = 2 * (q / NB) + (item & 1); nb = q % NB; };
    auto decode = [&](int it) -> TrItem {
        TrItem d; d.g1 = nullptr; d.gsplit = 1 << 30; d.f8 = 0; int kb, nb;
        if (it < N_SMALL) { const int l = it / PER_L; int r = it % PER_L;
            if (r < 1280) { kbnb(r, 80, kb, nb); d.W = in_win + (size_t)l * DM * INC; d.ldn = INC; d.KT = DM; d.WT = P1_F8 ? (bf16*)(ws + WS_WIN + (size_t)l * NIN * DM) : (bf16*)(ws + WS_WIN) + (size_t)l * NIN * DM; d.f8 = P1_F8; d.k0 = 64 * kb; d.n0 = 32 * nb; d.krow0 = d.k0; d.nrow0 = d.n0; d.g0 = in_gmix + l * DM; return d; } r -= 1280;
            if (r < 512) { kbnb(r, 32, kb, nb); d.W = in_wout + (size_t)l * DM * DM; d.ldn = DM; d.KT = DM; d.WT = (bf16*)(ws + WS_WOUT) + (size_t)l * DM * DM; d.k0 = 64 * kb; d.n0 = 32 * nb; d.krow0 = (d.k0 + 512) & 1023; d.nrow0 = d.n0; d.g0 = in_ga + l * 512; d.g1 = in_gb + l * 512; d.gsplit = 512; return d; } r -= 512;
            if (r < 512) { kbnb(r, 32, kb, nb); d.W = in_wpg + (size_t)l * DM * DM; d.ldn = DM; d.KT = DM; d.WT = (bf16*)(ws + WS_WPG) + (size_t)l * DM * DM; d.k0 = 64 * kb; d.n0 = 32 * nb; d.krow0 = d.k0; d.nrow0 = d.n0; d.g0 = in_gple + l * DM; return d; } r -= 512;
            kbnb(r, 32, kb, nb); d.W = in_wple + (size_t)l * PLE * DM; d.ldn = DM; d.KT = PLE; d.WT = (bf16*)(ws + WS_WPLE) + (size_t)l * DM * PLE; d.k0 = 64 * kb; d.n0 = 32 * nb; d.krow0 = d.k0; d.nrow0 = d.n0; d.g0 = nullptr; return d; }
#if !CONV_IN_P2
        if (it < N_SMALL + N_GU) { const int r = it - N_SMALL, le = r >> 10, item = r & 1023; kbnb(item, 64, kb, nb); d.k0 = 64 * kb; d.n0 = 32 * nb;
            d.nrow0 = d.n0 < 1024 ? 256 * (d.n0 >> 7) + (d.n0 & 127) : 256 * ((d.n0 - 1024) >> 7) + 128 + ((d.n0 - 1024) & 127);
            d.W = in_wgu + (size_t)le * DM * 2048; d.ldn = 2048; d.KT = DM; d.WT = (bf16*)(ws + WS_WGU + (size_t)le * 2048 * DM); d.f8 = 1; d.krow0 = d.k0; d.g0 = in_gmoe + (le >> 5) * DM; return d; }
        { const int r = it - N_SMALL - N_GU, le = r >> 9, item = r & 511; kbnb(item, 32, kb, nb); d.k0 = 64 * kb; d.n0 = 32 * nb;
            d.W = in_wdn + (size_t)le * DM * DM; d.ldn = DM; d.KT = DM; d.WT = (bf16*)(ws + WS_WDN + (size_t)le * DM * DM); d.f8 = 1; d.krow0 = d.k0; d.nrow0 = d.n0; d.g0 = nullptr; return d; }
#else
        return d;
#endif
    };
    { f32x4 va[8], vb[8], vc[8], vd[8]; float ga[8], gb[8], gc[8], gd[8]; int it = 2 * gw;
        if (it < NITEMS) { TrItem da = decode(it), db = decode(it + 1); tr_load(da, va, ga, F.lane); tr_load(db, vb, gb, F.lane);
            for (;;) { const int it2 = it + 2 * NGW; TrItem dc = da, dd = db; if (it2 < NITEMS) { dc = decode(it2); dd = decode(it2 + 1); tr_load(dc, vc, gc, F.lane); tr_load(dd, vd, gd, F.lane); }
                tr_store(da, va, ga, scr, F.lane); tr_store(db, vb, gb, scr, F.lane); if (it2 >= NITEMS) break;
                const int it3 = it2 + 2 * NGW; if (it3 < NITEMS) { da = decode(it3); db = decode(it3 + 1); tr_load(da, va, ga, F.lane); tr_load(db, vb, gb, F.lane); }
                tr_store(dc, vc, gc, scr, F.lane); tr_store(dd, vd, gd, scr, F.lane); if (it3 >= NITEMS) break; it = it3; } } }
    const int gt = F.vcu * (NWAVES * 64) + F.tid, NGT = F.G * NWAVES * 64;
    for (int i = gt; i < NLAYER * 32 * DM; i += NGT) { const int l = i / (32 * DM), j = (i / DM) % 32, k = i % DM;
        ((bf16*)(ws + WS_WFB))[i] = (bf16)(j < 8 ? f2bf(in_win[((size_t)l * DM + k) * INC + NIN + j] * in_gmix[l * DM + k]) : 0u);
        ((bf16*)(ws + WS_WRB))[i] = (bf16)f2bf(in_wr[((size_t)l * DM + k) * NEXP + j] * in_gmoe[l * DM + k]); }
    for (int i = gt; i < NLAYER * 4 * 128 * 128; i += NGT) { const int ii = (i >> 7) & 127, jj = i & 127; ((bf16*)(ws + WS_WSB))[i] = (bf16)(((jj >> 6) <= (ii >> 6)) ? f2bf(in_ws[i]) : 0u); }
#ifndef XROWS
#define XROWS 4
#endif
    static_assert(T % (XROWS * 8) == 0, "x rows per wave");
    for (int m = XROWS * gw; m < T; m += XROWS * NGW) { f32x4 v[XROWS][4]; float s[XROWS];
#pragma unroll
        for (int r = 0; r < XROWS; ++r) { const GAS f32x4* xr = (const GAS f32x4*)(in_x + (size_t)(m + r) * DM) + F.lane;
#pragma unroll
            for (int j = 0; j < 4; ++j) v[r][j] = FIN_NT ? __builtin_nontemporal_load(xr + 64 * j) : xr[64 * j]; }
#pragma unroll
        for (int r = 0; r < XROWS; ++r) { float ss = 0.f;
#pragma unroll
            for (int j = 0; j < 4; ++j) ss += (v[r][j].x * v[r][j].x + v[r][j].y * v[r][j].y) + (v[r][j].z * v[r][j].z + v[r][j].w * v[r][j].w);
            s[r] = wave_sum(ss, F.lane);
            GAS unsigned long long* o8 = (GAS unsigned long long*)((bf16*)(ws + WS_HBA) + (size_t)(m + r) * DM) + F.lane;
#pragma unroll
            for (int j = 0; j < 4; ++j) o8[64 * j] = (unsigned long long)pk2(v[r][j].x, v[r][j].y) | ((unsigned long long)pk2(v[r][j].z, v[r][j].w) << 32);
            if (P1_F8) { GAS unsigned* o4 = (GAS unsigned*)(ws + WS_H8 + (size_t)(m + r) * DM) + F.lane;
#pragma unroll
                for (int j = 0; j < 4; ++j) o4[64 * j] = pk4_fp8(clamp448(v[r][j].x), clamp448(v[r][j].y), clamp448(v[r][j].z), clamp448(v[r][j].w)); }
            if (F.lane < 16) ((float*)(ws + WS_SSQX))[(size_t)(m + r) * 16 + F.lane] = F.lane == 0 ? s[r] : 0.f; } }
    if (!P_IN_P2) for (size_t i0 = gt; i0 < (size_t)NLAYER * T * PLE / 8; i0 += (size_t)4 * NGT) { f32x4 a[4], b[4];
#pragma unroll
        for (int u = 0; u < 4; ++u) { const size_t i = i0 + (size_t)u * NGT; if (i < (size_t)NLAYER * T * PLE / 8) { const GAS f32x4* pr = (const GAS f32x4*)in_p + 2 * i; a[u] = pr[0]; b[u] = pr[1]; } }
#pragma unroll
        for (int u = 0; u < 4; ++u) { const size_t i = i0 + (size_t)u * NGT; if (i < (size_t)NLAYER * T * PLE / 8) { v4u o; o.x = pk2(a[u].x, a[u].y); o.y = pk2(a[u].z, a[u].w); o.z = pk2(b[u].x, b[u].y); o.w = pk2(b[u].z, b[u].w); ((GAS v4u*)(ws + WS_PB))[i] = o; } }
    }
}

#ifdef CONV_DUP
__device__ __forceinline__ int conv_two() { int n = 2; asm volatile("" : "+s"(n)); return n; }
#define CONV_REP _Pragma("unroll 1") for (int r_ = 0, nrep_ = conv_two(); r_ < nrep_; ++r_)
#else
#define CONV_REP
#endif
#ifndef CONV_CH
#define CONV_CH 8
#endif
#ifndef CONV_CL
#define CONV_CL 4
#endif
#if CONV_DMA
__device__ __forceinline__ void conv_experts(Frame& F, int l) {
    unsigned char* ws = F.ws;
    const float* in_gmoe = INP(12); const float* in_wgu = INP(15); const float* in_wdn = INP(17);
    constexpr int NCH = NEXP * 8 + NEXP * 4;
    gu32* ctr = F.ctl + CW_CONV + l * 64;
    LAS int* slot = (LAS int*)(F.lds + LDSCTL_OFF + 448);
    LAS unsigned char* gsm = F.lds + LDSCTL_OFF + 11264;
    const int lane = F.lane, w = F.wave, n16 = lane >> 2, qt = lane & 3;
    if (F.tid < 256) *(LAS f32x4*)(gsm + 16 * F.tid) = *(const GAS f32x4*)(in_gmoe + l * DM + 4 * F.tid);
    __syncthreads();
    unsigned nxtw = 0; if (F.tid == 0) nxtw = __hip_atomic_fetch_add(ctr, 1u, RLX_AGENT);
    struct Tile { const float* W; unsigned char* O; int ldn, n0, k0, nrow0, gain; };
    int itc = 0, tk = 16; Tile cd; cd.W = nullptr; cd.O = nullptr; cd.ldn = 0; cd.n0 = 0; cd.k0 = 0; cd.nrow0 = 0; cd.gain = 0;
    auto next_tile = [&](Tile& o) -> bool {
        if (tk == 16) {
            if (F.tid == 0) slot[itc & 1] = (int)nxtw;
            asm volatile("s_waitcnt lgkmcnt(0)\n\ts_barrier" ::: "memory");
            const int c = __builtin_amdgcn_readfirstlane(slot[itc & 1]); ++itc;
            if (c >= NCH) return false;
            if (F.tid == 0) nxtw = __hip_atomic_fetch_add(ctr, 1u, RLX_AGENT);
            if (c < NEXP * 8) { const int le = l * NEXP + (c >> 3), n0 = 256 * (c & 7), n0w = n0 + 32 * w;
                cd.W = in_wgu + (size_t)le * DM * 2048; cd.O = ws + WS_WGU + (size_t)le * 2048 * DM; cd.ldn = 2048; cd.n0 = n0; cd.gain = 1;
                cd.nrow0 = n0w < 1024 ? 256 * (n0w >> 7) + (n0w & 127) : 256 * ((n0w - 1024) >> 7) + 128 + ((n0w - 1024) & 127); }
            else { const int c2 = c - NEXP * 8, le = l * NEXP + (c2 >> 2), n0 = 256 * (c2 & 3);
                cd.W = in_wdn + (size_t)le * DM * DM; cd.O = ws + WS_WDN + (size_t)le * DM * DM; cd.ldn = DM; cd.n0 = n0; cd.gain = 0; cd.nrow0 = n0 + 32 * w; }
            tk = 0; }
        o = cd; o.k0 = 64 * tk; ++tk; return true; };
    auto issue = [&](const Tile& d, int b) {
        const int fl = ((w >> 1) & 1) * 4;
        const float* g0 = d.W + (size_t)(d.k0 + 8 * w) * d.ldn + d.n0 + 4 * (lane ^ fl);
#pragma unroll
        for (int i = 0; i < 8; ++i) __builtin_amdgcn_global_load_lds((const unsigned*)(g0 + (size_t)i * d.ldn), (LAS unsigned*)(F.lds + RING_OFF + b * 65536 + (8 * w + i) * 1024), 16, 0, CONV_DMA_AUX);
    };
    auto process = [&](const Tile& d, int b) {
        const int fk = 4 * (qt & 1); f32x4 t[8], gv[4];
#pragma unroll
        for (int q = 0; q < 2; ++q) { const int nl = 32 * w + 16 * q + n16; const LAS float* s = (const LAS float*)(F.lds + RING_OFF + b * 65536 + (16 * qt) * 1024 + 16 * ((nl >> 2) ^ fk) + 4 * (nl & 3));
#pragma unroll
            for (int e = 0; e < 4; ++e) { t[4 * q + e].x = s[(4 * e) * 256]; t[4 * q + e].y = s[(4 * e + 1) * 256]; t[4 * q + e].z = s[(4 * e + 2) * 256]; t[4 * q + e].w = s[(4 * e + 3) * 256]; } }
#pragma unroll
        for (int e = 0; e < 4; ++e) gv[e] = *(const LAS f32x4*)(gsm + (d.k0 + 16 * qt) * 4 + 16 * e);
        asm volatile("s_waitcnt lgkmcnt(0)" : "+v"(t[0]), "+v"(t[1]), "+v"(t[2]), "+v"(t[3]), "+v"(t[4]), "+v"(t[5]), "+v"(t[6]), "+v"(t[7]) :: "memory");
#pragma unroll
        for (int q = 0; q < 2; ++q) { unsigned char* dst8 = d.O + (size_t)(d.nrow0 + 16 * q + n16) * DM + d.k0 + 16 * qt; v4u o; unsigned ow[4];
#pragma unroll
            for (int e = 0; e < 4; ++e) { const f32x4 m = d.gain ? gv[e] * 64.0f : (f32x4){64.0f, 64.0f, 64.0f, 64.0f}; const f32x4 x = t[4 * q + e] * m; ow[e] = pk4_fp8(x.x, x.y, x.z, x.w); }
            o.x = ow[0]; o.y = ow[1]; o.z = ow[2]; o.w = ow[3]; *(GAS v4u*)dst8 = o; }
    };
    Tile cur;
    if (next_tile(cur)) { issue(cur, 0);
        for (int it = 0;; ++it) { Tile nx; const bool hn = next_tile(nx);
            if (it > 0) asm volatile("s_barrier" ::: "memory");
            if (hn) { issue(nx, (it + 1) & 1); asm volatile("s_waitcnt vmcnt(8)" ::: "memory"); } else asm volatile("s_waitcnt vmcnt(0)" ::: "memory");
            asm volatile("s_barrier" ::: "memory");
            process(cur, it & 1);
            if (!hn) break; cur = nx; } }
}
#else
__device__ __forceinline__ void conv_experts(Frame& F, int l) {
    LAS float* scr = (LAS float*)(F.lds + RING_OFF + F.wave * 8448);
    unsigned char* ws = F.ws;
    const float* in_gmoe = INP(12); const float* in_wgu = INP(15); const float* in_wdn = INP(17);
    constexpr int NP_GU = NEXP * 512, NP_DN = NEXP * 256, NP = NP_GU + NP_DN;
    constexpr int NBIG = (NP * 3 / 4) / CONV_CH, NSMALL = (NP - NBIG * CONV_CH) / CONV_CL, NCHUNK = NBIG + NSMALL;
    static_assert((NP * 3 / 4) % CONV_CH == 0 && (NP - NBIG * CONV_CH) % CONV_CL == 0, "chunking");
    gu32* ctr = F.ctl + CW_CONV + l * 64;
    auto kbnb = [](int item, int NB, int& kb, int& nb) { const int q = item >> 1; kb = 2 * (q / NB) + (item & 1); nb = q % NB; };
    auto decode = [&](int it) -> TrItem {
        TrItem d; d.g1 = nullptr; d.gsplit = 1 << 30; d.f8 = 1; int kb, nb;
        if (it < 2 * NP_GU) { const int le = l * NEXP + (it >> 10), item = it & 1023; kbnb(item, 64, kb, nb); d.k0 = 64 * kb; d.n0 = 32 * nb;
            d.nrow0 = d.n0 < 1024 ? 256 * (d.n0 >> 7) + (d.n0 & 127) : 256 * ((d.n0 - 1024) >> 7) + 128 + ((d.n0 - 1024) & 127);
            d.W = in_wgu + (size_t)le * DM * 2048; d.ldn = 2048; d.KT = DM; d.WT = (bf16*)(ws + WS_WGU + (size_t)le * 2048 * DM); d.krow0 = d.k0; d.g0 = in_gmoe + l * DM; return d; }
        { const int r = it - 2 * NP_GU, le = l * NEXP + (r >> 9), item = r & 511; kbnb(item, 32, kb, nb); d.k0 = 64 * kb; d.n0 = 32 * nb;
            d.W = in_wdn + (size_t)le * DM * DM; d.ldn = DM; d.KT = DM; d.WT = (bf16*)(ws + WS_WDN + (size_t)le * DM * DM); d.krow0 = d.k0; d.nrow0 = d.n0; d.g0 = nullptr; return d; }
    };
#if CONV_WG
    constexpr int WCH = 8 * CONV_CH, NWCH = NP / WCH; static_assert(NP % WCH == 0 && NWAVES == 8, "workgroup chunks");
    LAS int* slot = (LAS int*)(F.lds + LDSCTL_OFF + 448);
    unsigned nxtw = 0; if (F.tid == 0) nxtw = __hip_atomic_fetch_add(ctr, 1u, RLX_AGENT);
    f32x4 va[8], vb[8], vc[8], vd[8]; float ga[8], gb[8], gc[8], gd[8];
    int itc = 0, j = CONV_CH, base = 0;
    auto next = [&]() -> int {
        if (j == CONV_CH) {
            if (F.tid == 0) slot[itc & 1] = (int)nxtw;
            asm volatile("s_waitcnt lgkmcnt(0)\n\ts_barrier" ::: "memory");
            const int c = __builtin_amdgcn_readfirstlane(slot[itc & 1]); ++itc;
            if (c >= NWCH) return -1;
            if (F.tid == 0) nxtw = __hip_atomic_fetch_add(ctr, 1u, RLX_AGENT);
            base = c * WCH + F.wave; j = 0; }
        return base + 8 * j++; };
    int p = next();
    if (p >= 0) { TrItem da = decode(2 * p), db = decode(2 * p + 1); tr_load(da, va, ga, F.lane); tr_load(db, vb, gb, F.lane);
        for (;;) { const int p2 = next(); TrItem dc = da, dd = db; if (p2 >= 0) { dc = decode(2 * p2); dd = decode(2 * p2 + 1); tr_load(dc, vc, gc, F.lane); tr_load(dd, vd, gd, F.lane); }
            CONV_REP { tr_store(da, va, ga, scr, F.lane); tr_store(db, vb, gb, scr, F.lane); } if (p2 < 0) break;
            const int p3 = next(); if (p3 >= 0) { da = decode(2 * p3); db = decode(2 * p3 + 1); tr_load(da, va, ga, F.lane); tr_load(db, vb, gb, F.lane); }
            CONV_REP { tr_store(dc, vc, gc, scr, F.lane); tr_store(dd, vd, gd, scr, F.lane); } if (p3 < 0) break; } }
#else
    int cur = 0, end = 0;
    auto grab = [&]() -> unsigned { unsigned c = 0; if (F.lane == 0) c = __hip_atomic_fetch_add(ctr, 1u, RLX_AGENT); return c; };
    unsigned nxt = grab();
    auto next = [&]() -> int {
        if (cur == end) { const unsigned c = (unsigned)__builtin_amdgcn_readfirstlane((int)nxt); if (c >= (unsigned)NCHUNK) return -1; if (c < (unsigned)NBIG) { cur = (int)c * CONV_CH; end = cur + CONV_CH; } else { cur = NBIG * CONV_CH + ((int)c - NBIG) * CONV_CL; end = cur + CONV_CL; } nxt = grab(); }
        return cur++; };
    f32x4 va[8], vb[8], vc[8], vd[8]; float ga[8], gb[8], gc[8], gd[8];
    int p = next();
    if (p >= 0) { TrItem da = decode(2 * p), db = decode(2 * p + 1); tr_load(da, va, ga, F.lane); tr_load(db, vb, gb, F.lane);
        for (;;) { const int p2 = next(); TrItem dc = da, dd = db; if (p2 >= 0) { dc = decode(2 * p2); dd = decode(2 * p2 + 1); tr_load(dc, vc, gc, F.lane); tr_load(dd, vd, gd, F.lane); }
            tr_store(da, va, ga, scr, F.lane); tr_store(db, vb, gb, scr, F.lane); if (p2 < 0) break;
            const int p3 = next(); if (p3 >= 0) { da = decode(2 * p3); db = decode(2 * p3 + 1); tr_load(da, va, ga, F.lane); tr_load(db, vb, gb, F.lane); }
            tr_store(dc, vc, gc, scr, F.lane); tr_store(dd, vd, gd, scr, F.lane); if (p3 < 0) break; } }
#endif
}

#endif
__device__ __forceinline__ void conv_p(Frame& F) {
    static_assert(!P_IN_P2 || CONV_IN_P2, "conv_p is called from the conversion queue's call sites");
    unsigned char* ws = F.ws; const float* in_p = INP(1);
    constexpr int NPC = NLAYER * T * PLE / 65536;
    gu32* ctr = F.ctl + CW_CONV + 2 * 64;
    LAS int* slot = (LAS int*)(F.lds + LDSCTL_OFF + 456);
    for (int itc = 0;; ++itc) {
        if (F.tid == 0) slot[itc & 1] = (int)__hip_atomic_fetch_add(ctr, 1u, RLX_AGENT);
        __syncthreads();
        const int c = __builtin_amdgcn_readfirstlane(slot[itc & 1]);
        if (c >= NPC) break;
#pragma unroll 1
        for (int r = 0; r < 4; ++r) { f32x4 a[4], b[4]; const size_t i0 = (size_t)c * 8192 + (size_t)r * 2048 + F.tid;
#pragma unroll
            for (int u = 0; u < 4; ++u) { const GAS f32x4* pr = (const GAS f32x4*)in_p + 2 * (i0 + (size_t)u * 512); a[u] = RD1_NT ? __builtin_nontemporal_load(pr) : pr[0]; b[u] = RD1_NT ? __builtin_nontemporal_load(pr + 1) : pr[1]; }
#pragma unroll
            for (int u = 0; u < 4; ++u) { v4u o; o.x = pk2(a[u].x, a[u].y); o.y = pk2(a[u].z, a[u].w); o.z = pk2(b[u].x, b[u].y); o.w = pk2(b[u].z, b[u].w); ((GAS v4u*)(ws + WS_PB))[i0 + (size_t)u * 512] = o; } }
    }
}

constexpr int SK_PITCH = 2064, SK_BW = 0, SK_SCR = 32 * SK_PITCH, SK_SCR_BYTES = 4608, SK_LCNT = SK_SCR + 8 * SK_SCR_BYTES, SK_LBASE = SK_LCNT + 128;
typedef float f32x16 __attribute__((ext_vector_type(16)));
__device__ __forceinline__ int crow16(int r, int hi) { return (r & 3) + 8 * (r >> 2) + 4 * hi; }
__device__ __forceinline__ void sk_load_bw(Frame& F, const bf16* wsrc) {
    v4u t[8];
#pragma unroll
    for (int i = 0; i < 8; ++i) { const int idx = F.tid + 512 * i, row = idx >> 7, ch = idx & 127; t[i] = *(const GAS v4u*)(wsrc + row * 1024 + ch * 8); }
    asm volatile("" : "+v"(t[0]), "+v"(t[1]), "+v"(t[2]), "+v"(t[3]), "+v"(t[4]), "+v"(t[5]), "+v"(t[6]), "+v"(t[7]));
#pragma unroll
    for (int i = 0; i < 8; ++i) { const int idx = F.tid + 512 * i, row = idx >> 7, ch = idx & 127; *(LAS v4u*)(F.lds + SK_BW + row * SK_PITCH + ch * 16) = t[i]; }
}
__device__ __forceinline__ void skinny32_load(const bf16* hb, int tok0, int lane, int S0, v4u (&a)[32]) {
    const int r32 = lane & 31, hi = lane >> 5;
    const GAS v4u* ap = (const GAS v4u*)(hb + (size_t)(tok0 + r32) * DM + 32 * hi);
#pragma unroll
    for (int q = 0; q < 32; ++q) a[q] = ap[(S0 + (q >> 2)) * 8 + (q & 3)];
}
__device__ __forceinline__ f32x16 skinny32_mma(v4u (&a)[32], LAS const unsigned char* bw, int lane, int S0) {
    const int r32 = lane & 31, hi = lane >> 5;
    LAS const unsigned char* bp = bw + r32 * SK_PITCH + 64 * hi;
    f32x16 acc = f32x16{};
#pragma unroll
    for (int hf = 0; hf < 2; ++hf) {
        asm volatile("" : "+v"(a[16 * hf + 0]), "+v"(a[16 * hf + 1]), "+v"(a[16 * hf + 2]), "+v"(a[16 * hf + 3]), "+v"(a[16 * hf + 4]), "+v"(a[16 * hf + 5]), "+v"(a[16 * hf + 6]), "+v"(a[16 * hf + 7]), "+v"(a[16 * hf + 8]), "+v"(a[16 * hf + 9]), "+v"(a[16 * hf + 10]), "+v"(a[16 * hf + 11]), "+v"(a[16 * hf + 12]), "+v"(a[16 * hf + 13]), "+v"(a[16 * hf + 14]), "+v"(a[16 * hf + 15]));
#pragma unroll
        for (int ss = 0; ss < 4; ++ss) { const int S = S0 + 4 * hf + ss;
            const bf16x8 b0 = *(LAS const bf16x8*)(bp + S * 128), b1 = *(LAS const bf16x8*)(bp + S * 128 + 16), b2 = *(LAS const bf16x8*)(bp + S * 128 + 32), b3 = *(LAS const bf16x8*)(bp + S * 128 + 48);
            acc = __builtin_amdgcn_mfma_f32_32x32x16_bf16(__builtin_bit_cast(bf16x8, a[16 * hf + 4 * ss + 0]), b0, acc, 0, 0, 0);
            acc = __builtin_amdgcn_mfma_f32_32x32x16_bf16(__builtin_bit_cast(bf16x8, a[16 * hf + 4 * ss + 1]), b1, acc, 0, 0, 0);
            acc = __builtin_amdgcn_mfma_f32_32x32x16_bf16(__builtin_bit_cast(bf16x8, a[16 * hf + 4 * ss + 2]), b2, acc, 0, 0, 0);
            acc = __builtin_amdgcn_mfma_f32_32x32x16_bf16(__builtin_bit_cast(bf16x8, a[16 * hf + 4 * ss + 3]), b3, acc, 0, 0, 0); } }
    return acc;
}
__device__ __forceinline__ float row_rinv16(const float* ssq16, int tok) {
    const GAS f32x4* p = (const GAS f32x4*)(ssq16 + (size_t)tok * 16); const f32x4 a = p[0], b = p[1], c = p[2], d = p[3];
    const float s = (((a.x + a.y) + (a.z + a.w)) + ((b.x + b.y) + (b.z + b.w))) + (((c.x + c.y) + (c.z + c.w)) + ((d.x + d.y) + (d.z + d.w)));
    return rsqrtf(s * (1.0f / DM) + EPS);
}
__device__ __forceinline__ void p1_flogit(Frame& F, int l, const bf16* hb, const float* ssq16) {
    v4u ska[32]; bool skpre = F.vcu < T / 128;
    if (skpre) skinny32_load(hb, F.vcu * 128 + (F.wave & 3) * 32, F.lane, (F.wave >> 2) * 8, ska);
    sk_load_bw(F, (const bf16*)(F.ws + WS_WFB) + (size_t)l * 32 * DM);
    __syncthreads();
    LAS float* rvs = (LAS float*)(F.lds + SK_SCR + F.wave * SK_SCR_BYTES);
    const float* in_bf = INP(8);
    const int r32 = F.lane & 31, hi = F.lane >> 5;
    for (int g = F.vcu; g < T / 128; g += F.G) {
        const int tok0 = g * 128 + (F.wave & 3) * 32;
        const float rvv = row_rinv16(ssq16, tok0 + r32);
        if (!skpre) skinny32_load(hb, tok0, F.lane, (F.wave >> 2) * 8, ska);
        skpre = false;
        f32x16 acc = skinny32_mma(ska, F.lds + SK_BW, F.lane, (F.wave >> 2) * 8);
        if (F.wave < 4 && F.lane < 32) rvs[F.lane] = rvv;
        if (F.wave >= 4) {
#pragma unroll
            for (int r = 0; r < 16; ++r) rvs[r * 64 + F.lane] = acc[r]; }
        __syncthreads();
        if (F.wave < 4) { const LAS float* part = rvs + 4 * (SK_SCR_BYTES / 4);
#pragma unroll
            for (int r = 0; r < 16; ++r) acc[r] += part[r * 64 + F.lane];
            if (r32 < 8) { const float bf = in_bf[l * 8 + r32];
#pragma unroll
                for (int r = 0; r < 16; ++r) { const int tr = crow16(r, hi); const float v = acc[r] * rvs[tr] + bf; const float ls = fminf(v, 0.f) - log1pf(__expf(-fabsf(v)));
                    ((float*)(F.ws + WS_LF))[(size_t)r32 * T + (tok0 + tr)] = ls * LOG2E; } }
        }
        __syncthreads();
    }
}
__device__ __forceinline__ void p4_router(Frame& F, int l, const bf16* hb, const float* ssq16) {
    v4u ska[32]; bool skpre = F.vcu < T / 128;
    if (skpre) skinny32_load(hb, F.vcu * 128 + (F.wave & 3) * 32, F.lane, (F.wave >> 2) * 8, ska);
    sk_load_bw(F, (const bf16*)(F.ws + WS_WRB) + (size_t)l * 32 * DM);
    LAS int* lcnt = (LAS int*)(F.lds + SK_LCNT); LAS int* lbase = (LAS int*)(F.lds + SK_LBASE);
    LAS float* lg = (LAS float*)(F.lds + SK_SCR + F.wave * SK_SCR_BYTES);
    const int r32 = F.lane & 31, hi = F.lane >> 5;
    const float* in_br = INP(14);
    int* lists = (int*)(F.ws + WS_LISTS); int* tope = (int*)(F.ws + WS_TOPE); float* gate = (float*)(F.ws + WS_GATE); float* rinv = (float*)(F.ws + WS_RINV);
    for (int g = F.vcu; g < T / 128; g += F.G) {
        if (F.tid < 32) lcnt[F.tid] = 0;
        __syncthreads();
        int ei[4] = {0, 0, 0, 0}, lr[4] = {0, 0, 0, 0}; float gv[4] = {0.f, 0.f, 0.f, 0.f}, rv_tok = 0.f; const int tok = g * 128 + (F.wave & 3) * 32 + r32;
        const float rv_pre = row_rinv16(ssq16, tok);
        if (!skpre) skinny32_load(hb, g * 128 + (F.wave & 3) * 32, F.lane, (F.wave >> 2) * 8, ska);
        skpre = false;
        f32x16 acc = skinny32_mma(ska, F.lds + SK_BW, F.lane, (F.wave >> 2) * 8);
        if (F.wave >= 4) {
#pragma unroll
            for (int r = 0; r < 16; ++r) lg[r * 64 + F.lane] = acc[r]; }
        __syncthreads();
        if (F.wave < 4) { const LAS float* part = lg + 4 * (SK_SCR_BYTES / 4);
#pragma unroll
            for (int r = 0; r < 16; ++r) acc[r] += part[r * 64 + F.lane];
#pragma unroll
            for (int r = 0; r < 16; ++r) lg[crow16(r, hi) * 33 + r32] = acc[r];
            LDS_WAIT(); asm volatile("" ::: "memory");
            if (hi == 0) {
                const float rv = rv_pre; rinv[tok] = rv; rv_tok = rv;
                float v[32];
#pragma unroll
                for (int e = 0; e < 32; ++e) v[e] = lg[r32 * 33 + e] * rv + in_br[l * 32 + e];
                float tv[4];
#pragma unroll
                for (int k = 0; k < 4; ++k) { float best = -INFINITY; int bi = 0;
#pragma unroll
                    for (int e = 0; e < 32; ++e) { const bool gt = v[e] > best; best = gt ? v[e] : best; bi = gt ? e : bi; }
#pragma unroll
                    for (int e = 0; e < 32; ++e) v[e] = (e == bi) ? -INFINITY : v[e];
                    tv[k] = best; ei[k] = bi; }
                float sum = 0.f;
#pragma unroll
                for (int k = 0; k < 4; ++k) { gv[k] = __expf(tv[k] - tv[0]); sum += gv[k]; }
                const float inv = 1.0f / sum;
#pragma unroll
                for (int k = 0; k < 4; ++k) { gv[k] *= inv; lr[k] = __hip_atomic_fetch_add(&lcnt[ei[k]], 1, __ATOMIC_RELAXED, __HIP_MEMORY_SCOPE_WORKGROUP); }
            }
        }
        __syncthreads();
        if (F.tid < 32) { const int c = lcnt[F.tid]; lbase[F.tid] = c ? (int)__hip_atomic_fetch_add(F.ctl + CW_CNT + (l * 32 + F.tid) * 64, (unsigned)c, RLX_AGENT) : 0; }
        __syncthreads();
        if (F.wave < 4 && hi == 0) {
#pragma unroll
            for (int k = 0; k < 4; ++k) { const int slot = lbase[ei[k]] + lr[k]; { const int li_ = 2 * (ei[k] * 32768 + slot); lists[li_] = tok; lists[li_ + 1] = (int)__float_as_uint(rv_tok); } tope[tok * 4 + k] = (ei[k] << 16) | slot; gate[tok * 4 + k] = gv[k]; }
        }
        __syncthreads();
    }
}
__device__ __forceinline__ int build_tiles(Frame& F, int l) {
    LAS int* cnt = (LAS int*)(F.lds + LCNT_OFF); LAS int* tst = (LAS int*)(F.lds + LTST_OFF); LAS int* tiles = (LAS int*)(F.lds + LTILES_OFF);
    if (F.tid < 32) { const int c = (int)__hip_atomic_load(F.ctl + CW_CNT + (l * 32 + F.tid) * 64, RLX_AGENT), n = (c + 255) >> 8; int x = n;
#pragma unroll
        for (int o = 1; o < 32; o <<= 1) { const int y = __builtin_amdgcn_ds_bpermute((F.tid - o) << 2, x); if (F.tid >= o) x += y; }
        const int s0 = x - n; cnt[F.tid] = c; tst[F.tid] = s0; if (F.tid == 31) tst[32] = x;
        for (int m = 0; m < n; ++m) tiles[s0 + m] = F.tid | (m << 8); }
    __syncthreads();
    return __builtin_amdgcn_readfirstlane(tst[32]);
}
__device__ __forceinline__ int reuse_tiles(Frame& F, int l) {
    if (MK_PER_STEP) return build_tiles(F, l);
    return __builtin_amdgcn_readfirstlane(*(LAS int*)(F.lds + LTST_OFF + 32 * 4));
}

__device__ __forceinline__ void fox_scan(Frame& F, int bh) {
    const int b = bh >> 3, h = bh & 7, s0 = 8 * F.tid;
    const GAS f32x4* lf = (const GAS f32x4*)((const float*)(F.ws + WS_LF) + (size_t)h * T + (size_t)b * SEQ + s0);
    float v[8]; { const f32x4 a_ = lf[0], b_ = lf[1]; v[0] = a_.x; v[1] = a_.y; v[2] = a_.z; v[3] = a_.w; v[4] = b_.x; v[5] = b_.y; v[6] = b_.z; v[7] = b_.w; }
#pragma unroll
    for (int i = 1; i < 8; ++i) v[i] += v[i - 1];
    float x = v[7];
#pragma unroll
    for (int o = 1; o < 64; o <<= 1) { const float y = __int_as_float(__builtin_amdgcn_ds_bpermute((F.lane - o) << 2, __float_as_int(x))); if (F.lane >= o) x += y; }
    LAS float* wsum = (LAS float*)(F.lds + attn_body::LDS_WS);
    if (F.lane == 63) wsum[F.wave] = x;
    __syncthreads();
    float base = x - v[7];
    for (int w = 0; w < F.wave; ++w) base += wsum[w];
    LAS attn_body::kx2_t* kx = (LAS attn_body::kx2_t*)(F.lds + attn_body::LDS_KX) + s0;
#pragma unroll
    for (int i = 0; i < 8; ++i) { const float bias = -(base + v[i]); const unsigned hh = f2bf(bias); const float r1 = bias - __uint_as_float(hh << 16); const unsigned mm = f2bf(r1); const float r2 = r1 - __uint_as_float(mm << 16); const unsigned ll = f2bf(r2);
        attn_body::kx2_t o; o.x = hh | (mm << 16); o.y = ll | 0x3F800000u; kx[i] = o; }
    __syncthreads();
}
constexpr int GM_ST = 0, GM_VT = 1024, GM_PITCH = 136;
typedef float f32x4v __attribute__((ext_vector_type(4)));
#define GM_BAR() asm volatile("s_waitcnt lgkmcnt(0)\n\ts_barrier" ::: "memory")
__device__ __forceinline__ void gmlp_unit(Frame& F, int l, int blk) {
    const bf16* VG = (const bf16*)(F.ws + WS_U + SEG_BYTES); const bf16* U = (const bf16*)(F.ws + WS_U); bf16* YC = (bf16*)(F.ws + WS_YC);
    const bf16* WSB = (const bf16*)(F.ws + WS_WSB) + (size_t)l * 4 * 128 * 128;
    const float* in_lng = INP(4); const float* in_lnb = INP(5); const float* in_bs = INP(7);
    LAS float* st = (LAS float*)(F.lds + GM_ST); LAS unsigned char* vt = F.lds + GM_VT;
    const int row0 = blk * 128, lane = F.lane, w = F.wave, fr = lane & 15, fq = lane >> 4;
    const int i = 16 * w + fr; const size_t grow = (size_t)(row0 + i);
    auto ld_rws = [&](int g, unsigned (&r)[16]) {
#pragma unroll
        for (int q = 0; q < 16; ++q) r[q] = *(const GAS unsigned*)(VG + (size_t)(row0 + w * 16 + q) * 512 + g * 128 + 2 * lane); };
    auto ld_ln = [&](int g, float (&pp)[4]) { const int c = l * 512 + g * 128 + 2 * lane; pp[0] = in_lng[c]; pp[1] = in_lng[c + 1]; pp[2] = in_lnb[c]; pp[3] = in_lnb[c + 1]; };
    auto ld_wf = [&](int g, bf16x8 (&f)[4]) {
#pragma unroll
        for (int ks = 0; ks < 4; ++ks) f[ks] = *(const GAS bf16x8*)(WSB + ((size_t)(g * 128 + 16 * w + fr)) * 128 + 32 * ks + 8 * fq); };
    v4u raws[16];
#pragma unroll
    for (int rr = 0; rr < 16; ++rr) raws[rr] = *(const GAS v4u*)(VG + (size_t)(row0 + w * 16 + rr) * 512 + lane * 8);
    unsigned rws[16]; float lnp[4]; bf16x8 wf[4], wfn[4]; float bs, bsn;
    ld_rws(0, rws); ld_ln(0, lnp); ld_wf(0, wf); bs = in_bs[(l * 4 + 0) * 128 + i];
    asm volatile("" ::: "memory");
    float sm[16], qv[16];
#pragma unroll
    for (int rr = 0; rr < 16; ++rr) { const v4u raw = raws[rr]; sm[rr] = ((bf_lo(raw.x) + bf_hi(raw.x)) + (bf_lo(raw.y) + bf_hi(raw.y))) + ((bf_lo(raw.z) + bf_hi(raw.z)) + (bf_lo(raw.w) + bf_hi(raw.w))); }
#pragma unroll
    for (int o = 32; o >= 1; o >>= 1) { float tp[16];
#pragma unroll
        for (int rr = 0; rr < 16; ++rr) tp[rr] = shx(sm[rr], o, lane);
        GM_JOIN16(tp);
#pragma unroll
        for (int rr = 0; rr < 16; ++rr) sm[rr] += tp[rr]; }
#pragma unroll
    for (int rr = 0; rr < 16; ++rr) { const v4u raw = raws[rr]; const float mean = sm[rr] * (1.0f / 512.0f); sm[rr] = mean;
        const float d0 = bf_lo(raw.x) - mean, d1 = bf_hi(raw.x) - mean, d2 = bf_lo(raw.y) - mean, d3 = bf_hi(raw.y) - mean, d4 = bf_lo(raw.z) - mean, d5 = bf_hi(raw.z) - mean, d6 = bf_lo(raw.w) - mean, d7 = bf_hi(raw.w) - mean;
        qv[rr] = ((d0 * d0 + d1 * d1) + (d2 * d2 + d3 * d3)) + ((d4 * d4 + d5 * d5) + (d6 * d6 + d7 * d7)); }
#pragma unroll
    for (int o = 32; o >= 1; o >>= 1) { float tp[16];
#pragma unroll
        for (int rr = 0; rr < 16; ++rr) tp[rr] = shx(qv[rr], o, lane);
        GM_JOIN16(tp);
#pragma unroll
        for (int rr = 0; rr < 16; ++rr) qv[rr] += tp[rr]; }
#pragma unroll
    for (int rr = 0; rr < 16; ++rr) { const int j = w * 16 + rr; const float rstd = rsqrtf(qv[rr] * (1.0f / 512.0f) + EPS); if (lane == 0) { st[2 * j] = sm[rr]; st[2 * j + 1] = rstd; } }
    GM_BAR();
    float ss = 0.f;
#ifdef GM_DUP2
    int nrep2_ = 2; asm volatile("" : "+s"(nrep2_));
#pragma unroll 1
    for (int rep2_ = 0; rep2_ < nrep2_; ++rep2_) { ss = 0.f; ld_rws(0, rws); ld_ln(0, lnp); ld_wf(0, wf); bs = in_bs[(l * 4 + 0) * 128 + i];
#endif
#pragma unroll 1
    for (int g = 0; g < 4; ++g) {
        u32x2 uv[8];
#pragma unroll
        for (int nb = 0; nb < 8; ++nb) uv[nb] = RD1_NT ? __builtin_nontemporal_load((const GAS u32x2*)(U + grow * 512 + g * 128 + 16 * nb + 4 * fq)) : *(const GAS u32x2*)(U + grow * 512 + g * 128 + 16 * nb + 4 * fq);
        asm volatile("" ::: "memory");
        { const int c = 2 * lane; const float ga0 = lnp[0], ga1 = lnp[1], be0 = lnp[2], be1 = lnp[3];
#pragma unroll
            for (int pr = 0; pr < 8; ++pr) { const int j = w * 16 + 2 * pr;
                const unsigned r0 = rws[2 * pr], r1 = rws[2 * pr + 1];
                const float m0 = st[2 * j], s0 = st[2 * j + 1], m1 = st[2 * j + 2], s1 = st[2 * j + 3];
                const float v00 = (bf_lo(r0) - m0) * s0 * ga0 + be0, v01 = (bf_hi(r0) - m0) * s0 * ga1 + be1, v10 = (bf_lo(r1) - m1) * s1 * ga0 + be0, v11 = (bf_hi(r1) - m1) * s1 * ga1 + be1;
                *(LAS unsigned*)(vt + (c * GM_PITCH + j) * 2) = pk2(v00, v10); *(LAS unsigned*)(vt + ((c + 1) * GM_PITCH + j) * 2) = pk2(v01, v11); } }
        GM_BAR();
        { const int gn = g < 3 ? g + 1 : 3; ld_rws(gn, rws); ld_ln(gn, lnp); ld_wf(gn, wfn); bsn = in_bs[(l * 4 + gn) * 128 + i]; }
        asm volatile("" ::: "memory");
        f32x4v acc[8];
#pragma unroll
        for (int nb = 0; nb < 8; ++nb) acc[nb] = (f32x4v){0.f, 0.f, 0.f, 0.f};
#pragma unroll
        for (int ks = 0; ks < 4; ++ks) {
#pragma unroll
            for (int nb = 0; nb < 8; ++nb) { const bf16x8 vf = *(LAS const bf16x8*)(vt + ((16 * nb + fr) * GM_PITCH + 32 * ks + 8 * fq) * 2);
                acc[nb] = __builtin_amdgcn_mfma_f32_16x16x32_bf16(vf, wf[ks], acc[nb], 0, 0, 0); } }
#pragma unroll
        for (int nb = 0; nb < 8; ++nb) { f32x4v y = acc[nb] + bs;
            y[0] *= bf_lo(uv[nb].x); y[1] *= bf_hi(uv[nb].x); y[2] *= bf_lo(uv[nb].y); y[3] *= bf_hi(uv[nb].y);
            u32x2 o; o.x = cvt_pk_bf16(y[0], y[1]); o.y = cvt_pk_bf16(y[2], y[3]);
            const float y0 = bf_lo(o.x), y1 = bf_hi(o.x), y2 = bf_lo(o.y), y3 = bf_hi(o.y); ss += (y0 * y0 + y1 * y1) + (y2 * y2 + y3 * y3);
            *(GAS u32x2*)(YC + grow * DM + 512 + g * 128 + 16 * nb + 4 * fq) = o; }
        GM_BAR();
#pragma unroll
        for (int ks = 0; ks < 4; ++ks) wf[ks] = wfn[ks];
        bs = bsn;
    }
#ifdef GM_DUP2
    }
#endif
    ss += shx(ss, 16, lane); ss += shx(ss, 32, lane);
    if (fq == 0) ((float*)(F.ws + WS_GSS))[grow] = ss;
}
__device__ __forceinline__ void fp8x4_fma(float (&a)[16], int base, unsigned w, float g) { a[base] += g * __builtin_amdgcn_cvt_f32_fp8((int)w, 0); a[base + 1] += g * __builtin_amdgcn_cvt_f32_fp8((int)w, 1); a[base + 2] += g * __builtin_amdgcn_cvt_f32_fp8((int)w, 2); a[base + 3] += g * __builtin_amdgcn_cvt_f32_fp8((int)w, 3); }
constexpr int P7_NR = 2;
__device__ __forceinline__ void p7_combine(Frame& F, bf16* hb, float* ssq_out) {
    const LAS int* tst = (const LAS int*)(F.lds + LTST_OFF);
    const int gw = F.vcu * NWAVES + F.wave, NGW = F.G * NWAVES;
    const int* tope = (const int*)(F.ws + WS_TOPE); const float* gate = (const float*)(F.ws + WS_GATE); const unsigned char* ys = F.ws + WS_YS;
    for (int tok0 = gw; tok0 < T; tok0 += P7_NR * NGW) {
        v4u y[P7_NR][4], h0[P7_NR], h1[P7_NR]; float g[P7_NR][4]; int te[P7_NR][4];
#pragma unroll
        for (int r = 0; r < P7_NR; ++r) { const int tok = tok0 + r * NGW < T ? tok0 + r * NGW : tok0;
#pragma unroll
            for (int k = 0; k < 4; ++k) { te[r][k] = tope[tok * 4 + k]; g[r][k] = gate[tok * 4 + k]; } }
#pragma unroll
        for (int r = 0; r < P7_NR; ++r) { const int tok = tok0 + r * NGW < T ? tok0 + r * NGW : tok0; const GAS v4u* hr = (const GAS v4u*)(hb + (size_t)tok * DM) + 2 * F.lane;
#pragma unroll
            for (int k = 0; k < 4; ++k) { const size_t pos = (size_t)tst[te[r][k] >> 16] * 256 + (te[r][k] & 0xffff); y[r][k] = RD1_NT ? __builtin_nontemporal_load((const GAS v4u*)(ys + pos * DM) + F.lane) : *((const GAS v4u*)(ys + pos * DM) + F.lane); }
            h0[r] = hr[0]; h1[r] = hr[1]; }
#pragma unroll
        for (int r = 0; r < P7_NR; ++r) { const int tok = tok0 + r * NGW; if (tok < T) { float a[16];
            a[0] = bf_lo(h0[r].x); a[1] = bf_hi(h0[r].x); a[2] = bf_lo(h0[r].y); a[3] = bf_hi(h0[r].y); a[4] = bf_lo(h0[r].z); a[5] = bf_hi(h0[r].z); a[6] = bf_lo(h0[r].w); a[7] = bf_hi(h0[r].w);
            a[8] = bf_lo(h1[r].x); a[9] = bf_hi(h1[r].x); a[10] = bf_lo(h1[r].y); a[11] = bf_hi(h1[r].y); a[12] = bf_lo(h1[r].z); a[13] = bf_hi(h1[r].z); a[14] = bf_lo(h1[r].w); a[15] = bf_hi(h1[r].w);
#pragma unroll
            for (int k = 0; k < 4; ++k) { fp8x4_fma(a, 0, y[r][k].x, g[r][k]); fp8x4_fma(a, 4, y[r][k].y, g[r][k]); fp8x4_fma(a, 8, y[r][k].z, g[r][k]); fp8x4_fma(a, 12, y[r][k].w, g[r][k]); }
            float s = 0.f;
#pragma unroll
            for (int i = 0; i < 16; ++i) s += a[i] * a[i];
            v4u o0, o1; o0.x = pk2(a[0], a[1]); o0.y = pk2(a[2], a[3]); o0.z = pk2(a[4], a[5]); o0.w = pk2(a[6], a[7]); o1.x = pk2(a[8], a[9]); o1.y = pk2(a[10], a[11]); o1.z = pk2(a[12], a[13]); o1.w = pk2(a[14], a[15]);
            GAS v4u* hw = (GAS v4u*)(hb + (size_t)tok * DM) + 2 * F.lane; hw[0] = o0; hw[1] = o1;
            s = wave_sum(s, F.lane);
            if (F.lane < 16) ssq_out[(size_t)tok * 16 + F.lane] = F.lane == 0 ? s : 0.f; } }
    }
}
__device__ __forceinline__ void final_norm(Frame& F, const bf16* hb, const float* ssq16) {
    const int gw = F.vcu * NWAVES + F.wave, NGW = F.G * NWAVES;
    const GAS f32x4* gf = (const GAS f32x4*)INP(22) + F.lane; f32x4 gg[4];
#pragma unroll
    for (int j = 0; j < 4; ++j) gg[j] = gf[64 * j];
    for (int tok0 = 2 * gw; tok0 < T; tok0 += 2 * NGW) {
        float sq[2]; u32x2 hv[2][4];
#pragma unroll
        for (int r = 0; r < 2; ++r) { const int tok = tok0 + r; sq[r] = F.lane < 16 ? ssq16[(size_t)tok * 16 + F.lane] : 0.f;
            const GAS u32x2* hr = (const GAS u32x2*)(hb + (size_t)tok * DM) + F.lane;
#pragma unroll
            for (int j = 0; j < 4; ++j) hv[r][j] = FIN_NT ? __builtin_nontemporal_load(hr + 64 * j) : hr[64 * j]; }
#pragma unroll
        for (int o = 1; o < 64; o <<= 1) { const float t0 = shx(sq[0], o, F.lane), t1 = shx(sq[1], o, F.lane); sq[0] += t0; sq[1] += t1; }
#pragma unroll
        for (int r = 0; r < 2; ++r) { const int tok = tok0 + r; const float ri = rsqrtf(sq[r] * (1.0f / DM) + EPS); GAS f32x4* orow = (GAS f32x4*)(F.H + (size_t)tok * DM) + F.lane;
#pragma unroll
            for (int j = 0; j < 4; ++j) { const u32x2 h = hv[r][j]; f32x4 v; v.x = bf_lo(h.x); v.y = bf_hi(h.x); v.z = bf_lo(h.y); v.w = bf_hi(h.y); const f32x4 ov = v * ri * gg[j]; if (FIN_NT) __builtin_nontemporal_store(ov, orow + 64 * j); else orow[64 * j] = ov; } }
    }
}

struct Args { const float* in[23]; float* out; unsigned char* ws; int ph_lo, ph_hi; };
__global__ void __launch_bounds__(NWAVES * 64, 2) fwd_kernel(Args args) {
    extern __shared__ __attribute__((aligned(16))) unsigned char lds[];
    Frame F;
    F.lds = (LAS unsigned char*)lds;
    F.MISC = (volatile LAS unsigned*)(F.lds + MISC_OFF);
    F.tid = threadIdx.x; F.lane = F.tid & 63; F.wave = __builtin_amdgcn_readfirstlane(F.tid >> 6);
    const int wave0 = F.wave;
    F.G = gridDim.x; { const int bx = blockIdx.x; F.bx = bx; F.vcu = (F.G % 8 == 0) ? (bx % 8) * (F.G / 8) + bx / 8 : bx; }
    unsigned char* ws = (unsigned char*)(GAS unsigned char*)args.ws; F.ws = ws; F.H = (float*)(GAS float*)args.out;
    F.ctl = (gu32*)(ws + WS_CTL);
    for (int u = F.tid; u < (LDS_BYTES - LDSCTL_OFF) / 4; u += NWAVES * 64) ((LAS unsigned*)(F.lds + LDSCTL_OFF))[u] = 0u;
    __syncthreads();
    const int lo = args.ph_lo, hi = args.ph_hi;
    XcdBarrier bar; bar.bar = (unsigned*)(F.ctl + CW_BAR); bar.x = 0; bar.st = nullptr; bar.wave = 0;
    if (!MK_PER_STEP) bar = xcd_barrier_post((unsigned*)(F.ctl + CW_BAR), F.MISC + 8);
#if MK_PER_STEP
#define IN(k) (lo <= (k) && (k) < hi)
#else
#define IN(k) true
#endif
#ifndef PROBE_STEP
#define PROBE_STEP (-1)
#endif
#ifndef PROBE_MODE
#define PROBE_MODE 0
#endif
    unsigned long long ts0_ = (PROBE_STEP == 0) ? rt() : 0ull, ts1_ = 0;
#ifdef PROBE_CONV
#undef PROBE_STEP
#define PROBE_STEP 999
#endif
#ifdef PROBE_BARSUM
#undef PROBE_STEP
#define PROBE_STEP 999
#define SEAM(k) do { const unsigned long long tb_ = rt(); if (IN(k) && IN((k) + 1)) xcd_barrier(bar); ts1_ += rt() - tb_; } while (0)
#else
#define SEAM(k) do { if (PROBE_STEP == (k)) { if (PROBE_MODE == 0) ts1_ = rt(); else ts0_ = rt(); } if (IN(k) && IN((k) + 1)) xcd_barrier(bar); if (PROBE_STEP == (k) && PROBE_MODE == 1) ts1_ = rt(); if (PROBE_STEP == (k) + 1 && PROBE_MODE == 0) ts0_ = rt(); } while (0)
#endif
#define HBA ((bf16*)(ws + WS_HBA))
#define HBB ((bf16*)(ws + WS_HBB))
#define SSQX ((float*)(ws + WS_SSQX))
#define SSQY ((float*)(ws + WS_SSQY))

#ifndef PHMASK
#define PHMASK 0x3ff
#endif
#define PH(j) ((PHMASK >> (j)) & 1)
#ifndef DUPMASK
#define DUPMASK 0
#endif
#define NREP(j) (1 + ((DUPMASK >> (j)) & 1))
#ifndef SUBMASK
#define SUBMASK 0xff
#endif
#define SUB(j) ((SUBMASK >> (j)) & 1)
    if (PH(0) && IN(0)) { for (int rep_ = 0; rep_ < NREP(0); ++rep_) p0_prologue(F); } SEAM(0);

#define RETID() do { int t_ = mk_tid(wave0); F.tid = t_; F.lane = t_ & 63; F.wave = __builtin_amdgcn_readfirstlane(t_ >> 6); GAS unsigned char* w_ = (GAS unsigned char*)args.ws; asm volatile("" : "+s"(w_)); F.ws = (unsigned char*)w_; ws = (unsigned char*)w_; int bx_ = blockIdx.x, g_ = gridDim.x; asm volatile("" : "+s"(bx_), "+s"(g_)); F.G = g_; F.vcu = (g_ % 8 == 0) ? (bx_ % 8) * (g_ / 8) + bx_ / 8 : bx_; F.bx = bx_; } while (0)
    for (int l = 0; l < NLAYER; ++l) {
        const int sb = 1 + 8 * l;
        const bf16* hb_in = l == 0 ? HBA : HBB;
        if (PH(1) && IN(sb)) { RETID();
            if (!P_IN_P2 && SUB(0) && l == 0) {
                for (int rep_ = 0; rep_ < NREP(1); ++rep_) {
                    pg8::DenseOrder2 S; S.init((const bf16*)(ws + WS_PB), (const bf16*)(ws + WS_WPLE), T, DM, PLE, F.G, F.bx); S.astride = (size_t)T * PLE * 2; S.bstride = (size_t)DM * PLE * 2;
#if E_F8
                    EpiE8 E{ws + WS_E, (size_t)T * DM};
#else
                    EpiBf E{(bf16_t*)(ws + WS_E), nullptr, 0, (size_t)T * DM};
#endif
                    int kple = PLE; asm volatile("" : "+s"(kple));
                    pg8::gemm_phase<decltype(E), pg8::DenseOrder2, false, false>(F.lds + RING_OFF, kple, S, E, F.tid);
                }
            }
            for (int rep_ = 0; rep_ < NREP(2); ++rep_) {
            if (SUB(1)) p1_flogit(F, l, hb_in, SSQX);
            if (SUB(2)) {
#if P1_F8
            pg8::DenseOrder S; S.init(ws + WS_H8, ws + WS_WIN + (size_t)l * NIN * DM, T, NIN, DM / 2, F.G, F.bx);
            EpiIn8 E{(bf16_t*)(ws + WS_U), SSQX, F.ctl + CW_NORM + l * 256};
            int k8 = DM / 2; asm volatile("" : "+s"(k8));
            pg8::gemm_phase<EpiIn8, pg8::DenseOrder, false, false, 1>(F.lds + RING_OFF, k8, S, E, F.tid);
#else
            pg8::DenseOrder S; S.init(hb_in, (const bf16*)(ws + WS_WIN) + (size_t)l * NIN * DM, T, NIN, DM, F.G, F.bx);
            EpiIn E{(bf16_t*)(ws + WS_U), SSQX, F.ctl + CW_NORM + l * 256};
            pg8::gemm_phase<EpiIn, pg8::DenseOrder, false, false>(F.lds + RING_OFF, DM, S, E, F.tid);
#endif
            }
            }
        }
        SEAM(sb);
        if (PH(2) && IN(sb + 1)) { RETID();
            for (int rep_ = 0; rep_ < NREP(3); ++rep_) if (SUB(3)) for (int blk = F.vcu; blk < T / 128; blk += F.G) gmlp_unit(F, l, blk);
            if (CONV_IN_P2 && SUB(5) && (CONV_XCD ? (F.bx & 7) < CONV_NUM : (((F.bx >> 3) * CONV_NUM) & 7) < CONV_NUM)) { __syncthreads();
#ifdef PROBE_CONV
                const unsigned long long tc0_ = rt();
#endif
                conv_experts(F, l); if (P_IN_P2 && l == 0) conv_p(F); __syncthreads();
#ifdef PROBE_CONV
                if (l == 0) { ts0_ = tc0_; ts1_ = rt(); }
#endif
            }
            for (int rep_ = 0; rep_ < NREP(4); ++rep_) if (SUB(4)) for (int vv = F.vcu; vv < 256; vv += F.G) {
                int bh = vv >> 2; gu32* ctr = F.ctl + CW_AQ + (size_t)((l * NREP(4) + rep_) * 64) * 64;
                LAS int* qslot = (LAS int*)(F.lds + attn_body::LDS_WS + 64);
                for (;;) {
                    fox_scan(F, bh);
                    const gu32* nb = F.ctl + CW_NORM + l * 256;
                    const float qn2 = __uint_as_float(__hip_atomic_load(nb + (0 * 64 + bh) * 2, RLX_AGENT)) + __uint_as_float(__hip_atomic_load(nb + (0 * 64 + bh) * 2 + 1, RLX_AGENT));
                    const float kn2 = __uint_as_float(__hip_atomic_load(nb + (1 * 64 + bh) * 2, RLX_AGENT)) + __uint_as_float(__hip_atomic_load(nb + (1 * 64 + bh) * 2 + 1, RLX_AGENT));
                    const float theta = 2.0f * sqrtf(qn2 * kn2) + ATT_SKIP_T;
                    if (F.tid == 0) *qslot = (int)__hip_atomic_fetch_add(ctr + bh * 64, 1u, RLX_AGENT);
                    __syncthreads();
                    int qi = __builtin_amdgcn_readfirstlane(*qslot);
                    __syncthreads();
                    while (qi < 16) {
                        unsigned nxt_ = 16u; if (ATT_PREGRAB && F.tid == 0) nxt_ = __hip_atomic_fetch_add(ctr + bh * 64, 1u, RLX_AGENT);
                        attn_body::attn_unit<8>(bh >> 3, bh & 7, 15 - qi, (const attn_body::bf16*)(ws + WS_U + 2 * SEG_BYTES), (const attn_body::bf16*)(ws + WS_U + 3 * SEG_BYTES), (const attn_body::bf16*)(ws + WS_U + 4 * SEG_BYTES),
                                                (attn_body::bf16*)(ws + WS_YC), (float*)(ws + WS_OSS), (char*)lds + RING_OFF, F.tid, theta, (ATT_LATEGRAB && !ATT_PREGRAB) ? (unsigned*)(ctr + bh * 64) : nullptr, nxt_);
                        if (!ATT_PREGRAB && !ATT_LATEGRAB && F.tid == 0) nxt_ = __hip_atomic_fetch_add(ctr + bh * 64, 1u, RLX_AGENT);
                        if (F.tid == 0) *qslot = (int)nxt_;
                        __syncthreads();
                        qi = __builtin_amdgcn_readfirstlane(*qslot);
                        __syncthreads();
                    }
                    if (F.wave == 0) { const unsigned c = __hip_atomic_load(ctr + F.lane * 64, RLX_AGENT); const unsigned long long m = __ballot(c < 16u);
                        int nx = -1; if (m) { const unsigned long long rot = (m >> ((bh + 1) & 63)) | (((bh + 1) & 63) ? (m << (64 - ((bh + 1) & 63))) : 0ull); nx = (bh + 1 + __builtin_ctzll(rot)) & 63; }
                        if (F.lane == 0) *qslot = nx; }
                    __syncthreads();
                    const int nx = __builtin_amdgcn_readfirstlane(*qslot);
                    __syncthreads();
                    if (nx < 0) break;
                    bh = nx;
                }
            }
            if (CONV_IN_P2 && SUB(5)) { __syncthreads(); conv_experts(F, l); if (P_IN_P2 && l == 0) conv_p(F); }
        }
        SEAM(sb + 1);
        if (PH(3) && IN(sb + 2)) { RETID();
            pg8::DenseOrder S; S.init((const bf16*)(ws + WS_YC), (const bf16*)(ws + WS_WOUT) + (size_t)l * DM * DM, T, DM, DM, F.G, F.bx);
            EpiRes E{(const bf16_t*)(l == 0 ? HBA : HBB), (bf16_t*)HBA, SSQX, (const float*)(ws + WS_OSS), (const float*)(ws + WS_GSS), ws + WS_H8};
            pg8::gemm_phase<EpiRes, pg8::DenseOrder, false, true>(F.lds + RING_OFF, DM, S, E, F.tid);
            if (P_IN_P2 && SUB(0) && l == 0) {
                pg8::DenseOrder2 S2; S2.init((const bf16*)(ws + WS_PB), (const bf16*)(ws + WS_WPLE), T, DM, PLE, F.G, F.bx); S2.astride = (size_t)T * PLE * 2; S2.bstride = (size_t)DM * PLE * 2;
#if E_F8
                EpiE8 E2{ws + WS_E, (size_t)T * DM};
#else
                EpiBf E2{(bf16_t*)(ws + WS_E), nullptr, 0, (size_t)T * DM};
#endif
                int kple = PLE; asm volatile("" : "+s"(kple));
                pg8::gemm_phase<decltype(E2), pg8::DenseOrder2, false, false>(F.lds + RING_OFF, kple, S2, E2, F.tid);
            }
        }
        SEAM(sb + 2);
        if (PH(4) && IN(sb + 3)) { RETID(); p4_router(F, l, HBA, SSQX); }
        SEAM(sb + 3);
        if (PH(5) && IN(sb + 4)) { RETID();
            const int ntiles = build_tiles(F, l);
            pg8::GroupedOrder<true> S; S.A = (const char*)(ws + WS_H8); S.Bt = (const char*)(ws + WS_WGU + (size_t)l * NEXP * 2048 * DM); S.K = DM / 2; S.N = 2048; S.npn = 8;
            S.tiles = (const LAS int*)(F.lds + LTILES_OFF); S.cnt = (const LAS int*)(F.lds + LCNT_OFF); S.lists = (const int*)(ws + WS_LISTS); S.ntiles = ntiles; S.G = F.G; S.vcu = F.vcu;
#if FP8_SHAPE == 16
            EpiSwiglu16 E{ws + WS_ACT, (const int*)(ws + WS_LISTS), (const LAS int*)(F.lds + LCNT_OFF), INP(16) + (size_t)l * NEXP * 2048};
#else
            EpiSwiglu8 E{ws + WS_ACT, (const float*)(ws + WS_RINV), (const int*)(ws + WS_LISTS), (const LAS int*)(F.lds + LCNT_OFF), INP(16) + (size_t)l * NEXP * 2048};
#endif
            for (int rep_ = 0; rep_ < NREP(5); ++rep_) { int k8 = DM / 2; asm volatile("" : "+s"(k8)); pg8::gemm_phase<decltype(E), pg8::GroupedOrder<true>, true, false, FP8_SHAPE == 16 ? 2 : 1>(F.lds + RING_OFF, k8, S, E, F.tid); }
        }
        SEAM(sb + 4);
        if (PH(6) && IN(sb + 5)) { RETID();
            const int ntiles = reuse_tiles(F, l);
            pg8::GroupedOrder<false> S; S.A = (const char*)(ws + WS_ACT); S.Bt = (const char*)(ws + WS_WDN + (size_t)l * NEXP * DM * DM); S.K = DM / 2; S.N = DM; S.npn = 4;
            S.tiles = (const LAS int*)(F.lds + LTILES_OFF); S.cnt = (const LAS int*)(F.lds + LCNT_OFF); S.lists = nullptr; S.ntiles = ntiles; S.G = F.G; S.vcu = F.vcu;
#if FP8_SHAPE == 16
            EpiDown16 E{ws + WS_YS, INP(18) + (size_t)l * NEXP * DM};
#else
            EpiDown8 E{ws + WS_YS, INP(18) + (size_t)l * NEXP * DM};
#endif
            for (int rep_ = 0; rep_ < NREP(6); ++rep_) { int k8 = DM / 2; asm volatile("" : "+s"(k8)); pg8::gemm_phase<decltype(E), pg8::GroupedOrder<false>, false, false, FP8_SHAPE == 16 ? 2 : 1>(F.lds + RING_OFF, k8, S, E, F.tid); }
        }
        SEAM(sb + 5);
        if (PH(7) && IN(sb + 6)) { RETID(); (void)reuse_tiles(F, l); p7_combine(F, HBA, SSQY); }
        SEAM(sb + 6);
        if (PH(8) && IN(sb + 7)) { RETID();
            pg8::DenseOrder S; S.init(HBA, (const bf16*)(ws + WS_WPG) + (size_t)l * DM * DM, T, DM, DM, F.G, F.bx);
            EpiPle E{(const bf16_t*)HBA, (bf16_t*)HBB, SSQX, SSQY, E_F8 ? (const bf16_t*)(ws + WS_E + (size_t)l * T * DM) : (const bf16_t*)(ws + WS_E) + (size_t)l * T * DM};
            for (int rep_ = 0; rep_ < NREP(8); ++rep_) pg8::gemm_phase<EpiPle, pg8::DenseOrder, false, false>(F.lds + RING_OFF, DM, S, E, F.tid);
        }
        SEAM(sb + 7);
    }
    if (PH(9) && IN(NSTEPS - 1)) { RETID(); final_norm(F, HBB, SSQX); }
#ifdef PROBE_EPI
    if (blockIdx.x == 0) { __syncthreads(); const unsigned long long span_ = *(LAS unsigned long long*)(F.lds + LDSCTL_OFF + 384), te_ = rt(); while (rt() - te_ < span_) __builtin_amdgcn_s_sleep(8); }
#endif
    if (PROBE_STEP >= 0) { if (PROBE_STEP == NSTEPS - 1) ts1_ = rt(); if (blockIdx.x == 0) { const unsigned long long te_ = rt(), span_ = ts1_ - ts0_; while (rt() - te_ < span_) __builtin_amdgcn_s_sleep(8); } }
#undef IN
#undef SEAM
#undef HBA
#undef HBB
#undef SSQX
#undef SSQY
}

extern "C" void kernel_launch(void* const* d_in, const int* in_sizes, int n_in, void* d_out, int out_size, void* d_ws, size_t ws_size, hipStream_t stream) {
    static int grid = 0;
    if (grid == 0) {
        if (n_in != 23 || in_sizes[0] != T * DM || out_size != T * DM || ws_size < WS_END) { fprintf(stderr, "kernel_launch: unexpected shapes / workspace (n_in %d, ws %zu < %zu); nothing launched\n", n_in, ws_size, (size_t)WS_END); grid = -1; return; }
        int dev = 0, cus = 0, per_cu = 0;
        if (hipGetDevice(&dev) != hipSuccess || hipDeviceGetAttribute(&cus, hipDeviceAttributeMultiprocessorCount, dev) != hipSuccess) { grid = -1; return; }
        if (hipFuncSetAttribute((const void*)fwd_kernel, hipFuncAttributeMaxDynamicSharedMemorySize, LDS_BYTES) != hipSuccess) { fprintf(stderr, "kernel_launch: hipFuncSetAttribute failed\n"); grid = -1; return; }
        if (hipOccupancyMaxActiveBlocksPerMultiprocessor(&per_cu, (const void*)fwd_kernel, NWAVES * 64, LDS_BYTES) != hipSuccess || per_cu < 1) { fprintf(stderr, "kernel_launch: occupancy query says %d blocks per CU\n", per_cu); }
        (void)hipGetLastError();
        grid = cus;
    }
    if (grid < 0) return;
    if (hipMemsetAsync((char*)d_ws + WS_CTL, 0, CTL_ZERO_BYTES, stream) != hipSuccess) return;
    Args a{};
    for (int i = 0; i < 23; ++i) a.in[i] = (const float*)d_in[i];
    a.out = (float*)d_out; a.ws = (unsigned char*)d_ws;
#if MK_PER_STEP
    for (int s = 0; s < NSTEPS; ++s) { a.ph_lo = s; a.ph_hi = s + 1; hipLaunchKernelGGL(fwd_kernel, dim3(grid), dim3(NWAVES * 64), LDS_BYTES, stream, a); }
#else
    a.ph_lo = 0; a.ph_hi = NSTEPS;
    hipLaunchKernelGGL(fwd_kernel, dim3(grid), dim3(NWAVES * 64), LDS_BYTES, stream, a);
#endif
}
```

```cpp
#include <hip/hip_runtime.h>
#include <hip/hip_bf16.h>
#include <cstdio>
#include <cstdint>
#include <cmath>
namespace pg8 {
#ifndef PG8_PRIO8
#define PG8_PRIO8 1
#endif
#ifndef PG8_DMAFIRST
#define PG8_DMAFIRST 0
#endif
#if PG8_DMAFIRST
#define PG8_DMAFIRST_A(x) x
#define PG8_DMAFIRST_B(x)
#else
#define PG8_DMAFIRST_A(x)
#define PG8_DMAFIRST_B(x) x
#endif
#ifndef PG8_BAL
#define PG8_BAL 0
#endif
#define PG8_LAS __attribute__((address_space(3)))
typedef unsigned short bf16_t;
typedef short bf16x8 __attribute__((ext_vector_type(8)));
typedef float f32x4 __attribute__((ext_vector_type(4)));
typedef float f32x2 __attribute__((ext_vector_type(2)));
typedef unsigned u32x4 __attribute__((ext_vector_type(4)));
typedef unsigned u32x2 __attribute__((ext_vector_type(2)));
typedef int i32x8 __attribute__((ext_vector_type(8)));
typedef float f32x16 __attribute__((ext_vector_type(16)));
constexpr int BM = 256, BK = 64, HALF = 128, HTB = HALF * BK * 2  , STAGE_BYTES = 8 * HTB, NXCD = 8, WGM = 8;

__host__ __device__ __forceinline__ int lds_byte(int r, int c) { const int st = (r >> 4) * 2 + (c >> 5), rr = r & 15, cc = c & 31, ob = rr * 64 + cc * 2; return st * 1024 + (ob ^ (((ob >> 9) & 1) << 5)); }
__host__ __device__ __forceinline__ void stage_rc(int b, int& R, int& C) { const int st = b / 1024, sb = b % 1024, swz = sb ^ (((sb >> 9) & 1) << 5); R = (st >> 1) * 16 + swz / 64; C = (st & 1) * 32 + (swz % 64) / 2; }
__host__ __device__ __forceinline__ int perm32b(int rho) { return 16 * ((rho >> 2) & 1) + (rho & 3) + 4 * (rho >> 3); }
__host__ __device__ __forceinline__ int perm32(int rho) { const int n = rho >> 4, i = rho & 15; return 8 * (i >> 2) + 4 * n + (i & 3); }

struct Unit { int pm, pn, e, mt; };

struct DenseOrder {
    const char* A; const char* Bt; int K;
    int nM, nN, nwg, G, c;
    __device__ void init(const void* A_, const void* Bt_, int M, int N, int K_, int G_, int c_) { A = (const char*)A_; Bt = (const char*)Bt_; K = K_; nM = M / BM; nN = N / BM; nwg = nM * nN; G = G_; c = c_; }
    __device__ __forceinline__ bool next(int i, Unit& u) const {
        const long L = (long)i * G + c; if (L >= nwg) return false;
        int wgid = (int)L; { const int q = nwg / NXCD, r = nwg % NXCD, xcd = wgid % NXCD, off = wgid / NXCD; wgid = (xcd < r ? xcd * (q + 1) : r * (q + 1) + (xcd - r) * q) + off; }
        const int nig = WGM * nN, gid = wgid / nig, fm = gid * WGM, gsz = (nM - fm) < WGM ? (nM - fm) : WGM;
        u.pm = fm + ((wgid % nig) % gsz); u.pn = (wgid % nig) / gsz; u.e = 0; u.mt = 0; return true;
    }
    __device__ __forceinline__ const char* a_base(const Unit& u) const { return A + (size_t)u.pm * BM * K * 2; }
    __device__ __forceinline__ const char* b_base(const Unit& u) const { return Bt + (size_t)u.pn * BM * K * 2; }
    __device__ __forceinline__ unsigned row_off(const Unit&, int r) const { return (unsigned)(r * K * 2); }
    __device__ __forceinline__ const int* tok_ptr(const Unit&, int) const { return nullptr; }
};
struct DenseOrder2 : DenseOrder {
    size_t astride, bstride;
    __device__ __forceinline__ bool next(int i, Unit& u) const {
        const long L = (long)i * G + c; if (L >= 2L * nwg) return false;
        const int lay = L >= nwg ? 1 : 0; int wgid = (int)(L - (long)lay * nwg); { const int q = nwg / NXCD, r = nwg % NXCD, xcd = wgid % NXCD, off = wgid / NXCD; wgid = (xcd < r ? xcd * (q + 1) : r * (q + 1) + (xcd - r) * q) + off; }
        const int nig = WGM * nN, gid = wgid / nig, fm = gid * WGM, gsz = (nM - fm) < WGM ? (nM - fm) : WGM;
        u.pm = fm + ((wgid % nig) % gsz); u.pn = (wgid % nig) / gsz; u.e = lay; u.mt = 0; return true;
    }
    __device__ __forceinline__ const char* a_base(const Unit& u) const { return A + (size_t)u.e * astride + (size_t)u.pm * BM * K * 2; }
    __device__ __forceinline__ const char* b_base(const Unit& u) const { return Bt + (size_t)u.e * bstride + (size_t)u.pn * BM * K * 2; }
};
template <bool GATHER> struct GroupedOrder {
    const char* A; const char* Bt; int K, N, npn;
    const PG8_LAS int* tiles; const PG8_LAS int* cnt; const int* lists;
    int ntiles, G, vcu;
    __device__ __forceinline__ bool next(int i, Unit& u) const {
        const int L = i * G + vcu; if (L >= ntiles * npn) return false;
        const int ti = L / npn; u.pn = L - ti * npn; const int v = __builtin_amdgcn_readfirstlane(tiles[ti]); u.e = v & 255; u.mt = v >> 8; u.pm = ti; return true;
    }
    __device__ __forceinline__ const char* a_base(const Unit& u) const { return GATHER ? A : A + (size_t)u.pm * BM * K * 2; }
    __device__ __forceinline__ const char* b_base(const Unit& u) const { return Bt + ((size_t)u.e * N + (size_t)u.pn * BM) * K * 2; }
    __device__ __forceinline__ const int* tok_ptr(const Unit& u, int r) const { const int c1 = cnt[u.e] - 1; int rr = u.mt * BM + r; rr = rr < c1 ? rr : c1; return lists + 2 * (u.e * 32768 + rr); }
    __device__ __forceinline__ unsigned row_off(const Unit& u, int r) const {
        if (!GATHER) return (unsigned)(r * K * 2);
        const int c1 = cnt[u.e] - 1; int rr = u.mt * BM + r; rr = rr < c1 ? rr : c1; const int tok = lists[2 * (u.e * 32768 + rr)]; return (unsigned)tok * (unsigned)(K * 2);
    }
};

__device__ __forceinline__ unsigned cvt_pk_bf16(float lo, float hi) { unsigned r; asm volatile("v_cvt_pk_bf16_f32 %0, %1, %2" : "=v"(r) : "v"(lo), "v"(hi)); return r; }
__device__ __forceinline__ f32x2 gelu_pk(f32x2 v) {
    const f32x2 av = __builtin_elementwise_abs(v), d = av * 0.2316418882f + 1.0f;
    f32x2 t; t.x = __builtin_amdgcn_rcpf(d.x); t.y = __builtin_amdgcn_rcpf(d.y);
    f32x2 q = t * 0.5307027145f + (-0.7265760135f); q = q * t + 0.7107068705f; q = q * t + (-0.142248368f); q = q * t + 0.127414796f; q = q * t;
    const f32x2 s = (v * v) * (-0.72134752044f);
    f32x2 e; e.x = __builtin_amdgcn_exp2f(s.x); e.y = __builtin_amdgcn_exp2f(s.y);
    const f32x2 m = v * (q * e), r = v - m;
    f32x2 o; o.x = v.x < 0.f ? m.x : r.x; o.y = v.y < 0.f ? m.y : r.y; return o;
}

template <class Epi, class Sched, bool GATHER, bool MIDK, int F8 = 0>
__device__ __forceinline__ void gemm_phase(PG8_LAS unsigned char* lds, const int K, const Sched& S, const Epi& E, const int tid_in) {
    int tid_ = tid_in; asm volatile("" : "+v"(tid_));
    const int tid = tid_, wid = __builtin_amdgcn_readfirstlane(tid >> 6), lane = tid & 63, wr = wid >> 2, wc = wid & 3, fr = lane & 15, fq = lane >> 4;
    const int nt0 = K / BK;
#ifdef PROBE_K2
    const int nt = (F8 != 0 && GATHER) ? 2 * nt0 : nt0;
#else
    const int nt = nt0;
#endif
    unsigned voffA[2], voffB[2], ac[2][2], an[2][2];
    PG8_LAS unsigned char* anb = lds + STAGE_BYTES + 3072;
#pragma unroll
    for (int i = 0; i < 2; ++i) { int R, C; stage_rc(tid * 16 + i * 8192, R, C); if (F8 == 1) C ^= ((R >> 4) & 1) << 3;
        const int Rb = F8 == 1 ? ((R & ~31) + perm32b(R & 31)) : (Epi::PERM ? ((R & ~31) + perm32(R & 31)) : R);
        voffA[i] = (unsigned)(R * K + C) * 2u; voffB[i] = (unsigned)(Rb * K + C) * 2u; ac[0][i] = ac[1][i] = an[0][i] = an[1][i] = 0u; }
    const size_t kstep = (size_t)(BK * 2);
    const size_t hstep = (size_t)HALF * K * 2;
    const unsigned ldsw = (unsigned)wid * 1024u;
    const int aoff = F8 == 1 ? lds_byte(wr * 64 + (lane & 31), (lane >> 5) * 16) + ((lane >> 4) & 1) * 16 : F8 == 2 ? lds_byte(wr * 64 + fr, fq * 16) + (fq & 1) * 16 : lds_byte(wr * 64 + fr, fq * 8);
    const int boff = F8 == 1 ? lds_byte(wc * 32 + (lane & 31), (lane >> 5) * 16) + ((lane >> 4) & 1) * 16 : F8 == 2 ? lds_byte(wc * 32 + fr, fq * 16) + (fq & 1) * 16 : lds_byte(wc * 32 + fr, fq * 8);
    const int aoff2 = aoff ^ 16, boff2 = boff ^ 16;
#define PG8_SA(b, h) (((b) * 2 + (h)) * HTB)
#define PG8_SB(b, h) ((4 + (b) * 2 + (h)) * HTB)
#define PG8_STAGE(bufoff, gbase, voff) do { _Pragma("unroll") for (int _i = 0; _i < 2; ++_i) \
        __builtin_amdgcn_global_load_lds((const unsigned*)((const char*)(gbase) + (voff)[_i]), (PG8_LAS unsigned*)(lds + (bufoff) + ldsw + _i * 8192), 16, 0, 0); } while (0)
#define PG8_STAGE2(bufoff, gbase, o0, o1) do { \
        __builtin_amdgcn_global_load_lds((const unsigned*)((const char*)(gbase) + (o0)), (PG8_LAS unsigned*)(lds + (bufoff) + ldsw), 16, 0, 0); \
        __builtin_amdgcn_global_load_lds((const unsigned*)((const char*)(gbase) + (o1)), (PG8_LAS unsigned*)(lds + (bufoff) + ldsw + 8192), 16, 0, 0); } while (0)
#define PG8_LDA(dst, b, h) do { _Pragma("unroll") for (int m = 0; m < 4; ++m) _Pragma("unroll") for (int k = 0; k < 2; ++k) dst[m][k] = *(const PG8_LAS bf16x8*)(lds + PG8_SA(b, h) + aoff + m * 2048 + k * 1024); } while (0)
#define PG8_LDB(dst, b, h) do { _Pragma("unroll") for (int n = 0; n < 2; ++n) _Pragma("unroll") for (int k = 0; k < 2; ++k) dst[n][k] = *(const PG8_LAS bf16x8*)(lds + PG8_SB(b, h) + boff + n * 2048 + k * 1024); } while (0)
#define PG8_MMA(ai, bj, At, Bt) do { __builtin_amdgcn_s_setprio(1); _Pragma("unroll") for (int m = 0; m < 4; ++m) _Pragma("unroll") for (int n = 0; n < 2; ++n) _Pragma("unroll") for (int k = 0; k < 2; ++k) \
        acc[ai][bj][m][n] = __builtin_amdgcn_mfma_f32_16x16x32_bf16(Bt[n][k], At[m][k], acc[ai][bj][m][n], 0, 0, 0); __builtin_amdgcn_s_setprio(0); } while (0)
#define PG8_LDA8(dst, b, h) do { _Pragma("unroll") for (int m = 0; m < 2; ++m) _Pragma("unroll") for (int k = 0; k < 2; ++k) { const u32x4 lo_ = *(const PG8_LAS u32x4*)(lds + PG8_SA(b, h) + aoff + m * 4096 + k * 1024), hi_ = *(const PG8_LAS u32x4*)(lds + PG8_SA(b, h) + aoff2 + m * 4096 + k * 1024); \
        dst[m][k] = (i32x8){(int)lo_.x, (int)lo_.y, (int)lo_.z, (int)lo_.w, (int)hi_.x, (int)hi_.y, (int)hi_.z, (int)hi_.w}; } } while (0)
#define PG8_LDB8(dst, b, h) do { _Pragma("unroll") for (int k = 0; k < 2; ++k) { const u32x4 lo_ = *(const PG8_LAS u32x4*)(lds + PG8_SB(b, h) + boff + k * 1024), hi_ = *(const PG8_LAS u32x4*)(lds + PG8_SB(b, h) + boff2 + k * 1024); \
        dst[k] = (i32x8){(int)lo_.x, (int)lo_.y, (int)lo_.z, (int)lo_.w, (int)hi_.x, (int)hi_.y, (int)hi_.z, (int)hi_.w}; } } while (0)
#define PG8_MMA8(ai, bj, At, Bt) do { if (PG8_PRIO8) __builtin_amdgcn_s_setprio(1); _Pragma("unroll") for (int m = 0; m < 2; ++m) _Pragma("unroll") for (int k = 0; k < 2; ++k) \
        acc8[ai][bj][m] = __builtin_amdgcn_mfma_scale_f32_32x32x64_f8f6f4(Bt[k], At[m][k], acc8[ai][bj][m], 0, 0, 0, sc_w, 0, sc_x); if (PG8_PRIO8) __builtin_amdgcn_s_setprio(0); } while (0)
#define PG8_LDA16(dst, b, h) do { _Pragma("unroll") for (int m = 0; m < 4; ++m) { const u32x4 lo_ = *(const PG8_LAS u32x4*)(lds + PG8_SA(b, h) + aoff + m * 2048), hi_ = *(const PG8_LAS u32x4*)(lds + PG8_SA(b, h) + aoff2 + m * 2048); \
        dst[m] = (i32x8){(int)lo_.x, (int)lo_.y, (int)lo_.z, (int)lo_.w, (int)hi_.x, (int)hi_.y, (int)hi_.z, (int)hi_.w}; } } while (0)
#define PG8_LDB16(dst, b, h) do { _Pragma("unroll") for (int n = 0; n < 2; ++n) { const u32x4 lo_ = *(const PG8_LAS u32x4*)(lds + PG8_SB(b, h) + boff + n * 2048), hi_ = *(const PG8_LAS u32x4*)(lds + PG8_SB(b, h) + boff2 + n * 2048); \
        dst[n] = (i32x8){(int)lo_.x, (int)lo_.y, (int)lo_.z, (int)lo_.w, (int)hi_.x, (int)hi_.y, (int)hi_.z, (int)hi_.w}; } } while (0)
#define PG8_MMA16(ai, bj, At, Bt) do { __builtin_amdgcn_s_setprio(1); _Pragma("unroll") for (int m = 0; m < 4; ++m) _Pragma("unroll") for (int n = 0; n < 2; ++n) \
        asm volatile("s_nop 1\n\tv_mfma_scale_f32_16x16x128_f8f6f4 %0, %1, %2, %0, %3, %4 op_sel_hi:[0,0,0]" : "+v"(acc[ai][bj][m][n]) : "v"(Bt[n]), "v"(At[m]), "v"(sc_w), "v"(sc_x)); __builtin_amdgcn_s_setprio(0); } while (0)
#define PG8_XLDA(b, h) do { if constexpr (F8 == 1) { PG8_LDA8(At8, b, h); } else if constexpr (F8 == 2) { PG8_LDA16(At16, b, h); } else { PG8_LDA(At, b, h); } } while (0)
#define PG8_XLDB0(b, h) do { if constexpr (F8 == 1) { PG8_LDB8(B08, b, h); } else if constexpr (F8 == 2) { PG8_LDB16(B016, b, h); } else { PG8_LDB(B0, b, h); } } while (0)
#define PG8_XLDB1(b, h) do { if constexpr (F8 == 1) { PG8_LDB8(B18, b, h); } else if constexpr (F8 == 2) { PG8_LDB16(B116, b, h); } else { PG8_LDB(B1, b, h); } } while (0)
#define PG8_XMMA0(ai, bj) do { if constexpr (F8 == 1) { PG8_MMA8(ai, bj, At8, B08); } else if constexpr (F8 == 2) { PG8_MMA16(ai, bj, At16, B016); } else { PG8_MMA(ai, bj, At, B0); } } while (0)
#define PG8_XMMA1(ai, bj) do { if constexpr (F8 == 1) { PG8_MMA8(ai, bj, At8, B18); } else if constexpr (F8 == 2) { PG8_MMA16(ai, bj, At16, B116); } else { PG8_MMA(ai, bj, At, B1); } } while (0)
#define PG8_WAIT_V(n) asm volatile("s_waitcnt vmcnt(" #n ")" ::: "memory")
#define PG8_WAIT_V8R PG8_WAIT_V(8)
#define PG8_WAIT_L(n) asm volatile("s_waitcnt lgkmcnt(" #n ")" ::: "memory")
#define PG8_BAR __builtin_amdgcn_s_barrier()
#define PG8_SCHED __builtin_amdgcn_sched_barrier(0)
#define PG8_AOFFS(dst, u) do { if constexpr (GATHER) { int t2_ = tid; asm volatile("" : "+v"(t2_)); _Pragma("unroll") for (int _i = 0; _i < 2; ++_i) { int R_, C_; stage_rc(t2_ * 16 + _i * 8192, R_, C_); if (F8 == 1) C_ ^= ((R_ >> 4) & 1) << 3; \
        _Pragma("unroll") for (int _h = 0; _h < 2; ++_h) dst[_h][_i] = S.row_off(u, _h * HALF + R_) + (unsigned)(C_ * 2); } } } while (0)
#define PG8_TOKDMA(u) do { int t2_ = tid; asm volatile("" : "+v"(t2_)); _Pragma("unroll") for (int _i = 0; _i < 2; ++_i) { int R_, C_; stage_rc(t2_ * 16 + _i * 8192, R_, C_); \
        _Pragma("unroll") for (int _h = 0; _h < 2; ++_h) __builtin_amdgcn_global_load_lds((const unsigned*)S.tok_ptr(u, _h * HALF + R_), (PG8_LAS unsigned*)(anb + (_h * 2 + _i) * 2048 + wid * 256), 4, 0, 0); } } while (0)
#define PG8_STAGE_A(bufoff, gp, h, o0, o1) do { if constexpr (GATHER) { PG8_STAGE2(bufoff, gp, o0, o1); } else { PG8_STAGE(bufoff, (gp) + (h) * hstep, voffA); } } while (0)
    Unit cur, nxt; int ui = 0;
    if (!S.next(0, cur)) return;
    f32x4 acc[2][2][4][2];
#pragma unroll
    for (int a = 0; a < 2; ++a)
#pragma unroll
        for (int b = 0; b < 2; ++b)
#pragma unroll
            for (int m = 0; m < 4; ++m)
#pragma unroll
                for (int n = 0; n < 2; ++n) acc[a][b][m][n] = (f32x4){0.f, 0.f, 0.f, 0.f};
    bf16x8 At[4][2], B0[2][2], B1[2][2];
    f32x16 acc8[2][2][2]; i32x8 At8[2][2], B08[2], B18[2], At16[4], B016[2], B116[2];
    int sc_w = 0, sc_x = 0; if constexpr (F8 != 0) { sc_w = Epi::SCALE_W; sc_x = Epi::SCALE_X; asm volatile("" : "+v"(sc_w), "+v"(sc_x)); }
#pragma unroll
    for (int a = 0; a < 2; ++a)
#pragma unroll
        for (int b = 0; b < 2; ++b)
#pragma unroll
            for (int m = 0; m < 2; ++m) acc8[a][b][m] = f32x16{};
    const char* cA = S.a_base(cur); const char* cB = S.b_base(cur);
    PG8_AOFFS(ac, cur);
    if constexpr (GATHER) {
        Unit u1_; if (S.next(1, u1_)) { PG8_TOKDMA(u1_); } else { PG8_TOKDMA(cur); }
    }
    PG8_LAS unsigned char* epib = lds + STAGE_BYTES + 11264;
    if constexpr (F8 == 1) { int ln_e = lane; asm volatile("" : "+v"(ln_e)); E.epidma(cur, epib, wid, ln_e); }
    PG8_STAGE(PG8_SB(0, 0), cB, voffB); PG8_STAGE(PG8_SB(0, 1), cB + hstep, voffB); PG8_STAGE_A(PG8_SA(0, 0), cA, 0, ac[0][0], ac[0][1]); PG8_STAGE_A(PG8_SA(0, 1), cA, 1, ac[1][0], ac[1][1]);
    if (wr == 1) PG8_BAR;
    PG8_WAIT_V(2); PG8_BAR;
#if PG8_BAL
    PG8_STAGE(PG8_SB(1, 1), cB + hstep + kstep, voffB); PG8_STAGE_A(PG8_SA(1, 0), cA + kstep, 0, ac[0][0], ac[0][1]);
    PG8_WAIT_V(4); PG8_BAR;
#else
    PG8_STAGE(PG8_SB(1, 0), cB + kstep, voffB); PG8_STAGE_A(PG8_SA(1, 0), cA + kstep, 0, ac[0][0], ac[0][1]); PG8_STAGE(PG8_SB(1, 1), cB + hstep + kstep, voffB);
    PG8_WAIT_V(6); PG8_BAR;
#endif
    bool fresh = false;
    for (;;) {
        float pre[4] = {0.f, 0.f, 0.f, 0.f};
        if constexpr (F8 == 1) { E.prefetch(cur, wr, lane & 31, pre); }
        const bool has_next = S.next(ui + 1, nxt);
        const char* nA = has_next ? S.a_base(nxt) : cA; const char* nB = has_next ? S.b_base(nxt) : cB;
        for (int t = 0; t < nt; t += 2) {
            const bool last = (t == nt - 2);
            if constexpr (MIDK) { if (t == Epi::MIDK_T) { int fr_e = fr, fq_e = fq; asm volatile("" : "+v"(fr_e), "+v"(fq_e)); E.midk(acc, cur, wr, fr_e, fq_e); } }
            const char* a1 = cA + (size_t)((t + 1) & (nt0 - 1)) * kstep;
            const char* a2 = last ? nA : cA + (size_t)((t + 2) & (nt0 - 1)) * kstep; const char* b2 = last ? nB : cB + (size_t)((t + 2) & (nt0 - 1)) * kstep;
            const char* a3 = a2 + kstep; const char* b3 = b2 + kstep;
            unsigned o00 = ac[0][0], o01 = ac[0][1], o10 = ac[1][0], o11 = ac[1][1];
            if constexpr (GATHER) { if (last) { int t2_ = tid; asm volatile("" : "+v"(t2_));
#pragma unroll
                for (int _i = 0; _i < 2; ++_i) { int R_, C_; stage_rc(t2_ * 16 + _i * 8192, R_, C_); if (F8 == 1) C_ ^= ((R_ >> 4) & 1) << 3;
#pragma unroll
                    for (int _h = 0; _h < 2; ++_h) an[_h][_i] = *(const PG8_LAS unsigned*)(anb + (_h * 2 + _i) * 2048 + t2_ * 4) * (unsigned)(K * 2) + (unsigned)(C_ * 2); }
                o00 = an[0][0]; o01 = an[0][1]; o10 = an[1][0]; o11 = an[1][1]; } }
#if PG8_BAL
            const char* b1 = cB + (size_t)((t + 1) & (nt0 - 1)) * kstep;
            PG8_XLDB0(0, 0); PG8_XLDB1(0, 1); PG8_SCHED; PG8_XLDA(0, 0); PG8_STAGE(PG8_SB(1, 0), b1, voffB); PG8_STAGE_A(PG8_SA(1, 1), a1, 1, ac[1][0], ac[1][1]);
            PG8_WAIT_V(8); PG8_WAIT_L(0); PG8_BAR; PG8_XMMA0(0, 0); PG8_XMMA1(0, 1); PG8_BAR; PG8_SCHED;
            PG8_XLDA(0, 1); PG8_STAGE(PG8_SB(0, 1), b2 + hstep, voffB); PG8_STAGE_A(PG8_SA(0, 0), a2, 0, o00, o01);
            PG8_WAIT_V(6); PG8_WAIT_L(0); PG8_BAR; PG8_XMMA0(1, 0); PG8_XMMA1(1, 1); PG8_BAR; PG8_SCHED;
            PG8_XLDB0(1, 0); PG8_XLDB1(1, 1); PG8_SCHED; PG8_XLDA(1, 0); PG8_STAGE(PG8_SB(0, 0), b2, voffB); PG8_STAGE_A(PG8_SA(0, 1), a2, 1, o10, o11);
            PG8_WAIT_V(8); PG8_WAIT_L(0); PG8_BAR; PG8_XMMA0(0, 0); PG8_XMMA1(0, 1); PG8_BAR; PG8_SCHED;
            PG8_XLDA(1, 1); PG8_STAGE(PG8_SB(1, 1), b3 + hstep, voffB); PG8_STAGE_A(PG8_SA(1, 0), a3, 0, o00, o01);
            PG8_WAIT_V(6); PG8_WAIT_L(0); PG8_BAR; PG8_XMMA0(1, 0); PG8_XMMA1(1, 1); PG8_BAR; PG8_SCHED;
#else
            PG8_DMAFIRST_A(PG8_STAGE_A(PG8_SA(1, 1), a1, 1, ac[1][0], ac[1][1])); PG8_XLDB0(0, 0); PG8_XLDB1(0, 1); PG8_SCHED; PG8_XLDA(0, 0); PG8_DMAFIRST_B(PG8_STAGE_A(PG8_SA(1, 1), a1, 1, ac[1][0], ac[1][1]));
            PG8_WAIT_V8R; PG8_WAIT_L(0); PG8_BAR; PG8_XMMA0(0, 0); PG8_XMMA1(0, 1); PG8_BAR; PG8_SCHED;
            PG8_DMAFIRST_B(PG8_XLDA(0, 1)); PG8_STAGE(PG8_SB(0, 0), b2, voffB); PG8_STAGE(PG8_SB(0, 1), b2 + hstep, voffB); PG8_STAGE_A(PG8_SA(0, 0), a2, 0, o00, o01); PG8_DMAFIRST_A(PG8_XLDA(0, 1));
            PG8_WAIT_V8R; PG8_WAIT_L(0); PG8_BAR; PG8_XMMA0(1, 0); PG8_XMMA1(1, 1); PG8_BAR; PG8_SCHED;
            PG8_DMAFIRST_A(PG8_STAGE_A(PG8_SA(0, 1), a2, 1, o10, o11)); PG8_XLDB0(1, 0); PG8_XLDB1(1, 1); PG8_SCHED; PG8_XLDA(1, 0); PG8_DMAFIRST_B(PG8_STAGE_A(PG8_SA(0, 1), a2, 1, o10, o11));
            PG8_WAIT_V(8); PG8_WAIT_L(0); PG8_BAR; PG8_XMMA0(0, 0); PG8_XMMA1(0, 1); PG8_BAR; PG8_SCHED;
            PG8_DMAFIRST_B(PG8_XLDA(1, 1)); PG8_STAGE(PG8_SB(1, 0), b3, voffB); PG8_STAGE(PG8_SB(1, 1), b3 + hstep, voffB); PG8_STAGE_A(PG8_SA(1, 0), a3, 0, o00, o01); PG8_DMAFIRST_A(PG8_XLDA(1, 1));
            PG8_WAIT_V(8); PG8_WAIT_L(0); PG8_BAR; PG8_XMMA0(1, 0); PG8_XMMA1(1, 1); PG8_BAR; PG8_SCHED;
#endif
        }
#ifdef PROBE_EPI
        unsigned long long pe0_ = 0; if (Epi::PID == PROBE_EPI) pe0_ = __builtin_amdgcn_s_memrealtime();
#endif
        if (wr == 0) PG8_BAR;
        if constexpr (F8 == 1) { int r32_e = lane & 31, hi_e = lane >> 5; asm volatile("" : "+v"(r32_e), "+v"(hi_e)); E(acc8, cur, wr, wc, r32_e, hi_e, pre, epib + (ui & 1) * 2048); }
        else { int fr_e = fr, fq_e = fq; asm volatile("" : "+v"(fr_e), "+v"(fq_e)); E(acc, cur, wr, wc, fr_e, fq_e); }
        if constexpr (GATHER) { Unit u2_; if (S.next(ui + 2, u2_)) { PG8_TOKDMA(u2_); } }
        if constexpr (F8 == 1) { if (has_next) { int ln_e = lane; asm volatile("" : "+v"(ln_e)); E.epidma(nxt, epib + ((ui + 1) & 1) * 2048, wid, ln_e); } }
        if (!has_next) break;
#pragma unroll
        for (int a = 0; a < 2; ++a)
#pragma unroll
            for (int b = 0; b < 2; ++b)
#pragma unroll
                for (int m = 0; m < 4; ++m)
#pragma unroll
                    for (int n = 0; n < 2; ++n) acc[a][b][m][n] = (f32x4){0.f, 0.f, 0.f, 0.f};
#pragma unroll
        for (int a = 0; a < 2; ++a)
#pragma unroll
            for (int b = 0; b < 2; ++b)
#pragma unroll
                for (int m = 0; m < 2; ++m) acc8[a][b][m] = f32x16{};
        cur = nxt; cA = nA; cB = nB; ++ui; fresh = true;
        if constexpr (GATHER) {
#pragma unroll
            for (int _h = 0; _h < 2; ++_h)
#pragma unroll
                for (int _i = 0; _i < 2; ++_i) ac[_h][_i] = an[_h][_i];
        }
        if (wr == 1) PG8_BAR;
#ifdef PROBE_EPI
        if (Epi::PID == PROBE_EPI && tid == 0) { PG8_LAS unsigned long long* pa_ = (PG8_LAS unsigned long long*)(lds + STAGE_BYTES + 384); *pa_ += __builtin_amdgcn_s_memrealtime() - pe0_; }
#endif
    }
    PG8_WAIT_V(0);
    PG8_BAR;
#undef PG8_SA
#undef PG8_SB
#undef PG8_STAGE
#undef PG8_STAGE2
#undef PG8_LDA
#undef PG8_LDB
#undef PG8_MMA
#undef PG8_WAIT_V
#undef PG8_WAIT_L
#undef PG8_WAIT_V8R
#undef PG8_BAR
#undef PG8_SCHED
#undef PG8_AOFFS
#undef PG8_TOKDMA
#undef PG8_XLDA
#undef PG8_XLDB0
#undef PG8_XLDB1
#undef PG8_XMMA0
#undef PG8_XMMA1
#undef PG8_LDA8
#undef PG8_LDB8
#undef PG8_MMA8
#undef PG8_LDA16
#undef PG8_LDB16
#undef PG8_MMA16
#undef PG8_STAGE_A
}
}
namespace attn_body {
using bf16=__hip_bfloat16;
using bf16x8=__attribute__((ext_vector_type(8)))short;
using s16x4=__attribute__((ext_vector_type(4)))short;
using f32x16=__attribute__((ext_vector_type(16)))float;
using u32x4=__attribute__((ext_vector_type(4)))unsigned;
constexpr int BATCH=8,NHEAD=8,SEQ=4096,D=64,DM=NHEAD*D,ODM=1024;
constexpr int NW=8,QBLK=32,QB=QBLK*NW,KVBLK=64,NQB=SEQ/QB;
constexpr int ATTN_PITCH=DM, ATTN_UNIT_ROWS=QB;
__device__ __forceinline__ int crow(int r,int hi){return (r&3)+8*(r>>2)+4*hi;}
#define SBAR() __builtin_amdgcn_sched_barrier(0)
__device__ __forceinline__ void cmask(f32x16&p0,f32x16&p1,int jb,int qrel,int hi){
  const float NEG=-INFINITY; int kb=64*jb+4*hi;
  #pragma unroll
  for(int r=0;r<16;++r){int kv=kb+(r&3)+8*(r>>2); if(kv>qrel)p0[r]=NEG; if(kv+32>qrel)p1[r]=NEG;}
}

constexpr int NSLOT=3, SLOTB=8192;
constexpr int LDS_K=0, LDS_V=NSLOT*SLOTB, LDS_WS=2*NSLOT*SLOTB, LDS_OST=LDS_WS+NW*64*4, LDS_KX=86016, LDS_BYTES=LDS_KX+SEQ*8;
constexpr float C2=0.125f*1.4426950408889634f;
__device__ __forceinline__ void glds16(const void*gsrc,unsigned lds_dst){unsigned keep;
  asm volatile("s_mov_b32 %0, m0\n\ts_mov_b32 m0, %2\n\ts_nop 0\n\tglobal_load_lds_dwordx4 %1, off\n\ts_mov_b32 m0, %0":"=&s"(keep):"v"(gsrc),"s"(lds_dst):"memory");}
__device__ __forceinline__ float max3f(float a,float b,float c){float r;asm("v_max3_f32 %0, %1, %2, %3":"=v"(r):"v"(a),"v"(b),"v"(c));return r;}
__device__ __forceinline__ float max2f(float a,float b){float r;asm("v_max_f32_e32 %0, %1, %2":"=v"(r):"v"(a),"v"(b));return r;}
__device__ __forceinline__ float fadd_s(float a,float b){float r;asm("v_add_f32_e32 %0, %1, %2":"=v"(r):"v"(a),"v"(b));return r;}
__device__ __forceinline__ float fsub_s(float a,float b){float r;asm("v_sub_f32_e32 %0, %1, %2":"=v"(r):"v"(a),"v"(b));return r;}
typedef float f32x2_t __attribute__((ext_vector_type(2))); typedef __bf16 bf16x2_t __attribute__((ext_vector_type(2)));
__device__ __forceinline__ unsigned cvtpk_s(float lo,float hi){f32x2_t v={lo,hi};bf16x2_t b=__builtin_convertvector(v,bf16x2_t);return __builtin_bit_cast(unsigned,b);}
#define WAIT_BAR(N) asm volatile("s_waitcnt vmcnt(" #N ") lgkmcnt(0)\n\ts_barrier":::"memory")


typedef unsigned kx2_t __attribute__((ext_vector_type(2)));
__device__ __forceinline__ unsigned f2bf_(float f){unsigned u=__builtin_bit_cast(unsigned,f);return (u+0x7fffu+((u>>16)&1u))>>16;}
__device__ __forceinline__ float bf2f_(unsigned h){return __builtin_bit_cast(float,h<<16);}
__device__ __forceinline__ bf16x8 mk_qx(float mhat,int hi){ const float nm=-mhat; const unsigned h=f2bf_(nm); const float r1=nm-bf2f_(h); const unsigned m=f2bf_(r1); const float r2=r1-bf2f_(m); const unsigned l=f2bf_(r2);
  u32x4 w; w.x=hi?0u:0x3F803F80u; w.y=hi?0u:(0x3F80u|(h<<16)); w.z=hi?0u:(m|(l<<16)); w.w=0u; return __builtin_bit_cast(bf16x8,w); }
__device__ __forceinline__ bf16x8 mk_kx(kx2_t k,int hi){ (void)hi; u32x4 w; w.x=k.x; w.y=k.y; w.z=0x3F803F80u; w.w=0u; return __builtin_bit_cast(bf16x8,w); }
__device__ __forceinline__ void qkt(f32x16&p0,f32x16&p1,const char*Kslot,const bf16x8*qr,const bf16x8 qx,const bf16x8 kxa,const bf16x8 kxb,int r32,int hi){
  p0=__builtin_amdgcn_mfma_f32_32x32x16_bf16(kxa,qx,f32x16{},0,0,0);p1=__builtin_amdgcn_mfma_f32_32x32x16_bf16(kxb,qx,f32x16{},0,0,0);
  const char*kb=Kslot+hi*1024+r32*16;
  #pragma unroll
  for(int d0=0;d0<4;++d0){
    const bf16x8 b0=*reinterpret_cast<const bf16x8*>(kb+d0*2048);
    const bf16x8 b1=*reinterpret_cast<const bf16x8*>(kb+d0*2048+512);
    p0=__builtin_amdgcn_mfma_f32_32x32x16_bf16(b0,qr[d0],p0,0,0,0);p1=__builtin_amdgcn_mfma_f32_32x32x16_bf16(b1,qr[d0],p1,0,0,0);}
}
typedef __attribute__((address_space(3))) const char* lds_cptr;
typedef short v4i16_t __attribute__((ext_vector_type(4)));
__device__ __forceinline__ void kload8(bf16x8*kf,lds_cptr kp){
  kf[0]=*(const __attribute__((address_space(3))) bf16x8*)(kp);      kf[1]=*(const __attribute__((address_space(3))) bf16x8*)(kp+512);
  kf[2]=*(const __attribute__((address_space(3))) bf16x8*)(kp+2048); kf[3]=*(const __attribute__((address_space(3))) bf16x8*)(kp+2560);
  kf[4]=*(const __attribute__((address_space(3))) bf16x8*)(kp+4096); kf[5]=*(const __attribute__((address_space(3))) bf16x8*)(kp+4608);
  kf[6]=*(const __attribute__((address_space(3))) bf16x8*)(kp+6144); kf[7]=*(const __attribute__((address_space(3))) bf16x8*)(kp+6656);
}
__device__ __forceinline__ void kload2(bf16x8*kf,lds_cptr kp,int j){ kf[2*j]=*(const __attribute__((address_space(3))) bf16x8*)(kp+j*2048); kf[2*j+1]=*(const __attribute__((address_space(3))) bf16x8*)(kp+j*2048+512); }
__device__ __forceinline__ s16x4 vtr(lds_cptr p){ return __builtin_bit_cast(s16x4,__builtin_amdgcn_ds_read_tr16_b64_v4i16((__attribute__((address_space(3))) v4i16_t*)p)); }
__device__ __forceinline__ float rowmax(const f32x16&p0,const f32x16&p1){
  float a=max3f(p0[0],p0[1],p1[0]),b=max3f(p0[2],p0[3],p1[1]);a=max3f(a,p1[2],p1[3]);
  #pragma unroll
  for(int r=4;r<16;r+=4){a=max3f(a,p0[r],p0[r+1]);b=max3f(b,p0[r+2],p0[r+3]);a=max3f(a,p1[r],p1[r+1]);b=max3f(b,p1[r+2],p1[r+3]);}
  const float m=max2f(a,b);
  auto rr=__builtin_amdgcn_permlane32_swap(__float_as_uint(m),__float_as_uint(m),false,false);
  return max2f(__uint_as_float(rr[0]),__uint_as_float(rr[1]));
}
__device__ __forceinline__ void pv(f32x16*o,int vb,bf16x8 pa0,bf16x8 pa1,bf16x8 pa2,bf16x8 pa3){
  #pragma unroll
  for(int d0=0;d0<2;++d0){s16x4 lo[4],hi[4];
    #pragma unroll
    for(int ks=0;ks<4;++ks){
      asm volatile("ds_read_b64_tr_b16 %0,%1 offset:%c2":"=&v"(lo[ks]):"v"(vb),"i"(d0*4096+ks*1024):"memory");
      asm volatile("ds_read_b64_tr_b16 %0,%1 offset:%c2":"=&v"(hi[ks]):"v"(vb),"i"(d0*4096+ks*1024+512):"memory");}
    asm volatile("s_waitcnt lgkmcnt(0)":::"memory");SBAR();
    #define PK(k) (bf16x8){lo[k][0],lo[k][1],lo[k][2],lo[k][3],hi[k][0],hi[k][1],hi[k][2],hi[k][3]}
    o[d0]=__builtin_amdgcn_mfma_f32_32x32x16_bf16(pa0,PK(0),o[d0],0,0,0);
    o[d0]=__builtin_amdgcn_mfma_f32_32x32x16_bf16(pa1,PK(1),o[d0],0,0,0);
    o[d0]=__builtin_amdgcn_mfma_f32_32x32x16_bf16(pa2,PK(2),o[d0],0,0,0);
    o[d0]=__builtin_amdgcn_mfma_f32_32x32x16_bf16(pa3,PK(3),o[d0],0,0,0);
    #undef PK
  }
}

#ifndef ATTN_STORE16
#define ATTN_STORE16(p,v) (*(u32x4*)(p)=(v))
#endif
template<int THRL> __device__ __forceinline__ void attn_unit(int b,int h,int qb,const bf16*Q,const bf16*__restrict__ K,const bf16*__restrict__ V,bf16*O,float*OSS,char*shm,const int tid_in,const float theta,unsigned*grab_ctr,unsigned&grabbed){
  int tid_=tid_in; asm volatile("":"+v"(tid_)); const int tid=tid_,lane=tid&63,r32=lane&31,hi=lane>>5; const int wid=__builtin_amdgcn_readfirstlane(tid>>6);
  const long rowbase=(long)b*SEQ; const int q0=qb*QB;
  const bf16*Qw=Q+(rowbase+q0+wid*QBLK)*DM+h*D;
  int t0=0; { const __attribute__((address_space(3))) kx2_t*kb_=(const __attribute__((address_space(3))) kx2_t*)((lds_cptr)shm+LDS_KX);
    auto bias_at=[&](int k)->float{ const kx2_t e=kb_[k]; return bf2f_(e.x&0xffffu)+bf2f_(e.x>>16)+bf2f_(e.y&0xffffu); };
    const float lim=bias_at(q0)-theta; int lo_=0,hi_=((q0+QB)/KVBLK-4)>>1;
    while(lo_<hi_){ const int mid_=(lo_+hi_+1)>>1; if(bias_at(128*mid_-1)<=lim)lo_=mid_; else hi_=mid_-1; }
    t0=__builtin_amdgcn_readfirstlane(2*lo_); }
  const bf16*Kh=K+(rowbase+(long)t0*KVBLK)*DM+h*D,*Vh=V+(rowbase+(long)t0*KVBLK)*DM+h*D;
  const unsigned lds0=(unsigned)(uintptr_t)shm;
  float*wsf=(float*)(shm+LDS_WS)+wid*64;
  const bf16*ksrc=Kh+(long)lane*DM+wid*8;
  const bf16*vsrc=Vh+(long)(16*(wid&3)+(lane>>2))*DM+(wid>>2)*32+(lane&3)*8;
  const unsigned kdst=lds0+LDS_K+wid*1024, vdst=lds0+LDS_V+wid*1024;
  #define DMA_K(t,slot) glds16(ksrc+(long)(t)*KVBLK*DM,(unsigned)__builtin_amdgcn_readfirstlane(kdst+(slot)))
  #define DMA_V(t,slot) glds16(vsrc+(long)(t)*KVBLK*DM,(unsigned)__builtin_amdgcn_readfirstlane(vdst+(slot)))
  const int vb0=(int)(lds0+LDS_V)+((lane>>4)&1)*32+(lane&3)*8+(4*hi+((lane&15)>>2))*64;
  const char*Kbase=shm+LDS_K; bf16x8 kf[8];
  const lds_cptr shm3=(lds_cptr)shm; const lds_cptr kp0=shm3+LDS_K+hi*1024+r32*16; const lds_cptr vp0=shm3+LDS_V+((lane>>4)&1)*32+(lane&3)*8+(4*hi+((lane&15)>>2))*64;
  const int NT=(q0+QB)/KVBLK-t0;
  DMA_K(0,0);DMA_V(0,0);DMA_K(1,SLOTB);
  bf16x8 qr[4];
  #pragma unroll
  for(int d0=0;d0<4;++d0)qr[d0]=*reinterpret_cast<const bf16x8*>(&Qw[(long)r32*DM+d0*16+hi*8]);
  float mhat=0.f,l_reg=0.f;f32x16 o[2];o[0]=f32x16{};o[1]=f32x16{};bf16x8 qx=mk_qx(0.f,hi);asm volatile("":"+v"(qx));
  const __attribute__((address_space(3))) kx2_t*kxt=(const __attribute__((address_space(3))) kx2_t*)(shm3+LDS_KX)+r32+64*t0;
  const int qrel=wid*QBLK+r32;
  #define CMASK(P0,P1,t) do{int jb_=(t)-(NT-4); if(jb_>=0)cmask(P0,P1,jb_,qrel,hi);}while(0)
  bool resc=false;
  #define START(P0,P1) do{ const float rm=rowmax(P0,P1); resc=false; \
    { const float dl=rm; mhat=fadd_s(mhat,dl); \
      _Pragma("unroll") for(int r=0;r<16;++r){P0[r]=fsub_s(P0[r],dl);P1[r]=fsub_s(P1[r],dl);} \
      qx=mk_qx(mhat,hi); asm volatile("":"+v"(qx)); } \
    _Pragma("unroll") for(int r=0;r<16;++r)P0[r]=__builtin_amdgcn_exp2f(P0[r]); }while(0)
  #define RESC() do{ if(resc){ asm volatile("s_waitcnt lgkmcnt(0)":::"memory"); \
      _Pragma("unroll") for(int d_=0;d_<2;++d_) _Pragma("unroll") for(int r=0;r<16;++r)o[d_][r]*=wsf[crow(r,hi)]; } }while(0)
  f32x16 pA0,pA1,pB0,pB1;
  int sl_prev=0,sl_cur=0,sl_next=SLOTB;
  #define ROT() do{sl_prev=sl_cur;sl_cur=sl_next;sl_next=(sl_next==(NSLOT-1)*SLOTB)?0:sl_next+SLOTB;}while(0)
  DMA_K(2,2*SLOTB);
  WAIT_BAR(3);
  {const kx2_t ka_=kxt[0],kb_=kxt[32]; qkt(pA0,pA1,Kbase,qr,qx,mk_kx(ka_,hi),mk_kx(kb_,hi),r32,hi);}asm volatile("s_nop 15\n\ts_nop 7":"+v"(pA0),"+v"(pA1));CMASK(pA0,pA1,0);
  START(pA0,pA1);
  _Pragma("unroll") for(int r=0;r<16;++r)pA1[r]=__builtin_amdgcn_exp2f(pA1[r]);
  WAIT_BAR(0);
  DMA_K(3,0);DMA_V(1,SLOTB);
  ROT();
  kload8(kf,kp0+sl_cur);
  WAIT_BAR(2);
  s16x4 vlo[8],vhi[8]; u32x4 pw0,pw1,pw2,pw3;
  #define PKW(P,B) cvtpk_s(P[B],P[B+1])
  #define PAF(k) __builtin_bit_cast(bf16x8,pw##k)
  #define VFR(i) (bf16x8){vlo[i][0],vlo[i][1],vlo[i][2],vlo[i][3],vhi[i][0],vhi[i][1],vhi[i][2],vhi[i][3]}
  #define PIN(x) asm volatile("":"+v"(x))
  #define MX3(a,b,c) __builtin_fmaxf(__builtin_fmaxf((a),(b)),(c))
  #define GAPA(MF,A0,A1,A2,A3,W0,W1,PW) do{ MF; sacc+=A0; sacc+=A1; sacc+=A2; sacc+=A3; PIN(sacc); W0; W1; PIN(PW); SBAR(); }while(0)
  #define EX(v) __builtin_amdgcn_exp2f(v)
  #define GAPB(MF,X,B) do{ MF; X[B]=EX(X[B]); X[B+1]=EX(X[B+1]); X[B+2]=EX(X[B+2]); X[B+3]=EX(X[B+3]); PIN(X); SBAR(); }while(0)
  #define VRD(i) do{ vlo[i]=vtr(vp_+(((i)>>2)*4096+((i)&3)*1024)); vhi[i]=vtr(vp_+(((i)>>2)*4096+((i)&3)*1024+512)); }while(0)
  #define KRD(G,j) do{ if(G){ kload2(kf,kp0+sl_next,j); SBAR(); } }while(0)
  #define STEP(C0,C1,P0,P1,t,GK,GV,GL) do{ SBAR(); \
    const lds_cptr vp_=vp0+sl_prev; \
    { const kx2_t ka_=kxt[64*(t)],kb_=kxt[64*(t)+32]; C0=__builtin_amdgcn_mfma_f32_32x32x16_bf16(mk_kx(ka_,hi),qx,f32x16{},0,0,0); C1=__builtin_amdgcn_mfma_f32_32x32x16_bf16(mk_kx(kb_,hi),qx,f32x16{},0,0,0); } SBAR(); \
    VRD(0); SBAR(); float sacc=(P0[0]+P0[1]); \
    GAPA(C0=__builtin_amdgcn_mfma_f32_32x32x16_bf16(kf[0],qr[0],C0,0,0,0), P0[2],P0[3],P0[4],P0[5],     pw0[0]=PKW(P0,0), pw0[1]=PKW(P0,2), pw0); \
    VRD(4); SBAR(); GAPA(C1=__builtin_amdgcn_mfma_f32_32x32x16_bf16(kf[1],qr[0],C1,0,0,0), P0[6],P0[7],P0[8],P0[9],     pw0[2]=PKW(P0,4), pw0[3]=PKW(P0,6), pw0); \
    VRD(1); SBAR(); GAPA(C0=__builtin_amdgcn_mfma_f32_32x32x16_bf16(kf[2],qr[1],C0,0,0,0),   P0[10],P0[11],P0[12],P0[13], pw1[0]=PKW(P0,8), pw1[1]=PKW(P0,10), pw1); \
    VRD(5); SBAR(); GAPA(C1=__builtin_amdgcn_mfma_f32_32x32x16_bf16(kf[3],qr[1],C1,0,0,0),   P0[14],P0[15],P1[0],P1[1],   pw1[2]=PKW(P0,12),pw1[3]=PKW(P0,14), pw1); \
    VRD(2); SBAR(); GAPA(C0=__builtin_amdgcn_mfma_f32_32x32x16_bf16(kf[4],qr[2],C0,0,0,0),   P1[2],P1[3],P1[4],P1[5],     pw2[0]=PKW(P1,0), pw2[1]=PKW(P1,2), pw2); \
    VRD(6); SBAR(); GAPA(C1=__builtin_amdgcn_mfma_f32_32x32x16_bf16(kf[5],qr[2],C1,0,0,0),   P1[6],P1[7],P1[8],P1[9],     pw2[2]=PKW(P1,4), pw2[3]=PKW(P1,6), pw2); \
    VRD(3); SBAR(); GAPA(C0=__builtin_amdgcn_mfma_f32_32x32x16_bf16(kf[6],qr[3],C0,0,0,0),   P1[10],P1[11],P1[12],P1[13], pw3[0]=PKW(P1,8), pw3[1]=PKW(P1,10), pw3); \
    VRD(7); SBAR(); GAPA(C1=__builtin_amdgcn_mfma_f32_32x32x16_bf16(kf[7],qr[3],C1,0,0,0),   P1[14],P1[15],0.f,0.f,       pw3[2]=PKW(P1,12),pw3[3]=PKW(P1,14), pw3); \
    l_reg+=sacc; \
    if(GK){DMA_K((t)+3,sl_cur);} if(GV){DMA_V((t)+1,sl_next);} \
    CMASK(C0,C1,t); \
    { float a=MX3(C0[0],C0[1],C1[0]),b=MX3(C0[2],C0[3],C1[1]); a=MX3(a,C1[2],C1[3]); \
      _Pragma("unroll") for(int r=4;r<16;r+=4){a=MX3(a,C0[r],C0[r+1]);b=MX3(b,C0[r+2],C0[r+3]);a=MX3(a,C1[r],C1[r+1]);b=MX3(b,C1[r+2],C1[r+3]);} \
      float rm=__builtin_fmaxf(a,b); { auto rr=__builtin_amdgcn_permlane32_swap(__float_as_uint(rm),__float_as_uint(rm),false,false); rm=__builtin_fmaxf(__uint_as_float(rr[0]),__uint_as_float(rr[1])); } \
      resc=false; \
      if(__builtin_expect(__any(rm>(float)THRL),0)){ const float dl=__builtin_fmaxf(rm,0.f); mhat+=dl; \
        _Pragma("unroll") for(int r=0;r<16;++r){C0[r]-=dl;C1[r]-=dl;} \
        qx=mk_qx(mhat,hi); asm volatile("":"+v"(qx)); \
        const float f=__builtin_amdgcn_exp2f(-dl); l_reg*=f; if(hi==0)wsf[r32]=f; resc=true; } } \
    SBAR(); \
    GAPB(o[0]=__builtin_amdgcn_mfma_f32_32x32x16_bf16(PAF(0),VFR(0),o[0],0,0,0), C0,0); \
    GAPB(o[1]=__builtin_amdgcn_mfma_f32_32x32x16_bf16(PAF(0),VFR(4),o[1],0,0,0), C0,4); \
    KRD(GL,0); GAPB(o[0]=__builtin_amdgcn_mfma_f32_32x32x16_bf16(PAF(1),VFR(1),o[0],0,0,0), C0,8); \
    KRD(GL,1); GAPB(o[1]=__builtin_amdgcn_mfma_f32_32x32x16_bf16(PAF(1),VFR(5),o[1],0,0,0), C0,12); \
    KRD(GL,2); GAPB(o[0]=__builtin_amdgcn_mfma_f32_32x32x16_bf16(PAF(2),VFR(2),o[0],0,0,0), C1,0); \
    KRD(GL,3); GAPB(o[1]=__builtin_amdgcn_mfma_f32_32x32x16_bf16(PAF(2),VFR(6),o[1],0,0,0), C1,4); \
    GAPB(o[0]=__builtin_amdgcn_mfma_f32_32x32x16_bf16(PAF(3),VFR(3),o[0],0,0,0), C1,8); \
    GAPB(o[1]=__builtin_amdgcn_mfma_f32_32x32x16_bf16(PAF(3),VFR(7),o[1],0,0,0), C1,12); \
    }while(0)
  int t=1;
  #undef CMASK
  #define CMASK(P0,P1,t) do{}while(0)
  for(;t+5<NT;t+=2){
    STEP(pB0,pB1,pA0,pA1,t,true,true,true);     WAIT_BAR(2); RESC(); ROT();
    STEP(pA0,pA1,pB0,pB1,t+1,true,true,true);   WAIT_BAR(2); RESC(); ROT();
  }
  #undef CMASK
  #define CMASK(P0,P1,t) do{int jb_=(t)-(NT-4); if(jb_>=0)cmask(P0,P1,jb_,qrel,hi);}while(0)
  #define ENDW(tt) do{ if((tt)+3<NT){WAIT_BAR(2);} else if((tt)+2<NT){WAIT_BAR(1);} else {WAIT_BAR(0);} }while(0)
  for(;t+1<NT;t+=2){
    STEP(pB0,pB1,pA0,pA1,t,(t+3<NT),(t+1<NT),(t+1<NT));       ENDW(t);   RESC(); ROT();
    STEP(pA0,pA1,pB0,pB1,t+1,(t+4<NT),(t+2<NT),(t+2<NT));     ENDW(t+1); RESC(); ROT();
  }
  STEP(pB0,pB1,pA0,pA1,NT-1,false,false,false); RESC();
  if(grab_ctr&&tid_in==0) grabbed=__hip_atomic_fetch_add((__attribute__((address_space(1))) unsigned*)grab_ctr,1u,__ATOMIC_RELAXED,__HIP_MEMORY_SCOPE_AGENT);
  { float sacc=pB0[0]+pB0[1]; _Pragma("unroll") for(int r=2;r<16;++r)sacc+=pB0[r]; _Pragma("unroll") for(int r=0;r<16;++r)sacc+=pB1[r]; l_reg+=sacc;
    pw0=(u32x4){PKW(pB0,0),PKW(pB0,2),PKW(pB0,4),PKW(pB0,6)};pw1=(u32x4){PKW(pB0,8),PKW(pB0,10),PKW(pB0,12),PKW(pB0,14)};pw2=(u32x4){PKW(pB1,0),PKW(pB1,2),PKW(pB1,4),PKW(pB1,6)};pw3=(u32x4){PKW(pB1,8),PKW(pB1,10),PKW(pB1,12),PKW(pB1,14)};
    SBAR(); pv(o,vb0+sl_cur,PAF(0),PAF(1),PAF(2),PAF(3)); }
  #undef PKW
  #undef PAF
  #undef VFR
  #undef PIN
  #undef MX3
  #undef GAPA
  #undef GAPB
  #undef EX
  #undef VRD
  #undef KRD
  #undef STEP
  #undef ENDW
  {auto rr=__builtin_amdgcn_permlane32_swap(__float_as_uint(l_reg),__float_as_uint(l_reg),false,false);l_reg=__uint_as_float(rr[0])+__uint_as_float(rr[1]);}
  if(hi==0)wsf[32+r32]=l_reg;asm volatile("s_waitcnt lgkmcnt(0)":::"memory");
  float rli[16];
  #pragma unroll
  for(int r=0;r<16;++r)rli[r]=__builtin_amdgcn_rcpf(wsf[32+crow(r,hi)]);
  bf16*Ow=O+(rowbase+q0+wid*QBLK)*ODM+h*D; float*OSw=OSS+(rowbase+q0+wid*QBLK)*NHEAD+h;
  { bf16*stg=(bf16*)(shm+LDS_OST)+wid*2048;
    #pragma unroll
    for(int r=0;r<16;++r){const int orow=crow(r,hi);
      #pragma unroll
      for(int d0=0;d0<2;++d0)stg[orow*64+d0*32+r32]=__float2bfloat16(o[d0][r]*rli[r]);}
    asm volatile("s_waitcnt lgkmcnt(0)":::"memory");
    #pragma unroll
    for(int i=0;i<4;++i){const int row=i*8+(lane>>3),ch=lane&7; const u32x4 v=*(const u32x4*)(stg+row*64+ch*8); ATTN_STORE16(Ow+(long)row*ODM+ch*8,v);
      float ss=0.f; _Pragma("unroll") for(int j=0;j<4;++j){const float a=__uint_as_float(v[j]<<16),b2=__uint_as_float(v[j]&0xffff0000u); ss+=a*a+b2*b2;}
      ss+=__int_as_float(__builtin_amdgcn_ds_bpermute((lane^1)<<2,__float_as_int(ss)));ss+=__int_as_float(__builtin_amdgcn_ds_bpermute((lane^2)<<2,__float_as_int(ss)));ss+=__int_as_float(__builtin_amdgcn_ds_bpermute((lane^4)<<2,__float_as_int(ss))); if(ch==0)OSw[(long)row*NHEAD]=ss;} }
  asm volatile("s_waitcnt lgkmcnt(0)\n\ts_barrier":::"memory");
  #undef DMA_K
  #undef DMA_V
  #undef CMASK
  #undef START
  #undef RESC
  #undef ROT
}
constexpr int ATTN_LDS_BYTES=LDS_BYTES;
struct AttnTensors { const bf16* Q; const bf16* K; const bf16* V; bf16* O; float* OSS; };
struct AttnUnit { int bh; int qb; };
struct StaticOrder {
  int vcu;
  __device__ __forceinline__ explicit StaticOrder(int v):vcu(v){}
  __device__ __forceinline__ bool next(int i,AttnUnit&u)const{ if(i>=4)return false; const int s=vcu&3; u.bh=vcu>>2; u.qb=(i==0)?s:(i==1)?15-s:(i==2)?4+s:11-s; return true; }
  __device__ __forceinline__ void a_ready(const AttnUnit&)const{}
  __device__ __forceinline__ void done(const AttnUnit&)const{}
};
template<class Sched,int THRL=8> __device__ __forceinline__ void attn_phase(char*lds,const AttnTensors&T,const Sched&S,const int tid_in){
  AttnUnit u;
  for(int i=0;S.next(i,u);++i){ S.a_ready(u); { unsigned g_=0u; attn_unit<THRL>(u.bh/NHEAD,u.bh%NHEAD,u.qb,T.Q,T.K,T.V,T.O,T.OSS,lds,tid_in,0.f,nullptr,g_); } S.done(u); }
}
#undef SBAR
#undef WAIT_BAR
}
constexpr int NWAVES = 8;
constexpr int T = 32768, DM = 1024, SEQ = 4096, NBATCH = 8, NLAYER = 2, NHEADS = 8, NEXP = 32, INC = 2568, NIN = 2560, PLE = 256, MAXTILES = 544;
constexpr float EPS = 1e-5f, LOG2E = 1.4426950408889634f;
constexpr int NSTEPS = 2 + 8 * NLAYER;
#ifndef FP8_SHAPE
#define FP8_SHAPE 32
#endif
#ifndef ATT_PREGRAB
#define ATT_PREGRAB 0
#endif
#ifndef ATT_LATEGRAB
#define ATT_LATEGRAB 1
#endif
#ifndef RD1_NT
#define RD1_NT 1
#endif
#ifndef FROWS
#define FROWS 4
#endif
#ifndef FIN_NT
#define FIN_NT 1
#endif
#ifndef P0_NT
#define P0_NT 0
#endif
#ifndef ATT_SKIP_T
#define ATT_SKIP_T 40.0f
#endif
#ifndef MK_PER_STEP
#define MK_PER_STEP 0
#endif

constexpr size_t MiB = 1u << 20;
constexpr size_t WS_CTL = 0, CTL_ZERO_BYTES = 1 * MiB;
constexpr size_t WS_WFB = 1 * MiB, WS_WRB = WS_WFB + 128 * 1024, WS_WSB = WS_WRB + 128 * 1024;
constexpr size_t WS_WIN = 2 * MiB, WS_WOUT = 12 * MiB, WS_WPG = 16 * MiB, WS_WPLE = 20 * MiB, WS_WGU = 32 * MiB, WS_WDN = 288 * MiB;
constexpr size_t WS_HBA = 416 * MiB, WS_HBB = 480 * MiB;
constexpr size_t WS_SSQX = 544 * MiB, WS_SSQY = 546 * MiB;
constexpr size_t WS_LF = 548 * MiB, WS_OSS = 549 * MiB, WS_RINV = 550 * MiB, WS_TOPE = 551 * MiB, WS_GATE = 551 * MiB + 512 * 1024, WS_LISTS = 552 * MiB  , WS_GSS = 550 * MiB + 512 * 1024;
constexpr size_t WS_U = 560 * MiB, SEG_BYTES = 32 * MiB;
constexpr size_t WS_YC = 720 * MiB;
constexpr size_t WS_ACT = 784 * MiB, WS_YS = 1056 * MiB;
constexpr size_t WS_PB = 1328 * MiB, WS_E = 1360 * MiB, WS_H8 = 1488 * MiB, WS_END = 1520 * MiB;
constexpr int CW_BAR = 4096;
constexpr int CW_NORM = 24576;
constexpr int CW_AQ = 32768;
constexpr int CW_CONV = 65536;
#ifndef P1_F8
#define P1_F8 0
#endif
#ifndef CONV_IN_P2
#define CONV_IN_P2 1
#endif
#ifndef EPI_DMA6
#define EPI_DMA6 1
#endif
#ifndef CONV_DMA
#define CONV_DMA 0
#endif
#ifndef CONV_DMA_AUX
#define CONV_DMA_AUX 0
#endif
#ifndef CONV_BUF
#define CONV_BUF 0
#endif
#ifndef E_F8
#define E_F8 1
#endif
#ifndef P_IN_P2
#define P_IN_P2 1
#endif
#ifndef CONV_WG
#define CONV_WG 1
#endif
#ifndef CONV_XCD
#define CONV_XCD 0
#endif
#ifndef CONV_NUM
#define CONV_NUM 3
#endif
constexpr int CW_CNT = 16384;

constexpr int RING_OFF = 0, RING_BYTES = 131072;
constexpr int LDSCTL_OFF = RING_BYTES, MISC_OFF = LDSCTL_OFF + 320;
constexpr int LCNT_OFF = LDSCTL_OFF + 512, LTST_OFF = LCNT_OFF + 128, LTILES_OFF = LTST_OFF + 256;
constexpr int LDS_BYTES = 147456;
static_assert(LTILES_OFF + MAXTILES * 4 <= LDS_BYTES, "LDS map");

#define GAS __attribute__((address_space(1)))
#define LAS __attribute__((address_space(3)))
typedef unsigned short bf16;
typedef unsigned v4u __attribute__((ext_vector_type(4)));
typedef float f32x4 __attribute__((ext_vector_type(4)));
typedef short bf16x8 __attribute__((ext_vector_type(8)));
typedef GAS unsigned gu32;
typedef GAS unsigned long long gu64;
#define RLX_AGENT __ATOMIC_RELAXED, __HIP_MEMORY_SCOPE_AGENT
#define LDS_WAIT() asm volatile("s_waitcnt lgkmcnt(0)" ::: "memory")
#define VM_WAIT() asm volatile("s_waitcnt vmcnt(0)" ::: "memory")
__device__ __forceinline__ unsigned long long rt() { return __builtin_amdgcn_s_memrealtime(); }
__device__ __forceinline__ unsigned f2bf(float f) { unsigned u = __builtin_bit_cast(unsigned, f); return (u + 0x7fffu + ((u >> 16) & 1u)) >> 16; }
__device__ __forceinline__ unsigned pk2(float lo, float hi) { return f2bf(lo) | (f2bf(hi) << 16); }

#define XB_TMO      128
#define XB_XCNT(j)  (256  + 64 * (j))
#define XB_XSUB(j)  (1280 + 64 * (j))
#define XB_XGEN(j)  (2304 + 64 * (j))
#define XB_TOP      3328
#define XB_TOPGEN   3392
#define XCD_BAR_WORDS 3456
#define XB_SPIN_CAP (1u << 18)

__device__ __forceinline__ unsigned xb_ld(unsigned* p)              { return __hip_atomic_load(p, __ATOMIC_RELAXED, __HIP_MEMORY_SCOPE_AGENT); }
__device__ __forceinline__ unsigned xb_add(unsigned* p, unsigned v) { return __hip_atomic_fetch_add(p, v, __ATOMIC_RELAXED, __HIP_MEMORY_SCOPE_AGENT); }
__device__ __forceinline__ unsigned xb_xcc_id() { return (unsigned)__builtin_amdgcn_s_getreg((3 << 11) | 20) & 0xFu; }
#define XB_SPIN(cond, bar) do { unsigned _sp = 0; while (cond) { __builtin_amdgcn_s_sleep(1); \
    if ((++_sp & 255u) == 0u) { if (xb_ld(&(bar)[XB_TMO])) break; if (_sp > XB_SPIN_CAP) { atomicAdd(&(bar)[XB_TMO], 1u); break; } } } } while (0)

struct XcdBarrier {
    unsigned* bar; unsigned x;
    volatile LAS unsigned* st;
    int wave;
};

__device__ __forceinline__ XcdBarrier xcd_barrier_post(unsigned* bar, volatile LAS unsigned* st) {
    XcdBarrier b; b.bar = bar; b.x = (unsigned)__builtin_amdgcn_readfirstlane((int)xb_xcc_id()); b.st = st;     b.wave = __builtin_amdgcn_readfirstlane((int)(threadIdx.x >> 6));
    if (threadIdx.x == 0) (void)xb_add(&bar[XB_XCNT(b.x)], 1u);
    return b;
}
__device__ __forceinline__ void xcd_barrier_complete(unsigned* bar, unsigned x, unsigned& nloc, unsigned& nx) {
    const unsigned G = gridDim.x * gridDim.y * gridDim.z;
    unsigned sum, cnt, mine, sp = 0u;
    for (;;) {
        sum = 0u; cnt = 0u; mine = 0u;
#pragma unroll
        for (unsigned j = 0; j < 16; ++j) { const unsigned c = xb_ld(&bar[XB_XCNT(j)]); sum += c; cnt += (c > 0u) ? 1u : 0u; mine = (j == x) ? c : mine; }
        if (sum == G) break;
        __builtin_amdgcn_s_sleep(1);
        if ((++sp & 255u) == 0u) { if (xb_ld(&bar[XB_TMO])) break; if (sp > XB_SPIN_CAP) { atomicAdd(&bar[XB_TMO], 1u); break; } }
    }
    nloc = mine > 0u ? mine : 1u; nx = cnt > 0u ? cnt : 1u;
}

__device__ __forceinline__ void xcd_barrier(const XcdBarrier& b) {
    asm volatile("s_waitcnt vmcnt(0)" ::: "memory");
    __syncthreads();
    unsigned ln_; asm volatile("v_mbcnt_lo_u32_b32 %0, -1, 0\n\tv_mbcnt_hi_u32_b32 %0, -1, %0" : "=v"(ln_));
    if (b.wave == 0 && ln_ == 0u) {
        GAS unsigned* barg_ = (GAS unsigned*)b.bar; asm volatile("" : "+s"(barg_)); unsigned* bar = (unsigned*)barg_; unsigned bx_ = b.x; asm volatile("" : "+s"(bx_));
        __builtin_amdgcn_s_waitcnt(0);
        unsigned nloc = b.st[0], nx = b.st[1];
        if (nloc == 0u) { xcd_barrier_complete(bar, bx_, nloc, nx); b.st[0] = nloc; b.st[1] = nx; }
        const unsigned old = xb_add(&bar[XB_XSUB(bx_)], 1u);
        const unsigned gen = old / nloc;
        if (old + 1u == (gen + 1u) * nloc) {
            __builtin_amdgcn_fence(__ATOMIC_RELEASE, "agent");
            asm volatile("s_waitcnt vmcnt(0)" ::: "memory");
            const unsigned og = xb_add(&bar[XB_TOP], 1u);
            const unsigned tg = og / nx;
            if (og + 1u == (tg + 1u) * nx) xb_add(&bar[XB_TOPGEN], 1u);
            else XB_SPIN(xb_ld(&bar[XB_TOPGEN]) == tg, bar);
            __builtin_amdgcn_fence(__ATOMIC_ACQUIRE, "agent");
            xb_add(&bar[XB_XGEN(bx_)], 1u);
            asm volatile("s_waitcnt vmcnt(0)" ::: "memory");
        } else {
            XB_SPIN(xb_ld(&bar[XB_XGEN(bx_)]) == gen, bar);
            __builtin_amdgcn_fence(__ATOMIC_ACQUIRE, "agent");
            asm volatile("s_waitcnt vmcnt(0)" ::: "memory");
        }
    }
    __syncthreads();
}
struct Frame {
    LAS unsigned char* lds;
    volatile LAS unsigned* MISC;
    gu32* ctl;
    int tid, lane, wave;
    int vcu, G, bx;
    float* H; unsigned char* ws;
};
__device__ __forceinline__ int mk_tid(int wave) { int t; asm volatile("v_mbcnt_lo_u32_b32 %0, -1, 0\n\tv_mbcnt_hi_u32_b32 %0, -1, %0\n\tv_lshl_add_u32 %0, %1, 6, %0" : "=&v"(t) : "s"(wave)); return t; }
__device__ __forceinline__ const float* ld_inp(int k) { const GAS float* p; asm volatile("s_load_dwordx2 %0, %1, %2\n\ts_waitcnt lgkmcnt(0)" : "=s"(p) : "s"(__builtin_amdgcn_kernarg_segment_ptr()), "s"(k * 8) : "memory"); return (const float*)p; }
#define INP(k) ld_inp(k)
__device__ __forceinline__ float shx(float v, int o, int lane) { return __int_as_float(__builtin_amdgcn_ds_bpermute((lane ^ o) << 2, __float_as_int(v))); }
__device__ __forceinline__ float wave_sum(float v, int lane) {
#pragma unroll
    for (int o = 1; o < 64; o <<= 1) v += shx(v, o, lane);
    return v;
}
__device__ __forceinline__ float bf_lo(unsigned w) { return __uint_as_float(w << 16); }
__device__ __forceinline__ float bf_hi(unsigned w) { return __uint_as_float(w & 0xffff0000u); }
__device__ __forceinline__ float sigmoidf_(float x) { return __builtin_amdgcn_rcpf(1.0f + __builtin_amdgcn_exp2f(-x * LOG2E)); }

#define GM_JOIN16(a) asm volatile("s_waitcnt lgkmcnt(0)" : "+v"(a[0]), "+v"(a[1]), "+v"(a[2]), "+v"(a[3]), "+v"(a[4]), "+v"(a[5]), "+v"(a[6]), "+v"(a[7]), "+v"(a[8]), "+v"(a[9]), "+v"(a[10]), "+v"(a[11]), "+v"(a[12]), "+v"(a[13]), "+v"(a[14]), "+v"(a[15]))
using pg8::f32x2; using pg8::u32x4; using pg8::u32x2; using pg8::bf16_t; using pg8::Unit; using pg8::cvt_pk_bf16;
__device__ __forceinline__ void rows_rinv(const float* ssq16, int rowbase, int fq, int lane, float (&rv)[2][4]) {
    f32x4 p[8];
#pragma unroll
    for (int k = 0; k < 8; ++k) p[k] = *(const f32x4*)((const char*)ssq16 + ((unsigned)(rowbase + (k >> 2) * 128 + (k & 3) * 16) * 64u + 16u * (unsigned)fq));
    asm volatile("" : "+v"(p[0]), "+v"(p[1]), "+v"(p[2]), "+v"(p[3]), "+v"(p[4]), "+v"(p[5]), "+v"(p[6]), "+v"(p[7]));
    float sv[8], tv[8];
#pragma unroll
    for (int k = 0; k < 8; ++k) sv[k] = (p[k][0] + p[k][1]) + (p[k][2] + p[k][3]);
#pragma unroll
    for (int o = 16; o <= 32; o <<= 1) {
#pragma unroll
        for (int k = 0; k < 8; ++k) tv[k] = shx(sv[k], o, lane);
        asm volatile("s_waitcnt lgkmcnt(0)" : "+v"(tv[0]), "+v"(tv[1]), "+v"(tv[2]), "+v"(tv[3]), "+v"(tv[4]), "+v"(tv[5]), "+v"(tv[6]), "+v"(tv[7]));
#pragma unroll
        for (int k = 0; k < 8; ++k) sv[k] += tv[k]; }
#pragma unroll
    for (int k = 0; k < 8; ++k) rv[k >> 2][k & 3] = rsqrtf(sv[k] * (1.0f / DM) + EPS);
}
#define GP(T_, base, boff) ((T_*)((char*)(base) + (unsigned)(boff)))
#define GPC(T_, base, boff) ((const T_*)((const char*)(base) + (unsigned)(boff)))
#ifndef ST_AUX
#define ST_AUX 0
#endif
__device__ __forceinline__ void st16(void* base, unsigned boff, u32x4 v) {
#if ST_AUX
    __builtin_amdgcn_raw_buffer_store_b128(v, __builtin_amdgcn_make_buffer_rsrc(base, 0, 0x7fffffff, 0x00020000), boff, 0, ST_AUX);
#else
    *GP(u32x4, base, boff) = v;
#endif
}
struct EpiIn {
    static constexpr bool PERM = true; static constexpr int PID = 1; static constexpr int NST = 16;
    bf16_t* O; const float* ssq16; gu32* norm;
    __device__ __forceinline__ void operator()(const f32x4 (&acc)[2][2][4][2], const Unit& u, int wr, int wc, int fr, int fq) const {
        const int row0 = u.pm * 256 + wr * 64 + fr, seg = u.pn >> 1; float nmx[2] = {0.f, 0.f};
        bf16_t* base = O + (size_t)seg * (SEG_BYTES / 2);
        const unsigned cb = (unsigned)((u.pn & 1) * 256 + wc * 32 + 8 * fq) * 2u;
        float rv[2][4]; rows_rinv(ssq16, row0, fq, fq * 16 + fr, rv);
#pragma unroll
        for (int ai = 0; ai < 2; ++ai)
#pragma unroll
            for (int m = 0; m < 4; ++m) { const unsigned ob = (unsigned)(row0 + ai * 128 + m * 16) * 1024u + cb; const float r = rv[ai][m];
#pragma unroll
                for (int bj = 0; bj < 2; ++bj) { f32x4 v0 = acc[ai][bj][m][0] * r, v1 = acc[ai][bj][m][1] * r;
                    if (seg < 2) { f32x2 a = pg8::gelu_pk((f32x2){v0[0], v0[1]}), b = pg8::gelu_pk((f32x2){v0[2], v0[3]}), c = pg8::gelu_pk((f32x2){v1[0], v1[1]}), d = pg8::gelu_pk((f32x2){v1[2], v1[3]});
                        v0 = (f32x4){a.x, a.y, b.x, b.y}; v1 = (f32x4){c.x, c.y, d.x, d.y}; }
                    else if (seg == 2) { v0 = v0 * attn_body::C2; v1 = v1 * attn_body::C2; }
                    if (seg == 2 || seg == 3) { float s = ((v0[0] * v0[0] + v0[1] * v0[1]) + (v0[2] * v0[2] + v0[3] * v0[3])) + ((v1[0] * v1[0] + v1[1] * v1[1]) + (v1[2] * v1[2] + v1[3] * v1[3]));
                        s += shx(s, 16, fq * 16 + fr); s += shx(s, 32, fq * 16 + fr); nmx[bj] = fmaxf(nmx[bj], s); }
                    u32x4 w; w.x = cvt_pk_bf16(v0[0], v0[1]); w.y = cvt_pk_bf16(v0[2], v0[3]); w.z = cvt_pk_bf16(v1[0], v1[1]); w.w = cvt_pk_bf16(v1[2], v1[3]);
                    *GP(u32x4, base, ob + bj * 256) = w; }
                asm volatile("" ::: "memory"); }
        if (seg == 2 || seg == 3) {
#pragma unroll
            for (int bj = 0; bj < 2; ++bj) { float s = nmx[bj];
#pragma unroll
                for (int o = 1; o < 16; o <<= 1) s = fmaxf(s, shx(s, o, fq * 16 + fr));
                if (fr == 0 && fq == 0) __hip_atomic_fetch_max(norm + ((((seg - 2) * 8 + (u.pm >> 4)) * 8 + (u.pn & 1) * 4 + bj * 2 + (wc >> 1)) * 2 + (wc & 1)), __float_as_uint(s * 1.02f), __ATOMIC_RELAXED, __HIP_MEMORY_SCOPE_AGENT); } }
    }
};
struct EpiBf {
    static constexpr bool PERM = true; static constexpr int PID = 0; static constexpr int NST = 16;
    bf16_t* O; const float* bias; int bias_estride; size_t o_estride;
    __device__ __forceinline__ void operator()(const f32x4 (&acc)[2][2][4][2], const Unit& u, int wr, int wc, int fr, int fq) const {
        const int row0 = u.pm * 256 + wr * 64 + fr, col0 = u.pn * 256 + wc * 32 + 8 * fq;
        f32x4 bv[2][2];
#pragma unroll
        for (int bj = 0; bj < 2; ++bj)
#pragma unroll
            for (int n = 0; n < 2; ++n) bv[bj][n] = bias ? *GPC(f32x4, bias, (unsigned)(u.e * bias_estride + col0 + bj * 128 + 4 * n) * 4u) : (f32x4){0.f, 0.f, 0.f, 0.f};
#pragma unroll
        for (int ai = 0; ai < 2; ++ai)
#pragma unroll
            for (int m = 0; m < 4; ++m) { const unsigned ob = ((unsigned)(row0 + ai * 128 + m * 16) * 1024u + (unsigned)col0) * 2u;
#pragma unroll
                for (int bj = 0; bj < 2; ++bj) { const f32x4 v0 = acc[ai][bj][m][0] + bv[bj][0], v1 = acc[ai][bj][m][1] + bv[bj][1];
                    u32x4 w; w.x = cvt_pk_bf16(v0[0], v0[1]); w.y = cvt_pk_bf16(v0[2], v0[3]); w.z = cvt_pk_bf16(v1[0], v1[1]); w.w = cvt_pk_bf16(v1[2], v1[3]);
                    *GP(u32x4, O + (size_t)u.e * o_estride, ob + bj * 256) = w; } }
    }
};
struct EpiSwiglu {
    static constexpr bool PERM = true;
    bf16_t* act; const float* rinv; const int* lists; const LAS int* cnt; const float* bgu;
    __device__ __forceinline__ void operator()(const f32x4 (&acc)[2][2][4][2], const Unit& u, int wr, int wc, int fr, int fq) const {
        const int rl0 = wr * 64 + fr, col8 = u.pn * 128 + wc * 32 + 8 * fq; const int ce = cnt[u.e];
        f32x4 bg[2], bl[2];
#pragma unroll
        for (int n = 0; n < 2; ++n) { bg[n] = *GPC(f32x4, bgu, (unsigned)(u.e * 2048 + col8 + 4 * n) * 4u); bl[n] = *GPC(f32x4, bgu, (unsigned)(u.e * 2048 + 1024 + col8 + 4 * n) * 4u); }
#pragma unroll
        for (int ai = 0; ai < 2; ++ai)
#pragma unroll
            for (int m = 0; m < 4; ++m) { const int rl = rl0 + ai * 128 + m * 16, rr = u.mt * 256 + rl; const int tok = (rr < ce) ? *GPC(int, lists, (unsigned)(u.e * 32768 + rr) * 4u) : 0; const float r = *GPC(float, rinv, (unsigned)tok * 4u);
                u32x4 w; unsigned wv[4];
#pragma unroll
                for (int n = 0; n < 2; ++n) { float a[4];
#pragma unroll
                    for (int i = 0; i < 4; ++i) { float g = acc[ai][0][m][n][i] * r + bg[n][i], li = acc[ai][1][m][n][i] * r + bl[n][i];
                        g = fminf(g, 7.0f); li = fminf(fmaxf(li, -7.0f), 7.0f); a[i] = g * sigmoidf_(1.702f * g) * (li + 1.0f); }
                    wv[2 * n] = cvt_pk_bf16(a[0], a[1]); wv[2 * n + 1] = cvt_pk_bf16(a[2], a[3]); }
                w.x = wv[0]; w.y = wv[1]; w.z = wv[2]; w.w = wv[3];
                *GP(u32x4, act, ((unsigned)(u.pm * 256 + rl) * 1024u + (unsigned)col8) * 2u) = w;
                asm volatile("" ::: "memory"); }
    }
};
using pg8::f32x16;
__device__ __forceinline__ unsigned pk4_fp8(float a, float b, float c, float d) { int w = 0; w = __builtin_amdgcn_cvt_pk_fp8_f32(a, b, w, false); w = __builtin_amdgcn_cvt_pk_fp8_f32(c, d, w, true); return (unsigned)w; }
__device__ __forceinline__ float clamp448(float v) { return __builtin_amdgcn_fmed3f(v, -448.0f, 448.0f); }
struct EpiSwiglu8 {
    static constexpr bool PERM = true; static constexpr int PID = 5; static constexpr int NST = 4; static constexpr int SCALE_W = 0x79797979, SCALE_X = 0x7F7F7F7F;
    unsigned char* act8; const float* rinv; const int* lists; const LAS int* cnt; const float* bgu;
    __device__ __forceinline__ void prefetch(const Unit&, int, int, float (&)[4]) const {}
    __device__ __forceinline__ void epidma(const Unit& u, LAS unsigned char* buf, int wid, int lane) const {
        if (wid < 4) { const int ce = cnt[u.e]; int rr = u.mt * 256 + wid * 64 + lane; rr = rr < ce ? rr : ce - 1;
            __builtin_amdgcn_global_load_lds((const unsigned*)(lists + 2 * (u.e * 32768 + rr) + 1), (LAS unsigned*)(buf + wid * 256), 4, 0, 0); }
        else { const int idx = (wid - 4) * 64 + lane;
            __builtin_amdgcn_global_load_lds((const unsigned*)(bgu + u.e * 2048 + (idx >> 7) * 1024 + u.pn * 128 + (idx & 127)), (LAS unsigned*)(buf + 1024 + (wid - 4) * 256), 4, 0, 0); }
    }
    __device__ __forceinline__ void operator()(const f32x16 (&acc)[2][2][2], const Unit& u, int wr, int wc, int r32, int hi, const float (&)[4], const LAS unsigned char* ep) const {
        const int cbase = u.pn * 128 + wc * 32 + 16 * hi;
#pragma unroll
        for (int ai = 0; ai < 2; ++ai)
#pragma unroll
            for (int m = 0; m < 2; ++m) { const int rl = ai * 128 + wr * 64 + m * 32 + r32;
#ifdef PROBE_K2
                const float r = 0.5f * *(const LAS float*)(ep + rl * 4);
#else
                const float r = *(const LAS float*)(ep + rl * 4);
#endif
                u32x4 w; unsigned wv[4];
#pragma unroll
                for (int q = 0; q < 4; ++q) { f32x2 a2[2];
                    const f32x4 bgq = *(const LAS f32x4*)(ep + 1024 + (wc * 32 + 16 * hi + 4 * q) * 4), blq = *(const LAS f32x4*)(ep + 1536 + (wc * 32 + 16 * hi + 4 * q) * 4);
#pragma unroll
                    for (int i = 0; i < 2; ++i) { f32x2 g = (f32x2){acc[ai][0][m][4 * q + 2 * i], acc[ai][0][m][4 * q + 2 * i + 1]} * r + (f32x2){bgq[2 * i], bgq[2 * i + 1]};
                        f32x2 li = (f32x2){acc[ai][1][m][4 * q + 2 * i], acc[ai][1][m][4 * q + 2 * i + 1]} * r + (f32x2){blq[2 * i], blq[2 * i + 1]};
                        g.x = fminf(g.x, 7.0f); g.y = fminf(g.y, 7.0f); li.x = __builtin_amdgcn_fmed3f(li.x, -7.0f, 7.0f); li.y = __builtin_amdgcn_fmed3f(li.y, -7.0f, 7.0f);
                        const f32x2 x = g * (-1.702f * LOG2E); f32x2 e; e.x = __builtin_amdgcn_exp2f(x.x); e.y = __builtin_amdgcn_exp2f(x.y); e = e + 1.0f;
                        f32x2 s; s.x = __builtin_amdgcn_rcpf(e.x); s.y = __builtin_amdgcn_rcpf(e.y);
                        a2[i] = (g * s) * (li + 1.0f); }
                    wv[q] = pk4_fp8(a2[0].x, a2[0].y, a2[1].x, a2[1].y); }
                w.x = wv[0]; w.y = wv[1]; w.z = wv[2]; w.w = wv[3];
                st16(act8, (unsigned)(u.pm * 256 + rl) * 1024u + (unsigned)cbase, w); }
    }
};
struct EpiDown8 {
    static constexpr bool PERM = true; static constexpr int NST = 8; static constexpr int PID = 6; static constexpr int SCALE_W = 0x79797979, SCALE_X = 0x7F7F7F7F;
    unsigned char* O; const float* bias;
    __device__ __forceinline__ void prefetch(const Unit&, int, int, float (&)[4]) const {}
    __device__ __forceinline__ void epidma(const Unit& u, LAS unsigned char* buf, int wid, int lane) const {
        if (EPI_DMA6 && wid == 0) __builtin_amdgcn_global_load_lds((const unsigned*)(bias + u.e * 1024 + u.pn * 256 + 4 * lane), (LAS unsigned*)buf, 16, 0, 0);
    }
    __device__ __forceinline__ void operator()(const f32x16 (&acc)[2][2][2], const Unit& u, int wr, int wc, int r32, int hi, const float (&)[4], const LAS unsigned char* ep) const {
#pragma unroll
        for (int bj = 0; bj < 2; ++bj) { const int col0 = u.pn * 256 + bj * 128 + wc * 32 + 16 * hi; f32x4 bv[2][4];
#pragma unroll
            for (int q = 0; q < 4; ++q) bv[bj][q] = EPI_DMA6 ? *(const LAS f32x4*)(ep + (bj * 128 + wc * 32 + 16 * hi + 4 * q) * 4) : *GPC(f32x4, bias, (unsigned)(u.e * 1024 + u.pn * 256 + bj * 128 + wc * 32 + 16 * hi + 4 * q) * 4u);
#pragma unroll
            for (int ai = 0; ai < 2; ++ai)
#pragma unroll
                for (int m = 0; m < 2; ++m) { const unsigned row = (unsigned)(u.pm * 256 + ai * 128 + wr * 64 + m * 32 + r32); u32x4 w; unsigned wv[4];
#pragma unroll
                    for (int q = 0; q < 4; ++q) wv[q] = pk4_fp8(clamp448(acc[ai][bj][m][4 * q] + bv[bj][q][0]), clamp448(acc[ai][bj][m][4 * q + 1] + bv[bj][q][1]), clamp448(acc[ai][bj][m][4 * q + 2] + bv[bj][q][2]), clamp448(acc[ai][bj][m][4 * q + 3] + bv[bj][q][3]));
                    w.x = wv[0]; w.y = wv[1]; w.z = wv[2]; w.w = wv[3];
                    st16(O, row * 1024u + (unsigned)col0, w); } }
    }
};
struct EpiE8 {
    static constexpr bool PERM = true; static constexpr int PID = 0; static constexpr int NST = 16;
    unsigned char* O; size_t o_estride;
    __device__ __forceinline__ void operator()(const f32x4 (&acc)[2][2][4][2], const Unit& u, int wr, int wc, int fr, int fq) const {
        const int row0 = u.pm * 256 + wr * 64 + fr, col0 = u.pn * 256 + wc * 32 + 8 * fq;
#pragma unroll
        for (int ai = 0; ai < 2; ++ai)
#pragma unroll
            for (int m = 0; m < 4; ++m) { const unsigned ob = (unsigned)(row0 + ai * 128 + m * 16) * 1024u + (unsigned)col0;
#pragma unroll
                for (int bj = 0; bj < 2; ++bj) { const f32x4 v0 = acc[ai][bj][m][0], v1 = acc[ai][bj][m][1];
                    u32x2 w; w.x = pk4_fp8(clamp448(v0[0]), clamp448(v0[1]), clamp448(v0[2]), clamp448(v0[3])); w.y = pk4_fp8(clamp448(v1[0]), clamp448(v1[1]), clamp448(v1[2]), clamp448(v1[3]));
                    *GP(u32x2, O + (size_t)u.e * o_estride, ob + bj * 128) = w; } }
    }
};
struct EpiIn8 {
    static constexpr bool PERM = true; static constexpr int PID = 1; static constexpr int NST = 16; static constexpr int SCALE_W = 0x79797979, SCALE_X = 0x7F7F7F7F;
    bf16_t* O; const float* ssq16; gu32* norm;
    __device__ __forceinline__ void prefetch(const Unit&, int, int, float (&)[4]) const {}
    __device__ __forceinline__ void epidma(const Unit&, LAS unsigned char*, int, int) const {}
    __device__ __forceinline__ void operator()(const f32x16 (&acc)[2][2][2], const Unit& u, int wr, int wc, int r32, int hi, const float (&)[4], const LAS unsigned char*) const {
        const int row0 = u.pm * 256 + wr * 64 + r32, seg = u.pn >> 1, lane = hi * 32 + r32; float nmx[2] = {0.f, 0.f};
        bf16_t* base = O + (size_t)seg * (SEG_BYTES / 2);
        const unsigned cb = (unsigned)((u.pn & 1) * 256 + wc * 32 + 16 * hi) * 2u;
        float rv[2][2];
#pragma unroll
        for (int ai = 0; ai < 2; ++ai)
#pragma unroll
            for (int m = 0; m < 2; ++m) { const unsigned rb = (unsigned)(row0 + ai * 128 + m * 32) * 64u + 32u * (unsigned)hi; const f32x4 p0 = *GPC(f32x4, ssq16, rb), p1 = *GPC(f32x4, ssq16, rb + 16u);
                float s = ((p0[0] + p0[1]) + (p0[2] + p0[3])) + ((p1[0] + p1[1]) + (p1[2] + p1[3])); s += shx(s, 32, lane); rv[ai][m] = rsqrtf(s * (1.0f / DM) + EPS); }
#pragma unroll
        for (int ai = 0; ai < 2; ++ai)
#pragma unroll
            for (int m = 0; m < 2; ++m) { const unsigned ob = (unsigned)(row0 + ai * 128 + m * 32) * 1024u + cb; const float r = rv[ai][m];
#pragma unroll
                for (int bj = 0; bj < 2; ++bj) { f32x2 s2 = (f32x2){0.f, 0.f};
#pragma unroll
                    for (int h = 0; h < 2; ++h) { f32x2 v[4];
#pragma unroll
                        for (int i = 0; i < 4; ++i) v[i] = (f32x2){acc[ai][bj][m][8 * h + 2 * i], acc[ai][bj][m][8 * h + 2 * i + 1]} * r;
                        if (seg < 2) {
#pragma unroll
                            for (int i = 0; i < 4; ++i) v[i] = pg8::gelu_pk(v[i]); }
                        else if (seg == 2) {
#pragma unroll
                            for (int i = 0; i < 4; ++i) v[i] = v[i] * attn_body::C2; }
#pragma unroll
                        for (int i = 0; i < 4; ++i) s2 = s2 + v[i] * v[i];
                        u32x4 w0; w0.x = cvt_pk_bf16(v[0].x, v[0].y); w0.y = cvt_pk_bf16(v[1].x, v[1].y); w0.z = cvt_pk_bf16(v[2].x, v[2].y); w0.w = cvt_pk_bf16(v[3].x, v[3].y);
                        *GP(u32x4, base, ob + bj * 256 + h * 16) = w0; asm volatile("" ::: "memory"); }
                    if (seg == 2 || seg == 3) { float s = s2.x + s2.y; s += shx(s, 32, lane); nmx[bj] = fmaxf(nmx[bj], s); } }
                asm volatile("" ::: "memory"); }
        if (seg == 2 || seg == 3) {
#pragma unroll
            for (int bj = 0; bj < 2; ++bj) { float s = nmx[bj];
#pragma unroll
                for (int o = 1; o < 32; o <<= 1) s = fmaxf(s, shx(s, o, lane));
                if (lane == 0) __hip_atomic_fetch_max(norm + ((((seg - 2) * 8 + (u.pm >> 4)) * 8 + (u.pn & 1) * 4 + bj * 2 + (wc >> 1)) * 2 + (wc & 1)), __float_as_uint(s * 1.02f), __ATOMIC_RELAXED, __HIP_MEMORY_SCOPE_AGENT); } }
    }
};
struct EpiSwiglu16 {
    static constexpr bool PERM = true; static constexpr int NST = 8; static constexpr int PID = 5; static constexpr int SCALE_W = 0x79797979, SCALE_X = 0x7F7F7F7F;
    unsigned char* act8; const int* lists; const LAS int* cnt; const float* bgu;
    __device__ __forceinline__ void operator()(const f32x4 (&acc)[2][2][4][2], const Unit& u, int wr, int wc, int fr, int fq) const {
        const int col8 = u.pn * 128 + wc * 32 + 8 * fq; const int ce = cnt[u.e];
        float rr_[8]; f32x4 bg[2], bl[2];
#pragma unroll
        for (int j = 0; j < 8; ++j) { const int rr = u.mt * 256 + (j >> 2) * 128 + wr * 64 + (j & 3) * 16 + fr; rr_[j] = (rr < ce) ? *GPC(float, lists, (unsigned)(u.e * 32768 + rr) * 8u + 4u) : 0.f; }
#pragma unroll
        for (int n = 0; n < 2; ++n) { bg[n] = *GPC(f32x4, bgu, (unsigned)(u.e * 2048 + col8 + 4 * n) * 4u); bl[n] = *GPC(f32x4, bgu, (unsigned)(u.e * 2048 + 1024 + col8 + 4 * n) * 4u); }
#pragma unroll
        for (int ai = 0; ai < 2; ++ai)
#pragma unroll
            for (int m = 0; m < 4; ++m) { const int rl = ai * 128 + wr * 64 + m * 16 + fr; const float r = rr_[ai * 4 + m]; u32x2 w; unsigned wv[2];
#pragma unroll
                for (int n = 0; n < 2; ++n) { f32x2 a2[2];
#pragma unroll
                    for (int i = 0; i < 2; ++i) { f32x2 g = (f32x2){acc[ai][0][m][n][2 * i], acc[ai][0][m][n][2 * i + 1]} * r + (f32x2){bg[n][2 * i], bg[n][2 * i + 1]};
                        f32x2 li = (f32x2){acc[ai][1][m][n][2 * i], acc[ai][1][m][n][2 * i + 1]} * r + (f32x2){bl[n][2 * i], bl[n][2 * i + 1]};
                        g.x = fminf(g.x, 7.0f); g.y = fminf(g.y, 7.0f); li.x = __builtin_amdgcn_fmed3f(li.x, -7.0f, 7.0f); li.y = __builtin_amdgcn_fmed3f(li.y, -7.0f, 7.0f);
                        const f32x2 x = g * (-1.702f * LOG2E); f32x2 e; e.x = __builtin_amdgcn_exp2f(x.x); e.y = __builtin_amdgcn_exp2f(x.y); e = e + 1.0f;
                        f32x2 s; s.x = __builtin_amdgcn_rcpf(e.x); s.y = __builtin_amdgcn_rcpf(e.y);
                        a2[i] = (g * s) * (li + 1.0f); }
                    wv[n] = pk4_fp8(a2[0].x, a2[0].y, a2[1].x, a2[1].y); }
                w.x = wv[0]; w.y = wv[1];
                *GP(u32x2, act8, (unsigned)(u.pm * 256 + rl) * 1024u + (unsigned)col8) = w; }
    }
};
struct EpiDown16 {
    static constexpr bool PERM = true; static constexpr int NST = 16; static constexpr int PID = 6; static constexpr int SCALE_W = 0x79797979, SCALE_X = 0x7F7F7F7F;
    unsigned char* O; const float* bias;
    __device__ __forceinline__ void operator()(const f32x4 (&acc)[2][2][4][2], const Unit& u, int wr, int wc, int fr, int fq) const {
        f32x4 bv[2][2];
#pragma unroll
        for (int bj = 0; bj < 2; ++bj)
#pragma unroll
            for (int n = 0; n < 2; ++n) bv[bj][n] = *GPC(f32x4, bias, (unsigned)(u.e * 1024 + u.pn * 256 + bj * 128 + wc * 32 + 8 * fq + 4 * n) * 4u);
#pragma unroll
        for (int ai = 0; ai < 2; ++ai)
#pragma unroll
            for (int m = 0; m < 4; ++m) { const unsigned row = (unsigned)(u.pm * 256 + ai * 128 + wr * 64 + m * 16 + fr);
#pragma unroll
                for (int bj = 0; bj < 2; ++bj) { const f32x4 v0 = acc[ai][bj][m][0] + bv[bj][0], v1 = acc[ai][bj][m][1] + bv[bj][1]; u32x2 w;
                    w.x = pk4_fp8(clamp448(v0[0]), clamp448(v0[1]), clamp448(v0[2]), clamp448(v0[3])); w.y = pk4_fp8(clamp448(v1[0]), clamp448(v1[1]), clamp448(v1[2]), clamp448(v1[3]));
                    *GP(u32x2, O, row * 1024u + (unsigned)(u.pn * 256 + bj * 128 + wc * 32 + 8 * fq)) = w; } }
    }
};
struct EpiRes {
    static constexpr bool PERM = true; static constexpr int PID = 3; static constexpr int NST = 32; static constexpr int MIDK_T = 8;
    const bf16_t* res; bf16_t* hb; float* ssq16; const float* oss; const float* gss; unsigned char* h8;
    __device__ __forceinline__ void midk(f32x4 (&acc)[2][2][4][2], const Unit& u, int wr, int fr, int fq) const {
#pragma unroll
        for (int ai = 0; ai < 2; ++ai) { f32x2 a[4]; float gs[4];
#pragma unroll
            for (int m = 0; m < 4; ++m) { const unsigned row = (unsigned)(u.pm * 256 + ai * 128 + wr * 64 + m * 16 + fr); a[m] = *GPC(f32x2, oss, row * 32u + 8u * fq); gs[m] = *GPC(float, gss, row * 4u); }
#pragma unroll
            for (int m = 0; m < 4; ++m) { float s = a[m][0] + a[m][1]; s += shx(s, 16, fq * 16 + fr); s += shx(s, 32, fq * 16 + fr);
                const float f = rsqrtf(s * (1.0f / 512.0f) + EPS) * sqrtf(gs[m] * (1.0f / 512.0f) + EPS);
#pragma unroll
                for (int bj = 0; bj < 2; ++bj)
#pragma unroll
                    for (int n = 0; n < 2; ++n) acc[ai][bj][m][n] = acc[ai][bj][m][n] * f; }
            asm volatile("" ::: "memory"); }
    }
    __device__ __forceinline__ void operator()(const f32x4 (&acc)[2][2][4][2], const Unit& u, int wr, int wc, int fr, int fq) const {
        const int col0 = u.pn * 256 + wc * 32 + 8 * fq;
        u32x4 rv[4][2]; float gs[4];
        auto ld = [&](int k, int sl) { const unsigned row = (unsigned)(u.pm * 256 + (k >> 2) * 128 + wr * 64 + (k & 3) * 16 + fr); const unsigned ob = (row * 1024u + (unsigned)col0) * 2u; gs[sl] = *GPC(float, gss, row * 4u);
#pragma unroll
            for (int bj = 0; bj < 2; ++bj) rv[sl][bj] = *GPC(u32x4, res, ob + (unsigned)(bj * 256)); };
#pragma unroll
        for (int k = 0; k < 4; ++k) ld(k, k);
#pragma unroll
        for (int k = 0; k < 8; ++k) { const int ai = k >> 2, m = k & 3, sl = k & 3;
            const unsigned row = (unsigned)(u.pm * 256 + ai * 128 + wr * 64 + m * 16 + fr); const unsigned ob = (row * 1024u + (unsigned)col0) * 2u; float ss = 0.f;
            const float ra = rsqrtf(gs[sl] * (1.0f / 512.0f) + EPS);
#pragma unroll
            for (int bj = 0; bj < 2; ++bj) { const unsigned o2 = ob + (unsigned)(bj * 256); const u32x4 r = rv[sl][bj]; const f32x4 a0 = acc[ai][bj][m][0] * ra, a1 = acc[ai][bj][m][1] * ra; float o[8];
                o[0] = bf_lo(r.x) + a0[0]; o[1] = bf_hi(r.x) + a0[1]; o[2] = bf_lo(r.y) + a0[2]; o[3] = bf_hi(r.y) + a0[3]; o[4] = bf_lo(r.z) + a1[0]; o[5] = bf_hi(r.z) + a1[1]; o[6] = bf_lo(r.w) + a1[2]; o[7] = bf_hi(r.w) + a1[3];
                u32x4 w; w.x = cvt_pk_bf16(o[0], o[1]); w.y = cvt_pk_bf16(o[2], o[3]); w.z = cvt_pk_bf16(o[4], o[5]); w.w = cvt_pk_bf16(o[6], o[7]); *GP(u32x4, hb, o2) = w;
                u32x2 q8; q8.x = pk4_fp8(clamp448(o[0]), clamp448(o[1]), clamp448(o[2]), clamp448(o[3])); q8.y = pk4_fp8(clamp448(o[4]), clamp448(o[5]), clamp448(o[6]), clamp448(o[7])); *GP(u32x2, h8, o2 >> 1) = q8;
#pragma unroll
                for (int i = 0; i < 8; ++i) ss += o[i] * o[i]; }
            if (k + 4 < 8) ld(k + 4, sl);
            ss += shx(ss, 16, fq * 16 + fr); ss += shx(ss, 32, fq * 16 + fr);
            if (fq == 0) *GP(float, ssq16, (row * 16u + (unsigned)(u.pn * 4 + wc)) * 4u) = ss;
            asm volatile("" ::: "memory"); }
    }
};
struct EpiPle {
    static constexpr bool PERM = true; static constexpr int PID = 8; static constexpr int NST = 16;
    const bf16_t* res; bf16_t* hb; float* ssq_out; const float* ssq_in; const bf16_t* eb;
    __device__ __forceinline__ void operator()(const f32x4 (&acc)[2][2][4][2], const Unit& u, int wr, int wc, int fr, int fq) const {
        const int col0 = u.pn * 256 + wc * 32 + 8 * fq, row0 = u.pm * 256 + wr * 64 + fr;
        u32x4 rr[4][2], ee[4][2];
        auto ld = [&](int k, int sl) { const unsigned ob = ((unsigned)(row0 + (k >> 2) * 128 + (k & 3) * 16) * 1024u + (unsigned)col0) * 2u;
#pragma unroll
            for (int bj = 0; bj < 2; ++bj) { rr[sl][bj] = *GPC(u32x4, res, ob + (unsigned)(bj * 256));
                if (E_F8) { const u32x2 e8 = *GPC(u32x2, eb, (ob >> 1) + (unsigned)(bj * 128)); ee[sl][bj].x = e8.x; ee[sl][bj].y = e8.y; } else ee[sl][bj] = *GPC(u32x4, eb, ob + (unsigned)(bj * 256)); } };
#pragma unroll
        for (int k = 0; k < 4; ++k) ld(k, k);
        float rv[2][4]; rows_rinv(ssq_in, row0, fq, fq * 16 + fr, rv);
#pragma unroll
        for (int k = 0; k < 8; ++k) { const int ai = k >> 2, m = k & 3, sl = k & 3;
            const unsigned row = (unsigned)(row0 + ai * 128 + m * 16); const unsigned ob = (row * 1024u + (unsigned)col0) * 2u; float ss = 0.f; const float sc = rv[ai][m];
#pragma unroll
            for (int bj = 0; bj < 2; ++bj) { const unsigned o2 = ob + (unsigned)(bj * 256); const u32x4 r = rr[sl][bj], ev = ee[sl][bj]; float o[8];
#pragma unroll
                for (int i = 0; i < 4; ++i) { const unsigned rw = i == 0 ? r.x : i == 1 ? r.y : i == 2 ? r.z : r.w, ew = i == 0 ? ev.x : i == 1 ? ev.y : i == 2 ? ev.z : ev.w;
                    const f32x2 a2 = (f32x2){acc[ai][bj][m][i >> 1][2 * (i & 1)], acc[ai][bj][m][i >> 1][2 * (i & 1) + 1]} * (sc * -LOG2E); f32x2 e; e.x = __builtin_amdgcn_exp2f(a2.x); e.y = __builtin_amdgcn_exp2f(a2.y); e = e + 1.0f;
                    f32x2 s; s.x = __builtin_amdgcn_rcpf(e.x); s.y = __builtin_amdgcn_rcpf(e.y);
                    f32x2 e2; if (E_F8) { const unsigned e8w = (i >> 1) ? ev.y : ev.x; e2 = (i & 1) ? __builtin_amdgcn_cvt_pk_f32_fp8((int)e8w, true) : __builtin_amdgcn_cvt_pk_f32_fp8((int)e8w, false); } else e2 = (f32x2){bf_lo(ew), bf_hi(ew)};
                    const f32x2 o2v = (f32x2){bf_lo(rw), bf_hi(rw)} + s * e2; o[2 * i] = o2v.x; o[2 * i + 1] = o2v.y; }
                u32x4 w; w.x = cvt_pk_bf16(o[0], o[1]); w.y = cvt_pk_bf16(o[2], o[3]); w.z = cvt_pk_bf16(o[4], o[5]); w.w = cvt_pk_bf16(o[6], o[7]); *GP(u32x4, hb, o2) = w;
                if (P1_F8) { u32x2 q8; q8.x = pk4_fp8(clamp448(o[0]), clamp448(o[1]), clamp448(o[2]), clamp448(o[3])); q8.y = pk4_fp8(clamp448(o[4]), clamp448(o[5]), clamp448(o[6]), clamp448(o[7])); *GP(u32x2, (unsigned char*)hb + (WS_H8 - WS_HBB), o2 >> 1) = q8; }
#pragma unroll
                for (int i = 0; i < 8; ++i) ss += o[i] * o[i]; }
            if (k + 4 < 8) ld(k + 4, sl);
            ss += shx(ss, 16, fq * 16 + fr); ss += shx(ss, 32, fq * 16 + fr);
            if (fq == 0) *GP(float, ssq_out, (row * 16u + (unsigned)(u.pn * 4 + wc)) * 4u) = ss;
            asm volatile("" ::: "memory"); }
    }
};

struct TrItem { const float* W; bf16* WT; const float* g0; const float* g1; int ldn, KT, k0, n0, krow0, nrow0, gsplit, f8; };
__device__ __forceinline__ void tr_gain(const TrItem& d, float (&g)[8], int lane) {
    if (d.g0) {
#pragma unroll
        for (int i = 0; i < 8; ++i) { const int k = d.k0 + 8 * i + (lane >> 3); const GAS float* gp = (const GAS float*)(k < d.gsplit ? d.g0 + k : d.g1 + (k - d.gsplit)); g[i] = *gp; }
    } else {
#pragma unroll
        for (int i = 0; i < 8; ++i) g[i] = 1.0f;
    }
}
__device__ __forceinline__ void tr_data(const TrItem& d, f32x4 (&v)[8], int lane) {
#if CONV_BUF
    const __amdgpu_buffer_rsrc_t rs = __builtin_amdgcn_make_buffer_rsrc((void*)d.W, 0, 0x40000000, 0x00020000);
    const unsigned vo = (unsigned)((d.k0 + (lane >> 3)) * d.ldn + d.n0 + 4 * (lane & 7)) * 4u;
#pragma unroll
    for (int i = 0; i < 8; ++i) v[i] = __builtin_bit_cast(f32x4, __builtin_amdgcn_raw_buffer_load_b128(rs, vo + (unsigned)(8 * i * d.ldn) * 4u, 0, CONV_BUF));
#else
    const GAS f32x4* src = (const GAS f32x4*)(d.W + (size_t)(d.k0 + (lane >> 3)) * d.ldn + d.n0 + 4 * (lane & 7));
#pragma unroll
    for (int i = 0; i < 8; ++i) v[i] = (P0_NT || RD1_NT) ? __builtin_nontemporal_load((const GAS f32x4*)((const GAS float*)src + (size_t)(8 * i) * d.ldn)) : *(const GAS f32x4*)((const GAS float*)src + (size_t)(8 * i) * d.ldn);
#endif
}
__device__ __forceinline__ void tr_load(const TrItem& d, f32x4 (&v)[8], float (&g)[8], int lane) { tr_gain(d, g, lane); tr_data(d, v, lane); }
__device__ __forceinline__ void tr_store(const TrItem& d, const f32x4 (&v)[8], const float (&g)[8], LAS float* scr, int lane) {
    const float gm = d.f8 ? 64.0f : 1.0f;
#pragma unroll
    for (int i = 0; i < 8; ++i) { const f32x4 w = v[i] * (g[i] * gm);
#pragma unroll
        for (int j = 0; j < 4; ++j) scr[(4 * (lane & 7) + j) * 65 + 8 * i + (lane >> 3)] = w[j]; }
    LDS_WAIT(); asm volatile("" ::: "memory");
    const int n16 = lane >> 2, qt = lane & 3; const LAS float* s = scr + n16 * 65 + 16 * qt;
    f32x4 t[8];
#pragma unroll
    for (int q = 0; q < 2; ++q)
#pragma unroll
        for (int e = 0; e < 4; ++e) { t[4 * q + e].x = s[q * 16 * 65 + 4 * e]; t[4 * q + e].y = s[q * 16 * 65 + 4 * e + 1]; t[4 * q + e].z = s[q * 16 * 65 + 4 * e + 2]; t[4 * q + e].w = s[q * 16 * 65 + 4 * e + 3]; }
    asm volatile("s_waitcnt lgkmcnt(0)" : "+v"(t[0]), "+v"(t[1]), "+v"(t[2]), "+v"(t[3]), "+v"(t[4]), "+v"(t[5]), "+v"(t[6]), "+v"(t[7]) :: "memory");
    if (d.f8) {
#pragma unroll
        for (int q = 0; q < 2; ++q) { unsigned char* dst8 = (unsigned char*)d.WT + (size_t)(d.nrow0 + n16 + 16 * q) * d.KT + d.krow0 + 16 * qt;
            v4u o; o.x = pk4_fp8(t[4 * q].x, t[4 * q].y, t[4 * q].z, t[4 * q].w); o.y = pk4_fp8(t[4 * q + 1].x, t[4 * q + 1].y, t[4 * q + 1].z, t[4 * q + 1].w);
            o.z = pk4_fp8(t[4 * q + 2].x, t[4 * q + 2].y, t[4 * q + 2].z, t[4 * q + 2].w); o.w = pk4_fp8(t[4 * q + 3].x, t[4 * q + 3].y, t[4 * q + 3].z, t[4 * q + 3].w);
            if (P0_NT) __builtin_nontemporal_store(o, (GAS v4u*)dst8); else *(GAS v4u*)dst8 = o; }
        return; }
#pragma unroll
    for (int q = 0; q < 2; ++q) { bf16* dst = d.WT + (size_t)(d.nrow0 + n16 + 16 * q) * d.KT + d.krow0 + 16 * qt;
#pragma unroll
        for (int h = 0; h < 2; ++h) { v4u o; o.x = pk2(t[4 * q + 2 * h].x, t[4 * q + 2 * h].y); o.y = pk2(t[4 * q + 2 * h].z, t[4 * q + 2 * h].w); o.z = pk2(t[4 * q + 2 * h + 1].x, t[4 * q + 2 * h + 1].y); o.w = pk2(t[4 * q + 2 * h + 1].z, t[4 * q + 2 * h + 1].w);
            *(GAS v4u*)(dst + 8 * h) = o; } }
}
__device__ __forceinline__ void p0_prologue(Frame& F) {
    LAS float* scr = (LAS float*)(F.lds + RING_OFF + F.wave * 8448);
    const int gw = F.vcu * NWAVES + F.wave, NGW = F.G * NWAVES;
    unsigned char* ws = F.ws;
    const float* in_x = INP(0); const float* in_p = INP(1); const float* in_gmix = INP(2); const float* in_win = INP(3); const float* in_ws = INP(6); const float* in_ga = INP(9); const float* in_gb = INP(10);
    const float* in_wout = INP(11); const float* in_gmoe = INP(12); const float* in_wr = INP(13); const float* in_gple = INP(19); const float* in_wpg = INP(20); const float* in_wple = INP(21);
#if CONV_IN_P2
    constexpr int PER_L = 1280 + 512 + 512 + 128, N_SMALL = NLAYER * PER_L, NITEMS = N_SMALL;
#else
    const float* in_wgu = INP(15); const float* in_wdn = INP(17);
    constexpr int PER_L = 1280 + 512 + 512 + 128, N_SMALL = NLAYER * PER_L, N_GU = NLAYER * NEXP * 1024, N_DN = NLAYER * NEXP * 512, NITEMS = N_SMALL + N_GU + N_DN;
#endif
    auto kbnb = [](int item, int NB, int& kb, int& nb) { const int q = item >> 1; kb = 2 * (q / NB) + (item & 1); nb = q % NB; };
    auto decode = [&](int it) -> TrItem {
        TrItem d; d.g1 = nullptr; d.gsplit = 1 << 30; d.f8 = 0; int kb, nb;
        if (it < N_SMALL) { const int l = it / PER_L; int r = it % PER_L;
            if (r < 1280) { kbnb(r, 80, kb, nb); d.W = in_win + (size_t)l * DM * INC; d.ldn = INC; d.KT = DM; d.WT = P1_F8 ? (bf16*)(ws + WS_WIN + (size_t)l * NIN * DM) : (bf16*)(ws + WS_WIN) + (size_t)l * NIN * DM; d.f8 = P1_F8; d.k0 = 64 * kb; d.n0 = 32 * nb; d.krow0 = d.k0; d.nrow0 = d.n0; d.g0 = in_gmix + l * DM; return d; } r -= 1280;
            if (r < 512) { kbnb(r, 32, kb, nb); d.W = in_wout + (size_t)l * DM * DM; d.ldn = DM; d.KT = DM; d.WT = (bf16*)(ws + WS_WOUT) + (size_t)l * DM * DM; d.k0 = 64 * kb; d.n0 = 32 * nb; d.krow0 = (d.k0 + 512) & 1023; d.nrow0 = d.n0; d.g0 = in_ga + l * 512; d.g1 = in_gb + l * 512; d.gsplit = 512; return d; } r -= 512;
            if (r < 512) { kbnb(r, 32, kb, nb); d.W = in_wpg + (size_t)l * DM * DM; d.ldn = DM; d.KT = DM; d.WT = (bf16*)(ws + WS_WPG) + (size_t)l * DM * DM; d.k0 = 64 * kb; d.n0 = 32 * nb; d.krow0 = d.k0; d.nrow0 = d.n0; d.g0 = in_gple + l * DM; return d; } r -= 512;
            kbnb(r, 32, kb, nb); d.W = in_wple + (size_t)l * PLE * DM; d.ldn = DM; d.KT = PLE; d.WT = (bf16*)(ws + WS_WPLE) + (size_t)l * DM * PLE; d.k0 = 64 * kb; d.n0 = 32 * nb; d.krow0 = d.k0; d.nrow0 = d.n0; d.g0 = nullptr; return d; }
#if !CONV_IN_P2
        if (it < N_SMALL + N_GU) { const int r = it - N_SMALL, le = r >> 10, item = r & 1023; kbnb(item, 64, kb, nb); d.k0 = 64 * kb; d.n0 = 32 * nb;
            d.nrow0 = d.n0 < 1024 ? 256 * (d.n0 >> 7) + (d.n0 & 127) : 256 * ((d.n0 - 1024) >> 7) + 128 + ((d.n0 - 1024) & 127);
            d.W = in_wgu + (size_t)le * DM * 2048; d.ldn = 2048; d.KT = DM; d.WT = (bf16*)(ws + WS_WGU + (size_t)le * 2048 * DM); d.f8 = 1; d.krow0 = d.k0; d.g0 = in_gmoe + (le >> 5) * DM; return d; }
        { const int r = it - N_SMALL - N_GU, le = r >> 9, item = r & 511; kbnb(item, 32, kb, nb); d.k0 = 64 * kb; d.n0 = 32 * nb;
            d.W = in_wdn + (size_t)le * DM * DM; d.ldn = DM; d.KT = DM; d.WT = (bf16*)(ws + WS_WDN + (size_t)le * DM * DM); d.f8 = 1; d.krow0 = d.k0; d.nrow0 = d.n0; d.g0 = nullptr; return d; }
#else
        return d;
#endif
    };
    { f32x4 va[8], vb[8], vc[8], vd[8]; float ga[8], gb[8], gc[8], gd[8]; int it = 2 * gw;
        if (it < NITEMS) { TrItem da = decode(it), db = decode(it + 1); tr_load(da, va, ga, F.lane); tr_load(db, vb, gb, F.lane);
            for (;;) { const int it2 = it + 2 * NGW; TrItem dc = da, dd = db; if (it2 < NITEMS) { dc = decode(it2); dd = decode(it2 + 1); tr_load(dc, vc, gc, F.lane); tr_load(dd, vd, gd, F.lane); }
                tr_store(da, va, ga, scr, F.lane); tr_store(db, vb, gb, scr, F.lane); if (it2 >= NITEMS) break;
                const int it3 = it2 + 2 * NGW; if (it3 < NITEMS) { da = decode(it3); db = decode(it3 + 1); tr_load(da, va, ga, F.lane); tr_load(db, vb, gb, F.lane); }
                tr_store(dc, vc, gc, scr, F.lane); tr_store(dd, vd, gd, scr, F.lane); if (it3 >= NITEMS) break; it = it3; } } }
    const int gt = F.vcu * (NWAVES * 64) + F.tid, NGT = F.G * NWAVES * 64;
    for (int i = gt; i < NLAYER * 32 * DM; i += NGT) { const int l = i / (32 * DM), j = (i / DM) % 32, k = i % DM;
        ((bf16*)(ws + WS_WFB))[i] = (bf16)(j < 8 ? f2bf(in_win[((size_t)l * DM + k) * INC + NIN + j] * in_gmix[l * DM + k]) : 0u);
        ((bf16*)(ws + WS_WRB))[i] = (bf16)f2bf(in_wr[((size_t)l * DM + k) * NEXP + j] * in_gmoe[l * DM + k]); }
    for (int i = gt; i < NLAYER * 4 * 128 * 128; i += NGT) { const int ii = (i >> 7) & 127, jj = i & 127; ((bf16*)(ws + WS_WSB))[i] = (bf16)(((jj >> 6) <= (ii >> 6)) ? f2bf(in_ws[i]) : 0u); }
#ifndef XROWS
#define XROWS 8
#endif
    static_assert(T % (XROWS * 8) == 0, "x rows per wave");
    for (int m = XROWS * gw; m < T; m += XROWS * NGW) { f32x4 v[XROWS][4]; float s[XROWS];
#pragma unroll
        for (int r = 0; r < XROWS; ++r) { const GAS f32x4* xr = (const GAS f32x4*)(in_x + (size_t)(m + r) * DM) + F.lane;
#pragma unroll
            for (int j = 0; j < 4; ++j) v[r][j] = FIN_NT ? __builtin_nontemporal_load(xr + 64 * j) : xr[64 * j]; }
#pragma unroll
        for (int r = 0; r < XROWS; ++r) { float ss = 0.f;
#pragma unroll
            for (int j = 0; j < 4; ++j) ss += (v[r][j].x * v[r][j].x + v[r][j].y * v[r][j].y) + (v[r][j].z * v[r][j].z + v[r][j].w * v[r][j].w);
            s[r] = wave_sum(ss, F.lane);
            GAS unsigned long long* o8 = (GAS unsigned long long*)((bf16*)(ws + WS_HBA) + (size_t)(m + r) * DM) + F.lane;
#pragma unroll
            for (int j = 0; j < 4; ++j) o8[64 * j] = (unsigned long long)pk2(v[r][j].x, v[r][j].y) | ((unsigned long long)pk2(v[r][j].z, v[r][j].w) << 32);
            if (P1_F8) { GAS unsigned* o4 = (GAS unsigned*)(ws + WS_H8 + (size_t)(m + r) * DM) + F.lane;
#pragma unroll
                for (int j = 0; j < 4; ++j) o4[64 * j] = pk4_fp8(clamp448(v[r][j].x), clamp448(v[r][j].y), clamp448(v[r][j].z), clamp448(v[r][j].w)); }
            if (F.lane < 16) ((float*)(ws + WS_SSQX))[(size_t)(m + r) * 16 + F.lane] = F.lane == 0 ? s[r] : 0.f; } }
    if (!P_IN_P2) for (size_t i0 = gt; i0 < (size_t)NLAYER * T * PLE / 8; i0 += (size_t)4 * NGT) { f32x4 a[4], b[4];
#pragma unroll
        for (int u = 0; u < 4; ++u) { const size_t i = i0 + (size_t)u * NGT; if (i < (size_t)NLAYER * T * PLE / 8) { const GAS f32x4* pr = (const GAS f32x4*)in_p + 2 * i; a[u] = pr[0]; b[u] = pr[1]; } }
#pragma unroll
        for (int u = 0; u < 4; ++u) { const size_t i = i0 + (size_t)u * NGT; if (i < (size_t)NLAYER * T * PLE / 8) { v4u o; o.x = pk2(a[u].x, a[u].y); o.y = pk2(a[u].z, a[u].w); o.z = pk2(b[u].x, b[u].y); o.w = pk2(b[u].z, b[u].w); ((GAS v4u*)(ws + WS_PB))[i] = o; } }
    }
}

#ifdef CONV_DUP
__device__ __forceinline__ int conv_two() { int n = 2; asm volatile("" : "+s"(n)); return n; }
#define CONV_REP _Pragma("unroll 1") for (int r_ = 0, nrep_ = conv_two(); r_ < nrep_; ++r_)
#else
#define CONV_REP
#endif
#ifndef CONV_CH
#define CONV_CH 8
#endif
#ifndef CONV_CL
#define CONV_CL 4
#endif
#if CONV_DMA
__device__ __forceinline__ void conv_experts(Frame& F, int l) {
    unsigned char* ws = F.ws;
    const float* in_gmoe = INP(12); const float* in_wgu = INP(15); const float* in_wdn = INP(17);
    constexpr int NCH = NEXP * 8 + NEXP * 4;
    gu32* ctr = F.ctl + CW_CONV + l * 64;
    LAS int* slot = (LAS int*)(F.lds + LDSCTL_OFF + 448);
    LAS unsigned char* gsm = F.lds + LDSCTL_OFF + 11264;
    const int lane = F.lane, w = F.wave, n16 = lane >> 2, qt = lane & 3;
    if (F.tid < 256) *(LAS f32x4*)(gsm + 16 * F.tid) = *(const GAS f32x4*)(in_gmoe + l * DM + 4 * F.tid);
    __syncthreads();
    unsigned nxtw = 0; if (F.tid == 0) nxtw = __hip_atomic_fetch_add(ctr, 1u, RLX_AGENT);
    struct Tile { const float* W; unsigned char* O; int ldn, n0, k0, nrow0, gain; };
    int itc = 0, tk = 16; Tile cd; cd.W = nullptr; cd.O = nullptr; cd.ldn = 0; cd.n0 = 0; cd.k0 = 0; cd.nrow0 = 0; cd.gain = 0;
    auto next_tile = [&](Tile& o) -> bool {
        if (tk == 16) {
            if (F.tid == 0) slot[itc & 1] = (int)nxtw;
            asm volatile("s_waitcnt lgkmcnt(0)\n\ts_barrier" ::: "memory");
            const int c = __builtin_amdgcn_readfirstlane(slot[itc & 1]); ++itc;
            if (c >= NCH) return false;
            if (F.tid == 0) nxtw = __hip_atomic_fetch_add(ctr, 1u, RLX_AGENT);
            if (c < NEXP * 8) { const int le = l * NEXP + (c >> 3), n0 = 256 * (c & 7), n0w = n0 + 32 * w;
                cd.W = in_wgu + (size_t)le * DM * 2048; cd.O = ws + WS_WGU + (size_t)le * 2048 * DM; cd.ldn = 2048; cd.n0 = n0; cd.gain = 1;
                cd.nrow0 = n0w < 1024 ? 256 * (n0w >> 7) + (n0w & 127) : 256 * ((n0w - 1024) >> 7) + 128 + ((n0w - 1024) & 127); }
            else { const int c2 = c - NEXP * 8, le = l * NEXP + (c2 >> 2), n0 = 256 * (c2 & 3);
                cd.W = in_wdn + (size_t)le * DM * DM; cd.O = ws + WS_WDN + (size_t)le * DM * DM; cd.ldn = DM; cd.n0 = n0; cd.gain = 0; cd.nrow0 = n0 + 32 * w; }
            tk = 0; }
        o = cd; o.k0 = 64 * tk; ++tk; return true; };
    auto issue = [&](const Tile& d, int b) {
        const int fl = ((w >> 1) & 1) * 4;
        const float* g0 = d.W + (size_t)(d.k0 + 8 * w) * d.ldn + d.n0 + 4 * (lane ^ fl);
#pragma unroll
        for (int i = 0; i < 8; ++i) __builtin_amdgcn_global_load_lds((const unsigned*)(g0 + (size_t)i * d.ldn), (LAS unsigned*)(F.lds + RING_OFF + b * 65536 + (8 * w + i) * 1024), 16, 0, CONV_DMA_AUX);
    };
    auto process = [&](const Tile& d, int b) {
        const int fk = 4 * (qt & 1); f32x4 t[8], gv[4];
#pragma unroll
        for (int q = 0; q < 2; ++q) { const int nl = 32 * w + 16 * q + n16; const LAS float* s = (const LAS float*)(F.lds + RING_OFF + b * 65536 + (16 * qt) * 1024 + 16 * ((nl >> 2) ^ fk) + 4 * (nl & 3));
#pragma unroll
            for (int e = 0; e < 4; ++e) { t[4 * q + e].x = s[(4 * e) * 256]; t[4 * q + e].y = s[(4 * e + 1) * 256]; t[4 * q + e].z = s[(4 * e + 2) * 256]; t[4 * q + e].w = s[(4 * e + 3) * 256]; } }
#pragma unroll
        for (int e = 0; e < 4; ++e) gv[e] = *(const LAS f32x4*)(gsm + (d.k0 + 16 * qt) * 4 + 16 * e);
        asm volatile("s_waitcnt lgkmcnt(0)" : "+v"(t[0]), "+v"(t[1]), "+v"(t[2]), "+v"(t[3]), "+v"(t[4]), "+v"(t[5]), "+v"(t[6]), "+v"(t[7]) :: "memory");
#pragma unroll
        for (int q = 0; q < 2; ++q) { unsigned char* dst8 = d.O + (size_t)(d.nrow0 + 16 * q + n16) * DM + d.k0 + 16 * qt; v4u o; unsigned ow[4];
#pragma unroll
            for (int e = 0; e < 4; ++e) { const f32x4 m = d.gain ? gv[e] * 64.0f : (f32x4){64.0f, 64.0f, 64.0f, 64.0f}; const f32x4 x = t[4 * q + e] * m; ow[e] = pk4_fp8(x.x, x.y, x.z, x.w); }
            o.x = ow[0]; o.y = ow[1]; o.z = ow[2]; o.w = ow[3]; *(GAS v4u*)dst8 = o; }
    };
    Tile cur;
    if (next_tile(cur)) { issue(cur, 0);
        for (int it = 0;; ++it) { Tile nx; const bool hn = next_tile(nx);
            if (it > 0) asm volatile("s_barrier" ::: "memory");
            if (hn) { issue(nx, (it + 1) & 1); asm volatile("s_waitcnt vmcnt(8)" ::: "memory"); } else asm volatile("s_waitcnt vmcnt(0)" ::: "memory");
            asm volatile("s_barrier" ::: "memory");
            process(cur, it & 1);
            if (!hn) break; cur = nx; } }
}
#else
__device__ __forceinline__ void conv_experts(Frame& F, int l) {
    LAS float* scr = (LAS float*)(F.lds + RING_OFF + F.wave * 8448);
    unsigned char* ws = F.ws;
    const float* in_gmoe = INP(12); const float* in_wgu = INP(15); const float* in_wdn = INP(17);
    constexpr int NP_GU = NEXP * 512, NP_DN = NEXP * 256, NP = NP_GU + NP_DN;
    constexpr int NBIG = (NP * 3 / 4) / CONV_CH, NSMALL = (NP - NBIG * CONV_CH) / CONV_CL, NCHUNK = NBIG + NSMALL;
    static_assert((NP * 3 / 4) % CONV_CH == 0 && (NP - NBIG * CONV_CH) % CONV_CL == 0, "chunking");
    gu32* ctr = F.ctl + CW_CONV + l * 64;
    auto kbnb = [](int item, int NB, int& kb, int& nb) { const int q = item >> 1; kb = 2 * (q / NB) + (item & 1); nb = q % NB; };
    auto decode = [&](int it) -> TrItem {
        TrItem d; d.g1 = nullptr; d.gsplit = 1 << 30; d.f8 = 1; int kb, nb;
        if (it < 2 * NP_GU) { const int le = l * NEXP + (it >> 10), item = it & 1023; kbnb(item, 64, kb, nb); d.k0 = 64 * kb; d.n0 = 32 * nb;
            d.nrow0 = d.n0 < 1024 ? 256 * (d.n0 >> 7) + (d.n0 & 127) : 256 * ((d.n0 - 1024) >> 7) + 128 + ((d.n0 - 1024) & 127);
            d.W = in_wgu + (size_t)le * DM * 2048; d.ldn = 2048; d.KT = DM; d.WT = (bf16*)(ws + WS_WGU + (size_t)le * 2048 * DM); d.krow0 = d.k0; d.g0 = in_gmoe + l * DM; return d; }
        { const int r = it - 2 * NP_GU, le = l * NEXP + (r >> 9), item = r & 511; kbnb(item, 32, kb, nb); d.k0 = 64 * kb; d.n0 = 32 * nb;
            d.W = in_wdn + (size_t)le * DM * DM; d.ldn = DM; d.KT = DM; d.WT = (bf16*)(ws + WS_WDN + (size_t)le * DM * DM); d.krow0 = d.k0; d.nrow0 = d.n0; d.g0 = nullptr; return d; }
    };
#if CONV_WG
    constexpr int WCH = 8 * CONV_CH, NWCH = NP / WCH; static_assert(NP % WCH == 0 && NWAVES == 8, "workgroup chunks");
    LAS int* slot = (LAS int*)(F.lds + LDSCTL_OFF + 448);
    unsigned nxtw = 0; if (F.tid == 0) nxtw = __hip_atomic_fetch_add(ctr, 1u, RLX_AGENT);
    f32x4 va[8], vb[8], vc[8], vd[8]; float ga[8], gb[8], gc[8], gd[8];
    int itc = 0, j = CONV_CH, base = 0;
    auto next = [&]() -> int {
        if (j == CONV_CH) {
            if (F.tid == 0) slot[itc & 1] = (int)nxtw;
            asm volatile("s_waitcnt lgkmcnt(0)\n\ts_barrier" ::: "memory");
            const int c = __builtin_amdgcn_readfirstlane(slot[itc & 1]); ++itc;
            if (c >= NWCH) return -1;
            if (F.tid == 0) nxtw = __hip_atomic_fetch_add(ctr, 1u, RLX_AGENT);
            base = c * WCH + F.wave; j = 0; }
        return base + 8 * j++; };
    int p = next();
    if (p >= 0) { TrItem da = decode(2 * p), db = decode(2 * p + 1); tr_load(da, va, ga, F.lane); tr_load(db, vb, gb, F.lane);
        for (;;) { const int p2 = next(); TrItem dc = da, dd = db; if (p2 >= 0) { dc = decode(2 * p2); dd = decode(2 * p2 + 1); tr_load(dc, vc, gc, F.lane); tr_load(dd, vd, gd, F.lane); }
            CONV_REP { tr_store(da, va, ga, scr, F.lane); tr_store(db, vb, gb, scr, F.lane); } if (p2 < 0) break;
            const int p3 = next(); if (p3 >= 0) { da = decode(2 * p3); db = decode(2 * p3 + 1); tr_load(da, va, ga, F.lane); tr_load(db, vb, gb, F.lane); }
            CONV_REP { tr_store(dc, vc, gc, scr, F.lane); tr_store(dd, vd, gd, scr, F.lane); } if (p3 < 0) break; } }
#else
    int cur = 0, end = 0;
    auto grab = [&]() -> unsigned { unsigned c = 0; if (F.lane == 0) c = __hip_atomic_fetch_add(ctr, 1u, RLX_AGENT); return c; };
    unsigned nxt = grab();
    auto next = [&]() -> int {
        if (cur == end) { const unsigned c = (unsigned)__builtin_amdgcn_readfirstlane((int)nxt); if (c >= (unsigned)NCHUNK) return -1; if (c < (unsigned)NBIG) { cur = (int)c * CONV_CH; end = cur + CONV_CH; } else { cur = NBIG * CONV_CH + ((int)c - NBIG) * CONV_CL; end = cur + CONV_CL; } nxt = grab(); }
        return cur++; };
    f32x4 va[8], vb[8], vc[8], vd[8]; float ga[8], gb[8], gc[8], gd[8];
    int p = next();
    if (p >= 0) { TrItem da = decode(2 * p), db = decode(2 * p + 1); tr_load(da, va, ga, F.lane); tr_load(db, vb, gb, F.lane);
        for (;;) { const int p2 = next(); TrItem dc = da, dd = db; if (p2 >= 0) { dc = decode(2 * p2); dd = decode(2 * p2 + 1); tr_load(dc, vc, gc, F.lane); tr_load(dd, vd, gd, F.lane); }
            tr_store(da, va, ga, scr, F.lane); tr_store(db, vb, gb, scr, F.lane); if (p2 < 0) break;
            const int p3 = next(); if (p3 >= 0) { da = decode(2 * p3); db = decode(2 * p3 + 1); tr_load(da, va, ga, F.lane); tr_load(db, vb, gb, F.lane); }
            tr_store(dc, vc, gc, scr, F.lane); tr_store(dd, vd, gd, scr, F.lane); if (p3 < 0) break; } }
#endif
}

#endif
__device__ __forceinline__ void conv_p(Frame& F) {
    static_assert(!P_IN_P2 || CONV_IN_P2, "conv_p is called from the conversion queue's call sites");
    unsigned char* ws = F.ws; const float* in_p = INP(1);
    constexpr int NPC = NLAYER * T * PLE / 65536;
    gu32* ctr = F.ctl + CW_CONV + 2 * 64;
    LAS int* slot = (LAS int*)(F.lds + LDSCTL_OFF + 456);
    for (int itc = 0;; ++itc) {
        if (F.tid == 0) slot[itc & 1] = (int)__hip_atomic_fetch_add(ctr, 1u, RLX_AGENT);
        __syncthreads();
        const int c = __builtin_amdgcn_readfirstlane(slot[itc & 1]);
        if (c >= NPC) break;
#pragma unroll 1
        for (int r = 0; r < 4; ++r) { f32x4 a[4], b[4]; const size_t i0 = (size_t)c * 8192 + (size_t)r * 2048 + F.tid;
#pragma unroll
            for (int u = 0; u < 4; ++u) { const GAS f32x4* pr = (const GAS f32x4*)in_p + 2 * (i0 + (size_t)u * 512); a[u] = pr[0]; b[u] = pr[1]; }
#pragma unroll
            for (int u = 0; u < 4; ++u) { v4u o; o.x = pk2(a[u].x, a[u].y); o.y = pk2(a[u].z, a[u].w); o.z = pk2(b[u].x, b[u].y); o.w = pk2(b[u].z, b[u].w); ((GAS v4u*)(ws + WS_PB))[i0 + (size_t)u * 512] = o; } }
    }
}

constexpr int SK_PITCH = 2064, SK_BW = 0, SK_SCR = 32 * SK_PITCH, SK_SCR_BYTES = 4608, SK_LCNT = SK_SCR + 8 * SK_SCR_BYTES, SK_LBASE = SK_LCNT + 128;
typedef float f32x16 __attribute__((ext_vector_type(16)));
__device__ __forceinline__ int crow16(int r, int hi) { return (r & 3) + 8 * (r >> 2) + 4 * hi; }
__device__ __forceinline__ void sk_load_bw(Frame& F, const bf16* wsrc) {
    v4u t[8];
#pragma unroll
    for (int i = 0; i < 8; ++i) { const int idx = F.tid + 512 * i, row = idx >> 7, ch = idx & 127; t[i] = *(const GAS v4u*)(wsrc + row * 1024 + ch * 8); }
    asm volatile("" : "+v"(t[0]), "+v"(t[1]), "+v"(t[2]), "+v"(t[3]), "+v"(t[4]), "+v"(t[5]), "+v"(t[6]), "+v"(t[7]));
#pragma unroll
    for (int i = 0; i < 8; ++i) { const int idx = F.tid + 512 * i, row = idx >> 7, ch = idx & 127; *(LAS v4u*)(F.lds + SK_BW + row * SK_PITCH + ch * 16) = t[i]; }
}
__device__ __forceinline__ void skinny32_load(const bf16* hb, int tok0, int lane, int S0, v4u (&a)[32]) {
    const int r32 = lane & 31, hi = lane >> 5;
    const GAS v4u* ap = (const GAS v4u*)(hb + (size_t)(tok0 + r32) * DM + 32 * hi);
#pragma unroll
    for (int q = 0; q < 32; ++q) a[q] = ap[(S0 + (q >> 2)) * 8 + (q & 3)];
}
__device__ __forceinline__ f32x16 skinny32_mma(v4u (&a)[32], LAS const unsigned char* bw, int lane, int S0) {
    const int r32 = lane & 31, hi = lane >> 5;
    LAS const unsigned char* bp = bw + r32 * SK_PITCH + 64 * hi;
    f32x16 acc = f32x16{};
#pragma unroll
    for (int hf = 0; hf < 2; ++hf) {
        asm volatile("" : "+v"(a[16 * hf + 0]), "+v"(a[16 * hf + 1]), "+v"(a[16 * hf + 2]), "+v"(a[16 * hf + 3]), "+v"(a[16 * hf + 4]), "+v"(a[16 * hf + 5]), "+v"(a[16 * hf + 6]), "+v"(a[16 * hf + 7]), "+v"(a[16 * hf + 8]), "+v"(a[16 * hf + 9]), "+v"(a[16 * hf + 10]), "+v"(a[16 * hf + 11]), "+v"(a[16 * hf + 12]), "+v"(a[16 * hf + 13]), "+v"(a[16 * hf + 14]), "+v"(a[16 * hf + 15]));
#pragma unroll
        for (int ss = 0; ss < 4; ++ss) { const int S = S0 + 4 * hf + ss;
            const bf16x8 b0 = *(LAS const bf16x8*)(bp + S * 128), b1 = *(LAS const bf16x8*)(bp + S * 128 + 16), b2 = *(LAS const bf16x8*)(bp + S * 128 + 32), b3 = *(LAS const bf16x8*)(bp + S * 128 + 48);
            acc = __builtin_amdgcn_mfma_f32_32x32x16_bf16(__builtin_bit_cast(bf16x8, a[16 * hf + 4 * ss + 0]), b0, acc, 0, 0, 0);
            acc = __builtin_amdgcn_mfma_f32_32x32x16_bf16(__builtin_bit_cast(bf16x8, a[16 * hf + 4 * ss + 1]), b1, acc, 0, 0, 0);
            acc = __builtin_amdgcn_mfma_f32_32x32x16_bf16(__builtin_bit_cast(bf16x8, a[16 * hf + 4 * ss + 2]), b2, acc, 0, 0, 0);
            acc = __builtin_amdgcn_mfma_f32_32x32x16_bf16(__builtin_bit_cast(bf16x8, a[16 * hf + 4 * ss + 3]), b3, acc, 0, 0, 0); } }
    return acc;
}
__device__ __forceinline__ float row_rinv16(const float* ssq16, int tok) {
    const GAS f32x4* p = (const GAS f32x4*)(ssq16 + (size_t)tok * 16); const f32x4 a = p[0], b = p[1], c = p[2], d = p[3];
    const float s = (((a.x + a.y) + (a.z + a.w)) + ((b.x + b.y) + (b.z + b.w))) + (((c.x + c.y) + (c.z + c.w)) + ((d.x + d.y) + (d.z + d.w)));
    return rsqrtf(s * (1.0f / DM) + EPS);
}
__device__ __forceinline__ void p1_flogit(Frame& F, int l, const bf16* hb, const float* ssq16) {
    v4u ska[32]; bool skpre = F.vcu < T / 128;
    if (skpre) skinny32_load(hb, F.vcu * 128 + (F.wave & 3) * 32, F.lane, (F.wave >> 2) * 8, ska);
    sk_load_bw(F, (const bf16*)(F.ws + WS_WFB) + (size_t)l * 32 * DM);
    __syncthreads();
    LAS float* rvs = (LAS float*)(F.lds + SK_SCR + F.wave * SK_SCR_BYTES);
    const float* in_bf = INP(8);
    const int r32 = F.lane & 31, hi = F.lane >> 5;
    for (int g = F.vcu; g < T / 128; g += F.G) {
        const int tok0 = g * 128 + (F.wave & 3) * 32;
        const float rvv = row_rinv16(ssq16, tok0 + r32);
        if (!skpre) skinny32_load(hb, tok0, F.lane, (F.wave >> 2) * 8, ska);
        skpre = false;
        f32x16 acc = skinny32_mma(ska, F.lds + SK_BW, F.lane, (F.wave >> 2) * 8);
        if (F.wave < 4 && F.lane < 32) rvs[F.lane] = rvv;
        if (F.wave >= 4) {
#pragma unroll
            for (int r = 0; r < 16; ++r) rvs[r * 64 + F.lane] = acc[r]; }
        __syncthreads();
        if (F.wave < 4) { const LAS float* part = rvs + 4 * (SK_SCR_BYTES / 4);
#pragma unroll
            for (int r = 0; r < 16; ++r) acc[r] += part[r * 64 + F.lane];
            if (r32 < 8) { const float bf = in_bf[l * 8 + r32];
#pragma unroll
                for (int r = 0; r < 16; ++r) { const int tr = crow16(r, hi); const float v = acc[r] * rvs[tr] + bf; const float ls = fminf(v, 0.f) - log1pf(__expf(-fabsf(v)));
                    ((float*)(F.ws + WS_LF))[(size_t)r32 * T + (tok0 + tr)] = ls * LOG2E; } }
        }
        __syncthreads();
    }
}
__device__ __forceinline__ void p4_router(Frame& F, int l, const bf16* hb, const float* ssq16) {
    v4u ska[32]; bool skpre = F.vcu < T / 128;
    if (skpre) skinny32_load(hb, F.vcu * 128 + (F.wave & 3) * 32, F.lane, (F.wave >> 2) * 8, ska);
    sk_load_bw(F, (const bf16*)(F.ws + WS_WRB) + (size_t)l * 32 * DM);
    LAS int* lcnt = (LAS int*)(F.lds + SK_LCNT); LAS int* lbase = (LAS int*)(F.lds + SK_LBASE);
    LAS float* lg = (LAS float*)(F.lds + SK_SCR + F.wave * SK_SCR_BYTES);
    const int r32 = F.lane & 31, hi = F.lane >> 5;
    const float* in_br = INP(14);
    int* lists = (int*)(F.ws + WS_LISTS); int* tope = (int*)(F.ws + WS_TOPE); float* gate = (float*)(F.ws + WS_GATE); float* rinv = (float*)(F.ws + WS_RINV);
    for (int g = F.vcu; g < T / 128; g += F.G) {
        if (F.tid < 32) lcnt[F.tid] = 0;
        __syncthreads();
        int ei[4] = {0, 0, 0, 0}, lr[4] = {0, 0, 0, 0}; float gv[4] = {0.f, 0.f, 0.f, 0.f}, rv_tok = 0.f; const int tok = g * 128 + (F.wave & 3) * 32 + r32;
        const float rv_pre = row_rinv16(ssq16, tok);
        if (!skpre) skinny32_load(hb, g * 128 + (F.wave & 3) * 32, F.lane, (F.wave >> 2) * 8, ska);
        skpre = false;
        f32x16 acc = skinny32_mma(ska, F.lds + SK_BW, F.lane, (F.wave >> 2) * 8);
        if (F.wave >= 4) {
#pragma unroll
            for (int r = 0; r < 16; ++r) lg[r * 64 + F.lane] = acc[r]; }
        __syncthreads();
        if (F.wave < 4) { const LAS float* part = lg + 4 * (SK_SCR_BYTES / 4);
#pragma unroll
            for (int r = 0; r < 16; ++r) acc[r] += part[r * 64 + F.lane];
#pragma unroll
            for (int r = 0; r < 16; ++r) lg[crow16(r, hi) * 33 + r32] = acc[r];
            LDS_WAIT(); asm volatile("" ::: "memory");
            if (hi == 0) {
                const float rv = rv_pre; rinv[tok] = rv; rv_tok = rv;
                float v[32];
#pragma unroll
                for (int e = 0; e < 32; ++e) v[e] = lg[r32 * 33 + e] * rv + in_br[l * 32 + e];
                float tv[4];
#pragma unroll
                for (int k = 0; k < 4; ++k) { float best = -INFINITY; int bi = 0;
#pragma unroll
                    for (int e = 0; e < 32; ++e) { const bool gt = v[e] > best; best = gt ? v[e] : best; bi = gt ? e : bi; }
#pragma unroll
                    for (int e = 0; e < 32; ++e) v[e] = (e == bi) ? -INFINITY : v[e];
                    tv[k] = best; ei[k] = bi; }
                float sum = 0.f;
#pragma unroll
                for (int k = 0; k < 4; ++k) { gv[k] = __expf(tv[k] - tv[0]); sum += gv[k]; }
                const float inv = 1.0f / sum;
#pragma unroll
                for (int k = 0; k < 4; ++k) { gv[k] *= inv; lr[k] = __hip_atomic_fetch_add(&lcnt[ei[k]], 1, __ATOMIC_RELAXED, __HIP_MEMORY_SCOPE_WORKGROUP); }
            }
        }
        __syncthreads();
        if (F.tid < 32) { const int c = lcnt[F.tid]; lbase[F.tid] = c ? (int)__hip_atomic_fetch_add(F.ctl + CW_CNT + (l * 32 + F.tid) * 64, (unsigned)c, RLX_AGENT) : 0; }
        __syncthreads();
        if (F.wave < 4 && hi == 0) {
#pragma unroll
            for (int k = 0; k < 4; ++k) { const int slot = lbase[ei[k]] + lr[k]; { const int li_ = 2 * (ei[k] * 32768 + slot); lists[li_] = tok; lists[li_ + 1] = (int)__float_as_uint(rv_tok); } tope[tok * 4 + k] = (ei[k] << 16) | slot; gate[tok * 4 + k] = gv[k]; }
        }
        __syncthreads();
    }
}
__device__ __forceinline__ int build_tiles(Frame& F, int l) {
    LAS int* cnt = (LAS int*)(F.lds + LCNT_OFF); LAS int* tst = (LAS int*)(F.lds + LTST_OFF); LAS int* tiles = (LAS int*)(F.lds + LTILES_OFF);
    if (F.tid < 32) { const int c = (int)__hip_atomic_load(F.ctl + CW_CNT + (l * 32 + F.tid) * 64, RLX_AGENT), n = (c + 255) >> 8; int x = n;
#pragma unroll
        for (int o = 1; o < 32; o <<= 1) { const int y = __builtin_amdgcn_ds_bpermute((F.tid - o) << 2, x); if (F.tid >= o) x += y; }
        const int s0 = x - n; cnt[F.tid] = c; tst[F.tid] = s0; if (F.tid == 31) tst[32] = x;
        for (int m = 0; m < n; ++m) tiles[s0 + m] = F.tid | (m << 8); }
    __syncthreads();
    return __builtin_amdgcn_readfirstlane(tst[32]);
}
__device__ __forceinline__ int reuse_tiles(Frame& F, int l) {
    if (MK_PER_STEP) return build_tiles(F, l);
    return __builtin_amdgcn_readfirstlane(*(LAS int*)(F.lds + LTST_OFF + 32 * 4));
}

__device__ __forceinline__ void fox_scan(Frame& F, int bh) {
    const int b = bh >> 3, h = bh & 7, s0 = 8 * F.tid;
    const GAS f32x4* lf = (const GAS f32x4*)((const float*)(F.ws + WS_LF) + (size_t)h * T + (size_t)b * SEQ + s0);
    float v[8]; { const f32x4 a_ = lf[0], b_ = lf[1]; v[0] = a_.x; v[1] = a_.y; v[2] = a_.z; v[3] = a_.w; v[4] = b_.x; v[5] = b_.y; v[6] = b_.z; v[7] = b_.w; }
#pragma unroll
    for (int i = 1; i < 8; ++i) v[i] += v[i - 1];
    float x = v[7];
#pragma unroll
    for (int o = 1; o < 64; o <<= 1) { const float y = __int_as_float(__builtin_amdgcn_ds_bpermute((F.lane - o) << 2, __float_as_int(x))); if (F.lane >= o) x += y; }
    LAS float* wsum = (LAS float*)(F.lds + attn_body::LDS_WS);
    if (F.lane == 63) wsum[F.wave] = x;
    __syncthreads();
    float base = x - v[7];
    for (int w = 0; w < F.wave; ++w) base += wsum[w];
    LAS attn_body::kx2_t* kx = (LAS attn_body::kx2_t*)(F.lds + attn_body::LDS_KX) + s0;
#pragma unroll
    for (int i = 0; i < 8; ++i) { const float bias = -(base + v[i]); const unsigned hh = f2bf(bias); const float r1 = bias - __uint_as_float(hh << 16); const unsigned mm = f2bf(r1); const float r2 = r1 - __uint_as_float(mm << 16); const unsigned ll = f2bf(r2);
        attn_body::kx2_t o; o.x = hh | (mm << 16); o.y = ll | 0x3F800000u; kx[i] = o; }
    __syncthreads();
}
constexpr int GM_ST = 0, GM_VT = 1024, GM_PITCH = 136;
typedef float f32x4v __attribute__((ext_vector_type(4)));
#define GM_BAR() asm volatile("s_waitcnt lgkmcnt(0)\n\ts_barrier" ::: "memory")
__device__ __forceinline__ void gmlp_unit(Frame& F, int l, int blk) {
    const bf16* VG = (const bf16*)(F.ws + WS_U + SEG_BYTES); const bf16* U = (const bf16*)(F.ws + WS_U); bf16* YC = (bf16*)(F.ws + WS_YC);
    const bf16* WSB = (const bf16*)(F.ws + WS_WSB) + (size_t)l * 4 * 128 * 128;
    const float* in_lng = INP(4); const float* in_lnb = INP(5); const float* in_bs = INP(7);
    LAS float* st = (LAS float*)(F.lds + GM_ST); LAS unsigned char* vt = F.lds + GM_VT;
    const int row0 = blk * 128, lane = F.lane, w = F.wave, fr = lane & 15, fq = lane >> 4;
    const int i = 16 * w + fr; const size_t grow = (size_t)(row0 + i);
    auto ld_rws = [&](int g, unsigned (&r)[16]) {
#pragma unroll
        for (int q = 0; q < 16; ++q) r[q] = *(const GAS unsigned*)(VG + (size_t)(row0 + w * 16 + q) * 512 + g * 128 + 2 * lane); };
    auto ld_ln = [&](int g, float (&pp)[4]) { const int c = l * 512 + g * 128 + 2 * lane; pp[0] = in_lng[c]; pp[1] = in_lng[c + 1]; pp[2] = in_lnb[c]; pp[3] = in_lnb[c + 1]; };
    auto ld_wf = [&](int g, bf16x8 (&f)[4]) {
#pragma unroll
        for (int ks = 0; ks < 4; ++ks) f[ks] = *(const GAS bf16x8*)(WSB + ((size_t)(g * 128 + 16 * w + fr)) * 128 + 32 * ks + 8 * fq); };
    v4u raws[16];
#pragma unroll
    for (int rr = 0; rr < 16; ++rr) raws[rr] = *(const GAS v4u*)(VG + (size_t)(row0 + w * 16 + rr) * 512 + lane * 8);
    unsigned rws[16]; float lnp[4]; bf16x8 wf[4], wfn[4]; float bs, bsn;
    ld_rws(0, rws); ld_ln(0, lnp); ld_wf(0, wf); bs = in_bs[(l * 4 + 0) * 128 + i];
    asm volatile("" ::: "memory");
    float sm[16], qv[16];
#pragma unroll
    for (int rr = 0; rr < 16; ++rr) { const v4u raw = raws[rr]; sm[rr] = ((bf_lo(raw.x) + bf_hi(raw.x)) + (bf_lo(raw.y) + bf_hi(raw.y))) + ((bf_lo(raw.z) + bf_hi(raw.z)) + (bf_lo(raw.w) + bf_hi(raw.w))); }
#pragma unroll
    for (int o = 32; o >= 1; o >>= 1) { float tp[16];
#pragma unroll
        for (int rr = 0; rr < 16; ++rr) tp[rr] = shx(sm[rr], o, lane);
        GM_JOIN16(tp);
#pragma unroll
        for (int rr = 0; rr < 16; ++rr) sm[rr] += tp[rr]; }
#pragma unroll
    for (int rr = 0; rr < 16; ++rr) { const v4u raw = raws[rr]; const float mean = sm[rr] * (1.0f / 512.0f); sm[rr] = mean;
        const float d0 = bf_lo(raw.x) - mean, d1 = bf_hi(raw.x) - mean, d2 = bf_lo(raw.y) - mean, d3 = bf_hi(raw.y) - mean, d4 = bf_lo(raw.z) - mean, d5 = bf_hi(raw.z) - mean, d6 = bf_lo(raw.w) - mean, d7 = bf_hi(raw.w) - mean;
        qv[rr] = ((d0 * d0 + d1 * d1) + (d2 * d2 + d3 * d3)) + ((d4 * d4 + d5 * d5) + (d6 * d6 + d7 * d7)); }
#pragma unroll
    for (int o = 32; o >= 1; o >>= 1) { float tp[16];
#pragma unroll
        for (int rr = 0; rr < 16; ++rr) tp[rr] = shx(qv[rr], o, lane);
        GM_JOIN16(tp);
#pragma unroll
        for (int rr = 0; rr < 16; ++rr) qv[rr] += tp[rr]; }
#pragma unroll
    for (int rr = 0; rr < 16; ++rr) { const int j = w * 16 + rr; const float rstd = rsqrtf(qv[rr] * (1.0f / 512.0f) + EPS); if (lane == 0) { st[2 * j] = sm[rr]; st[2 * j + 1] = rstd; } }
    GM_BAR();
    float ss = 0.f;
#ifdef GM_DUP2
    int nrep2_ = 2; asm volatile("" : "+s"(nrep2_));
#pragma unroll 1
    for (int rep2_ = 0; rep2_ < nrep2_; ++rep2_) { ss = 0.f; ld_rws(0, rws); ld_ln(0, lnp); ld_wf(0, wf); bs = in_bs[(l * 4 + 0) * 128 + i];
#endif
#pragma unroll 1
    for (int g = 0; g < 4; ++g) {
        u32x2 uv[8];
#pragma unroll
        for (int nb = 0; nb < 8; ++nb) uv[nb] = *(const GAS u32x2*)(U + grow * 512 + g * 128 + 16 * nb + 4 * fq);
        asm volatile("" ::: "memory");
        { const int c = 2 * lane; const float ga0 = lnp[0], ga1 = lnp[1], be0 = lnp[2], be1 = lnp[3];
#pragma unroll
            for (int pr = 0; pr < 8; ++pr) { const int j = w * 16 + 2 * pr;
                const unsigned r0 = rws[2 * pr], r1 = rws[2 * pr + 1];
                const float m0 = st[2 * j], s0 = st[2 * j + 1], m1 = st[2 * j + 2], s1 = st[2 * j + 3];
                const float v00 = (bf_lo(r0) - m0) * s0 * ga0 + be0, v01 = (bf_hi(r0) - m0) * s0 * ga1 + be1, v10 = (bf_lo(r1) - m1) * s1 * ga0 + be0, v11 = (bf_hi(r1) - m1) * s1 * ga1 + be1;
                *(LAS unsigned*)(vt + (c * GM_PITCH + j) * 2) = pk2(v00, v10); *(LAS unsigned*)(vt + ((c + 1) * GM_PITCH + j) * 2) = pk2(v01, v11); } }
        GM_BAR();
        { const int gn = g < 3 ? g + 1 : 3; ld_rws(gn, rws); ld_ln(gn, lnp); ld_wf(gn, wfn); bsn = in_bs[(l * 4 + gn) * 128 + i]; }
        asm volatile("" ::: "memory");
        f32x4v acc[8];
#pragma unroll
        for (int nb = 0; nb < 8; ++nb) acc[nb] = (f32x4v){0.f, 0.f, 0.f, 0.f};
#pragma unroll
        for (int ks = 0; ks < 4; ++ks) {
#pragma unroll
            for (int nb = 0; nb < 8; ++nb) { const bf16x8 vf = *(LAS const bf16x8*)(vt + ((16 * nb + fr) * GM_PITCH + 32 * ks + 8 * fq) * 2);
                acc[nb] = __builtin_amdgcn_mfma_f32_16x16x32_bf16(vf, wf[ks], acc[nb], 0, 0, 0); } }
#pragma unroll
        for (int nb = 0; nb < 8; ++nb) { f32x4v y = acc[nb] + bs;
            y[0] *= bf_lo(uv[nb].x); y[1] *= bf_hi(uv[nb].x); y[2] *= bf_lo(uv[nb].y); y[3] *= bf_hi(uv[nb].y);
            u32x2 o; o.x = cvt_pk_bf16(y[0], y[1]); o.y = cvt_pk_bf16(y[2], y[3]);
            const float y0 = bf_lo(o.x), y1 = bf_hi(o.x), y2 = bf_lo(o.y), y3 = bf_hi(o.y); ss += (y0 * y0 + y1 * y1) + (y2 * y2 + y3 * y3);
            *(GAS u32x2*)(YC + grow * DM + 512 + g * 128 + 16 * nb + 4 * fq) = o; }
        GM_BAR();
#pragma unroll
        for (int ks = 0; ks < 4; ++ks) wf[ks] = wfn[ks];
        bs = bsn;
    }
#ifdef GM_DUP2
    }
#endif
    ss += shx(ss, 16, lane); ss += shx(ss, 32, lane);
    if (fq == 0) ((float*)(F.ws + WS_GSS))[grow] = ss;
}
__device__ __forceinline__ void fp8x4_fma(float (&a)[16], int base, unsigned w, float g) { a[base] += g * __builtin_amdgcn_cvt_f32_fp8((int)w, 0); a[base + 1] += g * __builtin_amdgcn_cvt_f32_fp8((int)w, 1); a[base + 2] += g * __builtin_amdgcn_cvt_f32_fp8((int)w, 2); a[base + 3] += g * __builtin_amdgcn_cvt_f32_fp8((int)w, 3); }
constexpr int P7_NR = 2;
__device__ __forceinline__ void p7_combine(Frame& F, bf16* hb, float* ssq_out) {
    const LAS int* tst = (const LAS int*)(F.lds + LTST_OFF);
    const int gw = F.vcu * NWAVES + F.wave, NGW = F.G * NWAVES;
    const int* tope = (const int*)(F.ws + WS_TOPE); const float* gate = (const float*)(F.ws + WS_GATE); const unsigned char* ys = F.ws + WS_YS;
    for (int tok0 = gw; tok0 < T; tok0 += P7_NR * NGW) {
        v4u y[P7_NR][4], h0[P7_NR], h1[P7_NR]; float g[P7_NR][4]; int te[P7_NR][4];
#pragma unroll
        for (int r = 0; r < P7_NR; ++r) { const int tok = tok0 + r * NGW < T ? tok0 + r * NGW : tok0;
#pragma unroll
            for (int k = 0; k < 4; ++k) { te[r][k] = tope[tok * 4 + k]; g[r][k] = gate[tok * 4 + k]; } }
#pragma unroll
        for (int r = 0; r < P7_NR; ++r) { const int tok = tok0 + r * NGW < T ? tok0 + r * NGW : tok0; const GAS v4u* hr = (const GAS v4u*)(hb + (size_t)tok * DM) + 2 * F.lane;
#pragma unroll
            for (int k = 0; k < 4; ++k) { const size_t pos = (size_t)tst[te[r][k] >> 16] * 256 + (te[r][k] & 0xffff); y[r][k] = RD1_NT ? __builtin_nontemporal_load((const GAS v4u*)(ys + pos * DM) + F.lane) : *((const GAS v4u*)(ys + pos * DM) + F.lane); }
            h0[r] = hr[0]; h1[r] = hr[1]; }
#pragma unroll
        for (int r = 0; r < P7_NR; ++r) { const int tok = tok0 + r * NGW; if (tok < T) { float a[16];
            a[0] = bf_lo(h0[r].x); a[1] = bf_hi(h0[r].x); a[2] = bf_lo(h0[r].y); a[3] = bf_hi(h0[r].y); a[4] = bf_lo(h0[r].z); a[5] = bf_hi(h0[r].z); a[6] = bf_lo(h0[r].w); a[7] = bf_hi(h0[r].w);
            a[8] = bf_lo(h1[r].x); a[9] = bf_hi(h1[r].x); a[10] = bf_lo(h1[r].y); a[11] = bf_hi(h1[r].y); a[12] = bf_lo(h1[r].z); a[13] = bf_hi(h1[r].z); a[14] = bf_lo(h1[r].w); a[15] = bf_hi(h1[r].w);
#pragma unroll
            for (int k = 0; k < 4; ++k) { fp8x4_fma(a, 0, y[r][k].x, g[r][k]); fp8x4_fma(a, 4, y[r][k].y, g[r][k]); fp8x4_fma(a, 8, y[r][k].z, g[r][k]); fp8x4_fma(a, 12, y[r][k].w, g[r][k]); }
            float s = 0.f;
#pragma unroll
            for (int i = 0; i < 16; ++i) s += a[i] * a[i];
            v4u o0, o1; o0.x = pk2(a[0], a[1]); o0.y = pk2(a[2], a[3]); o0.z = pk2(a[4], a[5]); o0.w = pk2(a[6], a[7]); o1.x = pk2(a[8], a[9]); o1.y = pk2(a[10], a[11]); o1.z = pk2(a[12], a[13]); o1.w = pk2(a[14], a[15]);
            GAS v4u* hw = (GAS v4u*)(hb + (size_t)tok * DM) + 2 * F.lane; hw[0] = o0; hw[1] = o1;
            s = wave_sum(s, F.lane);
            if (F.lane < 16) ssq_out[(size_t)tok * 16 + F.lane] = F.lane == 0 ? s : 0.f; } }
    }
}
__device__ __forceinline__ void final_norm(Frame& F, const bf16* hb, const float* ssq16) {
    const int gw = F.vcu * NWAVES + F.wave, NGW = F.G * NWAVES;
    const GAS f32x4* gf = (const GAS f32x4*)INP(22) + F.lane; f32x4 gg[4];
#pragma unroll
    for (int j = 0; j < 4; ++j) gg[j] = gf[64 * j];
    constexpr int FR = FROWS; static_assert(T % (FR * 8) == 0, "final-norm rows per wave");
    for (int tok0 = FR * gw; tok0 < T; tok0 += FR * NGW) {
        float sq[FR]; u32x2 hv[FR][4];
#pragma unroll
        for (int r = 0; r < FR; ++r) { const int tok = tok0 + r; sq[r] = F.lane < 16 ? ssq16[(size_t)tok * 16 + F.lane] : 0.f;
            const GAS u32x2* hr = (const GAS u32x2*)(hb + (size_t)tok * DM) + F.lane;
#pragma unroll
            for (int j = 0; j < 4; ++j) hv[r][j] = FIN_NT ? __builtin_nontemporal_load(hr + 64 * j) : hr[64 * j]; }
#pragma unroll
        for (int o = 1; o < 64; o <<= 1) { float tq[FR];
#pragma unroll
            for (int r = 0; r < FR; ++r) tq[r] = shx(sq[r], o, F.lane);
#pragma unroll
            for (int r = 0; r < FR; ++r) sq[r] += tq[r]; }
#pragma unroll
        for (int r = 0; r < FR; ++r) { const int tok = tok0 + r; const float ri = rsqrtf(sq[r] * (1.0f / DM) + EPS); GAS f32x4* orow = (GAS f32x4*)(F.H + (size_t)tok * DM) + F.lane;
#pragma unroll
            for (int j = 0; j < 4; ++j) { const u32x2 h = hv[r][j]; f32x4 v; v.x = bf_lo(h.x); v.y = bf_hi(h.x); v.z = bf_lo(h.y); v.w = bf_hi(h.y); const f32x4 ov = v * ri * gg[j]; if (FIN_NT) __builtin_nontemporal_store(ov, orow + 64 * j); else orow[64 * j] = ov; } }
    }
}

struct Args { const float* in[23]; float* out; unsigned char* ws; int ph_lo, ph_hi; };
__global__ void __launch_bounds__(NWAVES * 64, 2) fwd_kernel(Args args) {
    extern __shared__ __attribute__((aligned(16))) unsigned char lds[];
    Frame F;
    F.lds = (LAS unsigned char*)lds;
    F.MISC = (volatile LAS unsigned*)(F.lds + MISC_OFF);
    F.tid = threadIdx.x; F.lane = F.tid & 63; F.wave = __builtin_amdgcn_readfirstlane(F.tid >> 6);
    const int wave0 = F.wave;
    F.G = gridDim.x; { const int bx = blockIdx.x; F.bx = bx; F.vcu = (F.G % 8 == 0) ? (bx % 8) * (F.G / 8) + bx / 8 : bx; }
    unsigned char* ws = (unsigned char*)(GAS unsigned char*)args.ws; F.ws = ws; F.H = (float*)(GAS float*)args.out;
    F.ctl = (gu32*)(ws + WS_CTL);
    for (int u = F.tid; u < (LDS_BYTES - LDSCTL_OFF) / 4; u += NWAVES * 64) ((LAS unsigned*)(F.lds + LDSCTL_OFF))[u] = 0u;
    __syncthreads();
    const int lo = args.ph_lo, hi = args.ph_hi;
    XcdBarrier bar; bar.bar = (unsigned*)(F.ctl + CW_BAR); bar.x = 0; bar.st = nullptr; bar.wave = 0;
    if (!MK_PER_STEP) bar = xcd_barrier_post((unsigned*)(F.ctl + CW_BAR), F.MISC + 8);
#if MK_PER_STEP
#define IN(k) (lo <= (k) && (k) < hi)
#else
#define IN(k) true
#endif
#ifndef PROBE_STEP
#define PROBE_STEP (-1)
#endif
#ifndef PROBE_MODE
#define PROBE_MODE 0
#endif
    unsigned long long ts0_ = (PROBE_STEP == 0) ? rt() : 0ull, ts1_ = 0;
#ifdef PROBE_CONV
#undef PROBE_STEP
#define PROBE_STEP 999
#endif
#ifdef PROBE_BARSUM
#undef PROBE_STEP
#define PROBE_STEP 999
#define SEAM(k) do { const unsigned long long tb_ = rt(); if (IN(k) && IN((k) + 1)) xcd_barrier(bar); ts1_ += rt() - tb_; } while (0)
#else
#define SEAM(k) do { if (PROBE_STEP == (k)) { if (PROBE_MODE == 0) ts1_ = rt(); else ts0_ = rt(); } if (IN(k) && IN((k) + 1)) xcd_barrier(bar); if (PROBE_STEP == (k) && PROBE_MODE == 1) ts1_ = rt(); if (PROBE_STEP == (k) + 1 && PROBE_MODE == 0) ts0_ = rt(); } while (0)
#endif
#define HBA ((bf16*)(ws + WS_HBA))
#define HBB ((bf16*)(ws + WS_HBB))
#define SSQX ((float*)(ws + WS_SSQX))
#define SSQY ((float*)(ws + WS_SSQY))

#ifndef PHMASK
#define PHMASK 0x3ff
#endif
#define PH(j) ((PHMASK >> (j)) & 1)
#ifndef DUPMASK
#define DUPMASK 0
#endif
#define NREP(j) (1 + ((DUPMASK >> (j)) & 1))
#ifndef SUBMASK
#define SUBMASK 0xff
#endif
#define SUB(j) ((SUBMASK >> (j)) & 1)
    if (PH(0) && IN(0)) { for (int rep_ = 0; rep_ < NREP(0); ++rep_) p0_prologue(F); } SEAM(0);

#define RETID() do { int t_ = mk_tid(wave0); F.tid = t_; F.lane = t_ & 63; F.wave = __builtin_amdgcn_readfirstlane(t_ >> 6); GAS unsigned char* w_ = (GAS unsigned char*)args.ws; asm volatile("" : "+s"(w_)); F.ws = (unsigned char*)w_; ws = (unsigned char*)w_; int bx_ = blockIdx.x, g_ = gridDim.x; asm volatile("" : "+s"(bx_), "+s"(g_)); F.G = g_; F.vcu = (g_ % 8 == 0) ? (bx_ % 8) * (g_ / 8) + bx_ / 8 : bx_; F.bx = bx_; } while (0)
    for (int l = 0; l < NLAYER; ++l) {
        const int sb = 1 + 8 * l;
        const bf16* hb_in = l == 0 ? HBA : HBB;
        if (PH(1) && IN(sb)) { RETID();
            if (!P_IN_P2 && SUB(0) && l == 0) {
                for (int rep_ = 0; rep_ < NREP(1); ++rep_) {
                    pg8::DenseOrder2 S; S.init((const bf16*)(ws + WS_PB), (const bf16*)(ws + WS_WPLE), T, DM, PLE, F.G, F.bx); S.astride = (size_t)T * PLE * 2; S.bstride = (size_t)DM * PLE * 2;
#if E_F8
                    EpiE8 E{ws + WS_E, (size_t)T * DM};
#else
                    EpiBf E{(bf16_t*)(ws + WS_E), nullptr, 0, (size_t)T * DM};
#endif
                    int kple = PLE; asm volatile("" : "+s"(kple));
                    pg8::gemm_phase<decltype(E), pg8::DenseOrder2, false, false>(F.lds + RING_OFF, kple, S, E, F.tid);
                }
            }
            for (int rep_ = 0; rep_ < NREP(2); ++rep_) {
            if (SUB(1)) p1_flogit(F, l, hb_in, SSQX);
            if (SUB(2)) {
#if P1_F8
            pg8::DenseOrder S; S.init(ws + WS_H8, ws + WS_WIN + (size_t)l * NIN * DM, T, NIN, DM / 2, F.G, F.bx);
            EpiIn8 E{(bf16_t*)(ws + WS_U), SSQX, F.ctl + CW_NORM + l * 256};
            int k8 = DM / 2; asm volatile("" : "+s"(k8));
            pg8::gemm_phase<EpiIn8, pg8::DenseOrder, false, false, 1>(F.lds + RING_OFF, k8, S, E, F.tid);
#else
            pg8::DenseOrder S; S.init(hb_in, (const bf16*)(ws + WS_WIN) + (size_t)l * NIN * DM, T, NIN, DM, F.G, F.bx);
            EpiIn E{(bf16_t*)(ws + WS_U), SSQX, F.ctl + CW_NORM + l * 256};
            pg8::gemm_phase<EpiIn, pg8::DenseOrder, false, false>(F.lds + RING_OFF, DM, S, E, F.tid);
#endif
            }
            }
        }
        SEAM(sb);
        if (PH(2) && IN(sb + 1)) { RETID();
            for (int rep_ = 0; rep_ < NREP(3); ++rep_) if (SUB(3)) for (int blk = F.vcu; blk < T / 128; blk += F.G) gmlp_unit(F, l, blk);
            if (CONV_IN_P2 && SUB(5) && (CONV_XCD ? (F.bx & 7) < CONV_NUM : (((F.bx >> 3) * CONV_NUM) & 7) < CONV_NUM)) { __syncthreads();
#ifdef PROBE_CONV
                const unsigned long long tc0_ = rt();
#endif
                conv_experts(F, l); if (P_IN_P2 && l == 0) conv_p(F); __syncthreads();
#ifdef PROBE_CONV
                if (l == 0) { ts0_ = tc0_; ts1_ = rt(); }
#endif
            }
            for (int rep_ = 0; rep_ < NREP(4); ++rep_) if (SUB(4)) for (int vv = F.vcu; vv < 256; vv += F.G) {
                int bh = vv >> 2; gu32* ctr = F.ctl + CW_AQ + (size_t)((l * NREP(4) + rep_) * 64) * 64;
                LAS int* qslot = (LAS int*)(F.lds + attn_body::LDS_WS + 64);
                for (;;) {
                    fox_scan(F, bh);
                    const gu32* nb = F.ctl + CW_NORM + l * 256;
                    const float qn2 = __uint_as_float(__hip_atomic_load(nb + (0 * 64 + bh) * 2, RLX_AGENT)) + __uint_as_float(__hip_atomic_load(nb + (0 * 64 + bh) * 2 + 1, RLX_AGENT));
                    const float kn2 = __uint_as_float(__hip_atomic_load(nb + (1 * 64 + bh) * 2, RLX_AGENT)) + __uint_as_float(__hip_atomic_load(nb + (1 * 64 + bh) * 2 + 1, RLX_AGENT));
                    const float theta = 2.0f * sqrtf(qn2 * kn2) + ATT_SKIP_T;
                    if (F.tid == 0) *qslot = (int)__hip_atomic_fetch_add(ctr + bh * 64, 1u, RLX_AGENT);
                    __syncthreads();
                    int qi = __builtin_amdgcn_readfirstlane(*qslot);
                    __syncthreads();
                    while (qi < 16) {
                        unsigned nxt_ = 16u; if (ATT_PREGRAB && F.tid == 0) nxt_ = __hip_atomic_fetch_add(ctr + bh * 64, 1u, RLX_AGENT);
                        attn_body::attn_unit<8>(bh >> 3, bh & 7, 15 - qi, (const attn_body::bf16*)(ws + WS_U + 2 * SEG_BYTES), (const attn_body::bf16*)(ws + WS_U + 3 * SEG_BYTES), (const attn_body::bf16*)(ws + WS_U + 4 * SEG_BYTES),
                                                (attn_body::bf16*)(ws + WS_YC), (float*)(ws + WS_OSS), (char*)lds + RING_OFF, F.tid, theta, (ATT_LATEGRAB && !ATT_PREGRAB) ? (unsigned*)(ctr + bh * 64) : nullptr, nxt_);
                        if (!ATT_PREGRAB && !ATT_LATEGRAB && F.tid == 0) nxt_ = __hip_atomic_fetch_add(ctr + bh * 64, 1u, RLX_AGENT);
                        if (F.tid == 0) *qslot = (int)nxt_;
                        __syncthreads();
                        qi = __builtin_amdgcn_readfirstlane(*qslot);
                        __syncthreads();
                    }
                    if (F.wave == 0) { const unsigned c = __hip_atomic_load(ctr + F.lane * 64, RLX_AGENT); const unsigned long long m = __ballot(c < 16u);
                        int nx = -1; if (m) { const unsigned long long rot = (m >> ((bh + 1) & 63)) | (((bh + 1) & 63) ? (m << (64 - ((bh + 1) & 63))) : 0ull); nx = (bh + 1 + __builtin_ctzll(rot)) & 63; }
                        if (F.lane == 0) *qslot = nx; }
                    __syncthreads();
                    const int nx = __builtin_amdgcn_readfirstlane(*qslot);
                    __syncthreads();
                    if (nx < 0) break;
                    bh = nx;
                }
            }
            if (CONV_IN_P2 && SUB(5)) { __syncthreads(); conv_experts(F, l); if (P_IN_P2 && l == 0) conv_p(F); }
        }
        SEAM(sb + 1);
        if (PH(3) && IN(sb + 2)) { RETID();
            pg8::DenseOrder S; S.init((const bf16*)(ws + WS_YC), (const bf16*)(ws + WS_WOUT) + (size_t)l * DM * DM, T, DM, DM, F.G, F.bx);
            EpiRes E{(const bf16_t*)(l == 0 ? HBA : HBB), (bf16_t*)HBA, SSQX, (const float*)(ws + WS_OSS), (const float*)(ws + WS_GSS), ws + WS_H8};
            pg8::gemm_phase<EpiRes, pg8::DenseOrder, false, true>(F.lds + RING_OFF, DM, S, E, F.tid);
            if (P_IN_P2 && SUB(0) && l == 0) {
                pg8::DenseOrder2 S2; S2.init((const bf16*)(ws + WS_PB), (const bf16*)(ws + WS_WPLE), T, DM, PLE, F.G, F.bx); S2.astride = (size_t)T * PLE * 2; S2.bstride = (size_t)DM * PLE * 2;
#if E_F8
                EpiE8 E2{ws + WS_E, (size_t)T * DM};
#else
                EpiBf E2{(bf16_t*)(ws + WS_E), nullptr, 0, (size_t)T * DM};
#endif
                int kple = PLE; asm volatile("" : "+s"(kple));
                pg8::gemm_phase<decltype(E2), pg8::DenseOrder2, false, false>(F.lds + RING_OFF, kple, S2, E2, F.tid);
            }
        }
        SEAM(sb + 2);
        if (PH(4) && IN(sb + 3)) { RETID(); p4_router(F, l, HBA, SSQX); }
        SEAM(sb + 3);
        if (PH(5) && IN(sb + 4)) { RETID();
            const int ntiles = build_tiles(F, l);
            pg8::GroupedOrder<true> S; S.A = (const char*)(ws + WS_H8); S.Bt = (const char*)(ws + WS_WGU + (size_t)l * NEXP * 2048 * DM); S.K = DM / 2; S.N = 2048; S.npn = 8;
            S.tiles = (const LAS int*)(F.lds + LTILES_OFF); S.cnt = (const LAS int*)(F.lds + LCNT_OFF); S.lists = (const int*)(ws + WS_LISTS); S.ntiles = ntiles; S.G = F.G; S.vcu = F.vcu;
#if FP8_SHAPE == 16
            EpiSwiglu16 E{ws + WS_ACT, (const int*)(ws + WS_LISTS), (const LAS int*)(F.lds + LCNT_OFF), INP(16) + (size_t)l * NEXP * 2048};
#else
            EpiSwiglu8 E{ws + WS_ACT, (const float*)(ws + WS_RINV), (const int*)(ws + WS_LISTS), (const LAS int*)(F.lds + LCNT_OFF), INP(16) + (size_t)l * NEXP * 2048};
#endif
            for (int rep_ = 0; rep_ < NREP(5); ++rep_) { int k8 = DM / 2; asm volatile("" : "+s"(k8)); pg8::gemm_phase<decltype(E), pg8::GroupedOrder<true>, true, false, FP8_SHAPE == 16 ? 2 : 1>(F.lds + RING_OFF, k8, S, E, F.tid); }
        }
        SEAM(sb + 4);
        if (PH(6) && IN(sb + 5)) { RETID();
            const int ntiles = reuse_tiles(F, l);
            pg8::GroupedOrder<false> S; S.A = (const char*)(ws + WS_ACT); S.Bt = (const char*)(ws + WS_WDN + (size_t)l * NEXP * DM * DM); S.K = DM / 2; S.N = DM; S.npn = 4;
            S.tiles = (const LAS int*)(F.lds + LTILES_OFF); S.cnt = (const LAS int*)(F.lds + LCNT_OFF); S.lists = nullptr; S.ntiles = ntiles; S.G = F.G; S.vcu = F.vcu;
#if FP8_SHAPE == 16
            EpiDown16 E{ws + WS_YS, INP(18) + (size_t)l * NEXP * DM};
#else
            EpiDown8 E{ws + WS_YS, INP(18) + (size_t)l * NEXP * DM};
#endif
            for (int rep_ = 0; rep_ < NREP(6); ++rep_) { int k8 = DM / 2; asm volatile("" : "+s"(k8)); pg8::gemm_phase<decltype(E), pg8::GroupedOrder<false>, false, false, FP8_SHAPE == 16 ? 2 : 1>(F.lds + RING_OFF, k8, S, E, F.tid); }
        }
        SEAM(sb + 5);
        if (PH(7) && IN(sb + 6)) { RETID(); (void)reuse_tiles(F, l); p7_combine(F, HBA, SSQY); }
        SEAM(sb + 6);
        if (PH(8) && IN(sb + 7)) { RETID();
            pg8::DenseOrder S; S.init(HBA, (const bf16*)(ws + WS_WPG) + (size_t)l * DM * DM, T, DM, DM, F.G, F.bx);
            EpiPle E{(const bf16_t*)HBA, (bf16_t*)HBB, SSQX, SSQY, E_F8 ? (const bf16_t*)(ws + WS_E + (size_t)l * T * DM) : (const bf16_t*)(ws + WS_E) + (size_t)l * T * DM};
            for (int rep_ = 0; rep_ < NREP(8); ++rep_) pg8::gemm_phase<EpiPle, pg8::DenseOrder, false, false>(F.lds + RING_OFF, DM, S, E, F.tid);
        }
        SEAM(sb + 7);
    }
    if (PH(9) && IN(NSTEPS - 1)) { RETID(); final_norm(F, HBB, SSQX); }
#ifdef PROBE_EPI
    if (blockIdx.x == 0) { __syncthreads(); const unsigned long long span_ = *(LAS unsigned long long*)(F.lds + LDSCTL_OFF + 384), te_ = rt(); while (rt() - te_ < span_) __builtin_amdgcn_s_sleep(8); }
#endif
    if (PROBE_STEP >= 0) { if (PROBE_STEP == NSTEPS - 1) ts1_ = rt(); if (blockIdx.x == 0) { const unsigned long long te_ = rt(), span_ = ts1_ - ts0_; while (rt() - te_ < span_) __builtin_amdgcn_s_sleep(8); } }
#undef IN
#undef SEAM
#undef HBA
#undef HBB
#undef SSQX
#undef SSQY
}

extern "C" void kernel_launch(void* const* d_in, const int* in_sizes, int n_in, void* d_out, int out_size, void* d_ws, size_t ws_size, hipStream_t stream) {
    static int grid = 0;
    if (grid == 0) {
        if (n_in != 23 || in_sizes[0] != T * DM || out_size != T * DM || ws_size < WS_END) { fprintf(stderr, "kernel_launch: unexpected shapes / workspace (n_in %d, ws %zu < %zu); nothing launched\n", n_in, ws_size, (size_t)WS_END); grid = -1; return; }
        int dev = 0, cus = 0, per_cu = 0;
        if (hipGetDevice(&dev) != hipSuccess || hipDeviceGetAttribute(&cus, hipDeviceAttributeMultiprocessorCount, dev) != hipSuccess) { grid = -1; return; }
        if (hipFuncSetAttribute((const void*)fwd_kernel, hipFuncAttributeMaxDynamicSharedMemorySize, LDS_BYTES) != hipSuccess) { fprintf(stderr, "kernel_launch: hipFuncSetAttribute failed\n"); grid = -1; return; }
        if (hipOccupancyMaxActiveBlocksPerMultiprocessor(&per_cu, (const void*)fwd_kernel, NWAVES * 64, LDS_BYTES) != hipSuccess || per_cu < 1) { fprintf(stderr, "kernel_launch: occupancy query says %d blocks per CU\n", per_cu); }
        (void)hipGetLastError();
        grid = cus;
    }
    if (grid < 0) return;
    if (hipMemsetAsync((char*)d_ws + WS_CTL, 0, CTL_ZERO_BYTES, stream) != hipSuccess) return;
    Args a{};
    for (int i = 0; i < 23; ++i) a.in[i] = (const float*)d_in[i];
    a.out = (float*)d_out; a.ws = (unsigned char*)d_ws;
#if MK_PER_STEP
    for (int s = 0; s < NSTEPS; ++s) { a.ph_lo = s; a.ph_hi = s + 1; hipLaunchKernelGGL(fwd_kernel, dim3(grid), dim3(NWAVES * 64), LDS_BYTES, stream, a); }
#else
    a.ph_lo = 0; a.ph_hi = NSTEPS;
    hipLaunchKernelGGL(fwd_kernel, dim3(grid), dim3(NWAVES * 64), LDS_BYTES, stream, a);
#endif
}
```
